# Optimizing an MI355X kernel written in HIP

```python
import math
import jax
import jax.numpy as jnp
from jax import lax
import numpy as np

D_MODEL = 2048
BATCH = 4
SEQ = 2048
DEPTH = 2

ATT_WIDTH = D_MODEL // 2
RWKV_WIDTH = D_MODEL - ATT_WIDTH
ATT_QK_DIM = 64
ATT_V_DIM = 2 * ATT_QK_DIM
ATT_HEADS = ATT_WIDTH // ATT_V_DIM
ATT_QK_COLS = ATT_HEADS * 2 * ATT_QK_DIM
ATT_COLS = 2 * ATT_QK_COLS + ATT_WIDTH
Q_BLOCK = 128
ALIBI_MAX_BIAS = 8.0
ATT_SUBLN_EPS = 1e-5
RWKV_HEAD = 64
RWKV_HEADS = RWKV_WIDTH // RWKV_HEAD
RWKV_W_RANK = 64
RWKV_A_RANK = 64
RWKV_G_RANK = 128
RWKV_V_RANK = 32
RWKV_COLS = 3 * RWKV_WIDTH + RWKV_W_RANK + RWKV_A_RANK + RWKV_G_RANK
RWKV_SPLIT = (RWKV_WIDTH, 2 * RWKV_WIDTH, 3 * RWKV_WIDTH,
              3 * RWKV_WIDTH + RWKV_W_RANK, 3 * RWKV_WIDTH + RWKV_W_RANK + RWKV_A_RANK)
RWKV_GN_EPS = 64e-5
IN_COLS = ATT_COLS + RWKV_COLS
N_EXPERTS = 64
N_GROUPS = 8
TOPK_GROUPS = 4
TOP_K = 8
D_EXPERT = 512
D_SHARED = 512
ROUTED_SCALE = 2.5
MOE_BLOCK = 128
NORM_EPS = 1e-6
N_MOD = 6

kernel_name = "hybrid_diffattn_rwkv7_moe_block"


def rms_norm(x, g, eps=NORM_EPS):
    xf = x.astype(jnp.float32)
    y = xf * lax.rsqrt(jnp.mean(xf * xf, axis=-1, keepdims=True) + eps)
    return (y * g.astype(jnp.float32)).astype(x.dtype)


def token_shift(h, mu):
    prev = jnp.pad(h, ((0, 0), (1, 0), (0, 0)))[:, :-1]
    return h + (prev - h) * mu


def alibi_slopes(n_heads):
    return 2.0 ** (-ALIBI_MAX_BIAS * jnp.arange(1, n_heads + 1, dtype=jnp.float32) / n_heads)


def diff_attention(q, k, v, lam, subln_g, lam_init):
    B, S = q.shape[0], q.shape[1]
    nb = S // Q_BLOCK
    f32 = jnp.float32
    scale = ATT_QK_DIM ** -0.5
    slopes = alibi_slopes(ATT_HEADS)[:, None, None, None]
    kf = k.astype(f32)
    vf = v.astype(f32)
    qb = q.astype(f32).reshape(B, nb, Q_BLOCK, ATT_HEADS, 2, ATT_QK_DIM).swapaxes(0, 1)
    kpos = jnp.arange(S)

    def block(args):
        qi, bi = args
        qpos = bi * Q_BLOCK + jnp.arange(Q_BLOCK)
        dist = qpos[:, None] - kpos[None, :]
        s = jnp.einsum("bqhcd,bkhcd->bhcqk", qi, kf) * scale - slopes * dist.astype(f32)
        s = jnp.where(dist >= 0, s, -jnp.inf)
        p = jax.nn.softmax(s, axis=-1)
        a = p[:, :, 0] - lam * p[:, :, 1]
        return jnp.einsum("bhqk,bkhd->bqhd", a, vf)

    o = lax.map(block, (qb, jnp.arange(nb)))
    o = o.swapaxes(0, 1).reshape(B, S, ATT_HEADS, ATT_V_DIM)
    o = o * lax.rsqrt(jnp.mean(o * o, axis=-1, keepdims=True) + ATT_SUBLN_EPS)
    o = o * subln_g.astype(f32) * (1.0 - lam_init)
    return o.reshape(B, S, ATT_WIDTH)


def wkv7_scan(r, w, k, v, a, b):
    B, S, H, N = r.shape
    xs = tuple(t.swapaxes(0, 1) for t in (r, w, k, v, a, b))

    def step(state, inp):
        r_t, w_t, k_t, v_t, a_t, b_t = inp
        sa = jnp.einsum("bhij,bhj->bhi", state, a_t)
        state = (state * w_t[:, :, None, :] + sa[..., None] * b_t[:, :, None, :]
                 + v_t[..., None] * k_t[:, :, None, :])
        return state, jnp.einsum("bhij,bhj->bhi", state, r_t)

    s0 = jnp.zeros((B, H, N, N), jnp.float32)
    _, ys = lax.scan(step, s0, xs)
    return ys.swapaxes(0, 1)


def rwkv7_mix(feats, v_first, w0, w2, a0, a2, g2, k_k, k_a, r_k, lnx_w, lnx_b, vres):
    B, S, _ = feats.shape
    f32 = jnp.float32
    feats = feats.astype(f32)
    r, k, v, w_lo, a_lo, g_lo = jnp.split(feats, list(RWKV_SPLIT), axis=-1)
    w = w0 + jnp.tanh(w_lo) @ w2
    decay = jnp.exp(-jnp.exp(-jax.nn.softplus(-w) - 0.5))
    a = jax.nn.sigmoid(a0 + a_lo @ a2)
    g = jax.nn.sigmoid(g_lo) @ g2
    if vres is None:
        v_first = v
    else:
        v0, v1, v2 = vres
        v = v + (v_first - v) * jax.nn.sigmoid(v0 + (v @ v1) @ v2)
    heads = lambda t: t.reshape(B, S, RWKV_HEADS, RWKV_HEAD)
    kk = heads(k * k_k)
    kk = kk / jnp.maximum(jnp.sqrt(jnp.sum(kk * kk, axis=-1, keepdims=True)), 1e-12)
    kh = heads(k * (1.0 + (a - 1.0) * k_a))
    rh, vh, ah = heads(r), heads(v), heads(a)
    y = wkv7_scan(rh, heads(decay), kh, vh, -kk, kk * ah)
    mu = jnp.mean(y, axis=-1, keepdims=True)
    var = jnp.mean(jnp.square(y - mu), axis=-1, keepdims=True)
    y = ((y - mu) * lax.rsqrt(var + RWKV_GN_EPS)).reshape(B, S, RWKV_WIDTH) * lnx_w + lnx_b
    bonus = jnp.sum(rh * kh * r_k, axis=-1, keepdims=True) * vh
    y = (y + bonus.reshape(B, S, RWKV_WIDTH)) * g
    return y, v_first


def swiglu(x, w_gate, w_up, w_down):
    return (jax.nn.silu(x @ w_gate) * (x @ w_up)) @ w_down


def routed_experts(xf, eidx, gate, w_gate, w_up, w_down):
    T, D = xf.shape
    A = T * TOP_K
    n_blocks = -(-A // MOE_BLOCK) + N_EXPERTS
    P = n_blocks * MOE_BLOCK
    flat_e = eidx.reshape(-1).astype(jnp.int32)
    flat_tok = jnp.repeat(jnp.arange(T, dtype=jnp.int32), TOP_K)
    flat_g = gate.reshape(-1)
    order = jnp.argsort(flat_e, stable=True)
    se, stok, sg = flat_e[order], flat_tok[order], flat_g[order]
    counts = jnp.bincount(flat_e, length=N_EXPERTS)
    padded = (counts + MOE_BLOCK - 1) // MOE_BLOCK * MOE_BLOCK
    pad_end = jnp.cumsum(padded)
    pad_start = pad_end - padded
    start = jnp.cumsum(counts) - counts
    dest = pad_start[se] + jnp.arange(A, dtype=jnp.int32) - start[se]
    row_tok = jnp.zeros((P,), jnp.int32).at[dest].set(stok)
    row_g = jnp.zeros((P,), xf.dtype).at[dest].set(sg)
    blk_start = jnp.arange(n_blocks, dtype=jnp.int32) * MOE_BLOCK
    blk_e = jnp.minimum(jnp.searchsorted(pad_end, blk_start, side="right"), N_EXPERTS - 1)

    def block(args):
        e, tok, g = args
        xb = xf[tok]
        return swiglu(xb, w_gate[e], w_up[e], w_down[e]) * g[:, None]

    rows = lax.map(block, (blk_e, row_tok.reshape(n_blocks, MOE_BLOCK),
                           row_g.reshape(n_blocks, MOE_BLOCK)))
    return jax.ops.segment_sum(rows.reshape(P, D), row_tok, num_segments=T)


def moe_ffn(xf, w_router, router_bias, w_exp_gate, w_exp_up, w_exp_down,
            w_sh_gate, w_sh_up, w_sh_down):
    T = xf.shape[0]
    scores = jax.nn.sigmoid((xf @ w_router).astype(jnp.float32))
    biased = scores + router_bias.astype(jnp.float32)
    grp = biased.reshape(T, N_GROUPS, N_EXPERTS // N_GROUPS)
    grp_score = jnp.sum(lax.top_k(grp, 2)[0], axis=-1)
    _, gidx = lax.top_k(grp_score, TOPK_GROUPS)
    gmask = jnp.sum(jax.nn.one_hot(gidx, N_GROUPS, dtype=jnp.float32), axis=1)
    emask = jnp.repeat(gmask, N_EXPERTS // N_GROUPS, axis=1)
    _, eidx = lax.top_k(jnp.where(emask > 0, biased, -jnp.inf), TOP_K)
    gate = jnp.take_along_axis(scores, eidx, axis=1)
    gate = gate / jnp.sum(gate, axis=-1, keepdims=True) * ROUTED_SCALE
    routed = routed_experts(xf, eidx, gate.astype(xf.dtype), w_exp_gate, w_exp_up, w_exp_down)
    return routed + swiglu(xf, w_sh_gate, w_sh_up, w_sh_down)


def setup_inputs(seed: int = 0) -> dict:
    key = jax.random.key(seed)
    ks = iter(jax.random.split(key, 48))
    f32 = jnp.float32
    L, D = DEPTH, D_MODEL
    LV = max(DEPTH - 1, 0)
    nrm = lambda shape, s: s * jax.random.normal(next(ks), shape, f32)
    gain = lambda shape: 1.0 + 0.05 * jax.random.normal(next(ks), shape, f32)
    return {
        "x": nrm((BATCH, SEQ, D), 1.0),
        "c": nrm((BATCH, D), 1.0),
        "w_ada": nrm((L, D, N_MOD * D), 0.5 * D ** -0.5),
        "b_ada": nrm((L, N_MOD * D), 0.01),
        "g_pre_mix": gain((L, D)),
        "g_post_mix": gain((L, D)),
        "g_pre_ffn": gain((L, D)),
        "g_post_ffn": gain((L, D)),
        "w_in": nrm((L, D, IN_COLS), D ** -0.5),
        "w_out": nrm((L, D, D), D ** -0.5),
        "lam_q1": nrm((L, ATT_QK_DIM), 0.1),
        "lam_k1": nrm((L, ATT_QK_DIM), 0.1),
        "lam_q2": nrm((L, ATT_QK_DIM), 0.1),
        "lam_k2": nrm((L, ATT_QK_DIM), 0.1),
        "att_subln_g": gain((L, ATT_V_DIM)),
        "rwkv_mu": jax.random.uniform(next(ks), (L, RWKV_COLS), f32),
        "rwkv_w0": jax.random.uniform(next(ks), (L, RWKV_WIDTH), f32, -6.5, 0.5),
        "rwkv_w2": nrm((L, RWKV_W_RANK, RWKV_WIDTH), 0.1),
        "rwkv_a0": nrm((L, RWKV_WIDTH), 0.1),
        "rwkv_a2": nrm((L, RWKV_A_RANK, RWKV_WIDTH), 0.1),
        "rwkv_g2": nrm((L, RWKV_G_RANK, RWKV_WIDTH), RWKV_G_RANK ** -0.5),
        "rwkv_k_k": gain((L, RWKV_WIDTH)),
        "rwkv_k_a": gain((L, RWKV_WIDTH)),
        "rwkv_r_k": nrm((L, RWKV_HEADS, RWKV_HEAD), 0.1),
        "rwkv_lnx_w": gain((L, RWKV_WIDTH)),
        "rwkv_lnx_b": nrm((L, RWKV_WIDTH), 0.01),
        "rwkv_v0": nrm((LV, RWKV_WIDTH), 0.1),
        "rwkv_v1": nrm((LV, RWKV_WIDTH, RWKV_V_RANK), RWKV_WIDTH ** -0.5),
        "rwkv_v2": nrm((LV, RWKV_V_RANK, RWKV_WIDTH), 0.1),
        "w_router": nrm((L, D, N_EXPERTS), D ** -0.5),
        "router_bias": nrm((L, N_EXPERTS), 0.01),
        "w_exp_gate": nrm((L, N_EXPERTS, D, D_EXPERT), D ** -0.5),
        "w_exp_up": nrm((L, N_EXPERTS, D, D_EXPERT), D ** -0.5),
        "w_exp_down": nrm((L, N_EXPERTS, D_EXPERT, D), D_EXPERT ** -0.5),
        "w_sh_gate": nrm((L, D, D_SHARED), D ** -0.5),
        "w_sh_up": nrm((L, D, D_SHARED), D ** -0.5),
        "w_sh_down": nrm((L, D_SHARED, D), D_SHARED ** -0.5),
    }


def reference(x, c, w_ada, b_ada, g_pre_mix, g_post_mix, g_pre_ffn, g_post_ffn, w_in, w_out,
              lam_q1, lam_k1, lam_q2, lam_k2, att_subln_g, rwkv_mu, rwkv_w0, rwkv_w2, rwkv_a0,
              rwkv_a2, rwkv_g2, rwkv_k_k, rwkv_k_a, rwkv_r_k, rwkv_lnx_w, rwkv_lnx_b, rwkv_v0,
              rwkv_v1, rwkv_v2, w_router, router_bias, w_exp_gate, w_exp_up, w_exp_down,
              w_sh_gate, w_sh_up, w_sh_down):
    B, S, D = x.shape
    cond = jax.nn.silu(c)
    v_first = None
    for i in range(DEPTH):
        mod = (cond @ w_ada[i] + b_ada[i])[:, None, :]
        sh_a, sc_a, g_a, sh_f, sc_f, g_f = jnp.split(mod, N_MOD, axis=-1)

        h = rms_norm(x, g_pre_mix[i]) * (1.0 + sc_a) + sh_a
        p = h @ w_in[i]
        q, k, v = jnp.split(p[..., :ATT_COLS], [ATT_QK_COLS, 2 * ATT_QK_COLS], axis=-1)
        lam_init = 0.8 - 0.6 * math.exp(-0.3 * i)
        lam = (jnp.exp(jnp.sum(lam_q1[i] * lam_k1[i])) - jnp.exp(jnp.sum(lam_q2[i] * lam_k2[i]))
               + lam_init).astype(jnp.float32)
        o_att = diff_attention(q.reshape(B, S, ATT_HEADS, 2, ATT_QK_DIM),
                               k.reshape(B, S, ATT_HEADS, 2, ATT_QK_DIM),
                               v.reshape(B, S, ATT_HEADS, ATT_V_DIM),
                               lam, att_subln_g[i], lam_init)
        feats = token_shift(p[..., ATT_COLS:], rwkv_mu[i])
        vres = None if i == 0 else (rwkv_v0[i - 1], rwkv_v1[i - 1], rwkv_v2[i - 1])
        o_rwkv, v_first = rwkv7_mix(feats, v_first, rwkv_w0[i], rwkv_w2[i], rwkv_a0[i],
                                    rwkv_a2[i], rwkv_g2[i], rwkv_k_k[i], rwkv_k_a[i],
                                    rwkv_r_k[i], rwkv_lnx_w[i], rwkv_lnx_b[i], vres)
        mixed = jnp.concatenate([o_att.astype(x.dtype), o_rwkv.astype(x.dtype)], axis=-1) @ w_out[i]
        x = x + g_a * rms_norm(mixed, g_post_mix[i])

        h = rms_norm(x, g_pre_ffn[i]) * (1.0 + sc_f) + sh_f
        y = moe_ffn(h.reshape(B * S, D), w_router[i], router_bias[i], w_exp_gate[i],
                    w_exp_up[i], w_exp_down[i], w_sh_gate[i], w_sh_up[i],
                    w_sh_down[i]).reshape(B, S, D)
        x = x + g_f * rms_norm(y.astype(x.dtype), g_post_ffn[i])
    return x
```

```cpp
#include <hip/hip_runtime.h>
#include <stdint.h>

typedef unsigned short bf16_t;
typedef short bf16x8 __attribute__((ext_vector_type(8)));
typedef float f32x4 __attribute__((ext_vector_type(4)));
typedef unsigned u32x4 __attribute__((ext_vector_type(4)));
typedef unsigned u32x2 __attribute__((ext_vector_type(2)));

#define T_    8192
#define D_    2048
#define S_    2048
#define NB_   4
#define NIN   6400
#define RW    1024
#define NE    64
#define CAP   8192
#define PMAX  90112
#define NTHR  256
#define LDS_BYTES 40960

struct Params {
    const float *x, *c, *w_ada, *b_ada, *g_pre_mix, *g_post_mix, *g_pre_ffn, *g_post_ffn, *w_in, *w_out;
    const float *lam_q1, *lam_k1, *lam_q2, *lam_k2, *subln_g, *mu, *w0, *w2, *a0, *a2, *g2, *k_k, *k_a, *r_k, *lnx_w, *lnx_b, *v0, *v1, *v2;
    const float *w_router, *router_bias, *w_eg, *w_eu, *w_ed, *w_sg, *w_su, *w_sd;
    float* out;
    unsigned* bar;
    float* mod;
    bf16_t* Hn;
    bf16_t* P;
    float *sr, *sw, *sk, *sv, *sa, *sb, *sy, *sg, *vfirst;
    float* bcoef;
    bf16_t* ocat;
    float* mixed;
    unsigned* counts;
    int* rowtok;
    float* rowg;
    int* tokpos;
    bf16_t* H1;
    bf16_t* Y2;
};

__device__ __forceinline__ float bf2f(unsigned short h) { return __uint_as_float(((unsigned)h) << 16); }
__device__ __forceinline__ unsigned cvt_pk_bf16(float lo, float hi) { unsigned r; asm volatile("v_cvt_pk_bf16_f32 %0, %1, %2" : "=v"(r) : "v"(lo), "v"(hi)); return r; }
__device__ __forceinline__ float wave_sum(float v) {
#pragma unroll
    for (int o = 32; o > 0; o >>= 1) v += __shfl_xor(v, o);
    return v;
}
__device__ __forceinline__ float sigmoidf_(float x) { return 1.0f / (1.0f + __expf(-x)); }
#define RL(v, j) __int_as_float(__builtin_amdgcn_readlane(__float_as_int(v), (j)))
__device__ __forceinline__ int rfl(int v) { return __builtin_amdgcn_readfirstlane(v); }

#define GT_ROWB 144
template <class ARow, class Epi>
__device__ __forceinline__ void gemm_tile(unsigned char* lds, const bf16_t* A, int lda, ARow arow, const float* bp, int ldb, int K, Epi epi) {
    const int tid = threadIdx.x, lane = tid & 63, wid = tid >> 6, wm = wid >> 1, wn = wid & 1, fr = lane & 15, fq = lane >> 4;
    unsigned char* sA = lds;
    unsigned char* sB = lds + 128 * GT_ROWB;
    const bf16_t* ap[4];
    int aoff[4];
#pragma unroll
    for (int i = 0; i < 4; ++i) { const int ch = tid + i * 256, r = ch >> 3, kc = ch & 7; ap[i] = A + (size_t)arow(r) * lda + kc * 8; aoff[i] = r * GT_ROWB + kc * 16; }
    const int bn = tid & 127, bkh = tid >> 7;
    const float* bq = bp + (size_t)(bkh * 32) * ldb;
    const int boff = bn * GT_ROWB + bkh * 64;
    f32x4 acc[4][4];
#pragma unroll
    for (int i = 0; i < 4; ++i)
#pragma unroll
        for (int j = 0; j < 4; ++j) acc[i][j] = (f32x4){0.f, 0.f, 0.f, 0.f};
    u32x4 ra[4]; float rb[32];
    const int nk = K >> 6;
#pragma unroll
    for (int i = 0; i < 4; ++i) ra[i] = *(const u32x4*)(ap[i]);
#pragma unroll
    for (int i = 0; i < 32; ++i) rb[i] = bq[(size_t)i * ldb];
    for (int kt = 0; kt < nk; ++kt) {
        __syncthreads();
#pragma unroll
        for (int i = 0; i < 4; ++i) *(u32x4*)(sA + aoff[i]) = ra[i];
#pragma unroll
        for (int g = 0; g < 4; ++g) { u32x4 w; w.x = cvt_pk_bf16(rb[g * 8 + 0], rb[g * 8 + 1]); w.y = cvt_pk_bf16(rb[g * 8 + 2], rb[g * 8 + 3]); w.z = cvt_pk_bf16(rb[g * 8 + 4], rb[g * 8 + 5]); w.w = cvt_pk_bf16(rb[g * 8 + 6], rb[g * 8 + 7]);
            *(u32x4*)(sB + boff + g * 16) = w; }
        __syncthreads();
        if (kt + 1 < nk) {
#pragma unroll
            for (int i = 0; i < 4; ++i) ra[i] = *(const u32x4*)(ap[i] + (size_t)(kt + 1) * 64);
            const float* bqq = bq + (size_t)(kt + 1) * 64 * ldb;
#pragma unroll
            for (int i = 0; i < 32; ++i) rb[i] = bqq[(size_t)i * ldb];
        }
#pragma unroll
        for (int ks = 0; ks < 2; ++ks) {
            bf16x8 af[4], bfr[4];
#pragma unroll
            for (int i = 0; i < 4; ++i) af[i] = *(const bf16x8*)(sA + (wm * 64 + i * 16 + fr) * GT_ROWB + ks * 64 + fq * 16);
#pragma unroll
            for (int j = 0; j < 4; ++j) bfr[j] = *(const bf16x8*)(sB + (wn * 64 + j * 16 + fr) * GT_ROWB + ks * 64 + fq * 16);
#pragma unroll
            for (int i = 0; i < 4; ++i)
#pragma unroll
                for (int j = 0; j < 4; ++j) acc[i][j] = __builtin_amdgcn_mfma_f32_16x16x32_bf16(bfr[j], af[i], acc[i][j], 0, 0, 0);
        }
    }
#pragma unroll
    for (int i = 0; i < 4; ++i)
#pragma unroll
        for (int j = 0; j < 4; ++j) epi(wm * 64 + i * 16 + fr, wn * 64 + j * 16 + fq * 4, acc[i][j]);
    __syncthreads();
}

__device__ void phase_adaln(const Params& p, unsigned char* lds) {
    float* cond = (float*)lds;
    float* red = cond + 4 * D_;
    const int tid = threadIdx.x, lane = tid & 63, w = tid >> 6;
    for (int i = tid; i < 4 * D_; i += NTHR) { const float v = p.c[i]; cond[i] = v / (1.0f + __expf(-v)); }
    __syncthreads();
    for (int unit = blockIdx.x; unit < 2 * 192; unit += gridDim.x) {
        const int l = unit / 192, n = (unit % 192) * 64 + lane;
        const float* W = p.w_ada + (size_t)l * D_ * 12288 + n;
        float a0 = 0.f, a1 = 0.f, a2 = 0.f, a3 = 0.f;
        const int k0 = w * 512;
#pragma unroll 8
        for (int k = k0; k < k0 + 512; ++k) { const float wv = W[(size_t)k * 12288]; a0 += cond[k] * wv; a1 += cond[D_ + k] * wv; a2 += cond[2 * D_ + k] * wv; a3 += cond[3 * D_ + k] * wv; }
        red[(w * 4 + 0) * 64 + lane] = a0; red[(w * 4 + 1) * 64 + lane] = a1; red[(w * 4 + 2) * 64 + lane] = a2; red[(w * 4 + 3) * 64 + lane] = a3;
        __syncthreads();
        {
            float s = 0.f;
#pragma unroll
            for (int ww = 0; ww < 4; ++ww) s += red[(ww * 4 + w) * 64 + lane];
            p.mod[((size_t)l * 4 + w) * 12288 + n] = s + p.b_ada[(size_t)l * 12288 + n];
        }
        __syncthreads();
    }
}

__device__ __forceinline__ void emit_hn(const f32x4 (&xv)[8], float rstd, const float* g, const float* sc, const float* sh, bf16_t* dst, int lane, float* hf) {
#pragma unroll
    for (int i = 0; i < 8; ++i) {
        const int e = i * 256 + lane * 4;
        const f32x4 gv = *(const f32x4*)(g + e), scv = *(const f32x4*)(sc + e), shv = *(const f32x4*)(sh + e);
        f32x4 h;
#pragma unroll
        for (int j = 0; j < 4; ++j) h[j] = xv[i][j] * rstd * gv[j] * (1.0f + scv[j]) + shv[j];
        u32x2 o; o.x = cvt_pk_bf16(h[0], h[1]); o.y = cvt_pk_bf16(h[2], h[3]);
        *(u32x2*)(dst + e) = o;
        if (hf) *(f32x4*)(hf + e) = h;
    }
}

__device__ void phase_prenorm0(const Params& p) {
    const int lane = threadIdx.x & 63, gw = blockIdx.x * (NTHR / 64) + (threadIdx.x >> 6), nw = gridDim.x * (NTHR / 64);
    for (int t = gw; t < T_; t += nw) {
        const int b = t / S_;
        f32x4 xv[8]; float ss = 0.f;
#pragma unroll
        for (int i = 0; i < 8; ++i) { xv[i] = *(const f32x4*)(p.x + (size_t)t * D_ + i * 256 + lane * 4); ss += xv[i][0] * xv[i][0] + xv[i][1] * xv[i][1] + xv[i][2] * xv[i][2] + xv[i][3] * xv[i][3]; }
        ss = wave_sum(ss);
        const float rstd = rsqrtf(ss * (1.0f / D_) + 1e-6f);
        const float* md = p.mod + (size_t)b * 12288;
        emit_hn(xv, rstd, p.g_pre_mix, md + 2048, md, p.Hn + (size_t)t * D_, lane, nullptr);
    }
}

__device__ void phase_gemm_in(const Params& p, int l, unsigned char* lds) {
    const float* B = p.w_in + (size_t)l * D_ * NIN;
    for (int unit = blockIdx.x; unit < 64 * 50; unit += gridDim.x) {
        const int mt = unit / 50, nt = unit % 50;
        bf16_t* Pp = p.P;
        gemm_tile(lds, p.Hn, D_, [=](int r) { return mt * 128 + r; }, B + nt * 128 + (threadIdx.x & 127), NIN, D_,
                  [=](int m, int n, f32x4 v) { u32x2 o; o.x = cvt_pk_bf16(v[0], v[1]); o.y = cvt_pk_bf16(v[2], v[3]); *(u32x2*)(Pp + (size_t)(mt * 128 + m) * NIN + nt * 128 + n) = o; });
    }
}

__device__ void phase_attn_naive(const Params& p) {
    const int lane = threadIdx.x & 63, gw = blockIdx.x * (NTHR / 64) + (threadIdx.x >> 6), nw = gridDim.x * (NTHR / 64);
    float* tmp = p.mixed;
    for (int it = gw; it < 2048; it += nw) {
        const int item = rfl(it);
        const int qb = 31 - (item >> 6), rest = item & 63, c = rest & 1, h = (rest >> 1) & 7, b = rest >> 4;
        const int q = qb * 64 + lane;
        const bf16_t* Pb = p.P + (size_t)b * S_ * NIN;
        float qv[64];
        {
            const bf16_t* qp = Pb + (size_t)q * NIN + h * 128 + c * 64;
#pragma unroll
            for (int i = 0; i < 8; ++i) { const u32x4 u = *(const u32x4*)(qp + i * 8);
#pragma unroll
                for (int j = 0; j < 4; ++j) { qv[i * 8 + j * 2] = __uint_as_float(u[j] << 16); qv[i * 8 + j * 2 + 1] = __uint_as_float(u[j] & 0xffff0000u); } }
        }
        const float scale2 = 0.125f * 1.44269504f, slope2 = exp2f(-(float)(h + 1)) * 1.44269504f;
        const int jmax = qb * 64 + 63;
        const bf16_t* kbase = Pb + 1024 + h * 128 + c * 64;
        const bf16_t* vbase = Pb + 2048 + h * 128;
        float m = -1e30f;
        for (int j = 0; j <= jmax; ++j) {
            const u32x4* kp = (const u32x4*)(kbase + (size_t)j * NIN);
            float s = 0.f;
#pragma unroll
            for (int i = 0; i < 8; ++i) { const u32x4 u = kp[i];
#pragma unroll
                for (int jj = 0; jj < 4; ++jj) { s += qv[i * 8 + jj * 2] * __uint_as_float(u[jj] << 16); s += qv[i * 8 + jj * 2 + 1] * __uint_as_float(u[jj] & 0xffff0000u); } }
            s = s * scale2 - slope2 * (float)(q - j);
            if (j <= q) m = fmaxf(m, s);
        }
        float lsum = 0.f; float acc[128];
#pragma unroll
        for (int d = 0; d < 128; ++d) acc[d] = 0.f;
        for (int j = 0; j <= jmax; ++j) {
            const u32x4* kp = (const u32x4*)(kbase + (size_t)j * NIN);
            float s = 0.f;
#pragma unroll
            for (int i = 0; i < 8; ++i) { const u32x4 u = kp[i];
#pragma unroll
                for (int jj = 0; jj < 4; ++jj) { s += qv[i * 8 + jj * 2] * __uint_as_float(u[jj] << 16); s += qv[i * 8 + jj * 2 + 1] * __uint_as_float(u[jj] & 0xffff0000u); } }
            s = s * scale2 - slope2 * (float)(q - j);
            const float pj = (j <= q) ? exp2f(s - m) : 0.f;
            lsum += pj;
            const u32x4* vp = (const u32x4*)(vbase + (size_t)j * NIN);
#pragma unroll
            for (int i = 0; i < 16; ++i) { const u32x4 u = vp[i];
#pragma unroll
                for (int jj = 0; jj < 4; ++jj) { acc[i * 8 + jj * 2] += pj * __uint_as_float(u[jj] << 16); acc[i * 8 + jj * 2 + 1] += pj * __uint_as_float(u[jj] & 0xffff0000u); } }
        }
        const float inv = 1.0f / lsum;
        float* op = tmp + (size_t)(b * S_ + q) * D_ + h * 256 + c * 128;
#pragma unroll
        for (int d = 0; d < 128; d += 4) *(f32x4*)(op + d) = (f32x4){acc[d] * inv, acc[d + 1] * inv, acc[d + 2] * inv, acc[d + 3] * inv};
    }
}

__device__ __forceinline__ float shifted(const bf16_t* P, int t, int col, float mu) {
    const float cur = bf2f(P[(size_t)t * NIN + 3072 + col]);
    const float prev = (t % S_) ? bf2f(P[(size_t)(t - 1) * NIN + 3072 + col]) : 0.f;
    return cur + (prev - cur) * mu;
}
#define PREP_RB 4
__device__ void phase_rwkv_prep(const Params& p, int l, unsigned char* lds) {
    float* lowr = (float*)lds;
    float* vrow = lowr + PREP_RB * 256;
    float* red = vrow + PREP_RB * 1024;
    float* vv = red + PREP_RB * 256;
    const int tid = threadIdx.x, lane = tid & 63;
    const float* mu = p.mu + (size_t)l * 3328;
    const float *w0 = p.w0 + l * RW, *w2 = p.w2 + (size_t)l * 64 * RW, *a0 = p.a0 + l * RW, *a2 = p.a2 + (size_t)l * 64 * RW, *g2 = p.g2 + (size_t)l * 128 * RW;
    const float *k_k = p.k_k + l * RW, *k_a = p.k_a + l * RW, *r_k = p.r_k + l * RW;
    for (int unit = blockIdx.x; unit < T_ / PREP_RB; unit += gridDim.x) {
        const int t0 = unit * PREP_RB;
        for (int idx = tid; idx < PREP_RB * 256; idx += NTHR) {
            const int r = idx >> 8, m = idx & 255;
            const float f = shifted(p.P, t0 + r, 3072 + m, mu[3072 + m]);
            lowr[idx] = (m < 64) ? tanhf(f) : (m < 128) ? f : sigmoidf_(f);
        }
        if (l > 0) {
            for (int idx = tid; idx < PREP_RB * 1024; idx += NTHR) { const int r = idx >> 10, cc = idx & 1023; vrow[idx] = shifted(p.P, t0 + r, 2048 + cc, mu[2048 + cc]); }
        }
        __syncthreads();
        if (l > 0) {
            const int j = tid & 31, part = tid >> 5;
            const float* v1 = p.v1;
#pragma unroll
            for (int r = 0; r < PREP_RB; ++r) {
                float s = 0.f;
                for (int cc = part * 128; cc < part * 128 + 128; ++cc) s += vrow[r * 1024 + cc] * v1[cc * 32 + j];
                red[(r * 8 + part) * 32 + j] = s;
            }
            __syncthreads();
            if (tid < PREP_RB * 32) { const int r = tid >> 5, jj = tid & 31; float s = 0.f;
#pragma unroll
                for (int pp = 0; pp < 8; ++pp) s += red[(r * 8 + pp) * 32 + jj];
                vv[r * 32 + jj] = s; }
            __syncthreads();
        }
#pragma unroll 1
        for (int i = 0; i < 4; ++i) {
            const int cc = tid + i * 256, h = cc >> 6;
            float wa[PREP_RB], aa[PREP_RB], ga[PREP_RB];
#pragma unroll
            for (int r = 0; r < PREP_RB; ++r) { wa[r] = 0.f; aa[r] = 0.f; ga[r] = 0.f; }
            for (int m = 0; m < 64; ++m) {
                const float w2v = w2[m * RW + cc], a2v = a2[m * RW + cc], g2a = g2[m * RW + cc], g2b = g2[(64 + m) * RW + cc];
#pragma unroll
                for (int r = 0; r < PREP_RB; ++r) { wa[r] += lowr[r * 256 + m] * w2v; aa[r] += lowr[r * 256 + 64 + m] * a2v; ga[r] += lowr[r * 256 + 128 + m] * g2a + lowr[r * 256 + 192 + m] * g2b; }
            }
#pragma unroll
            for (int r = 0; r < PREP_RB; ++r) {
                const int t = t0 + r;
                const float rr = shifted(p.P, t, cc, mu[cc]), kx = shifted(p.P, t, 1024 + cc, mu[1024 + cc]);
                float vx = shifted(p.P, t, 2048 + cc, mu[2048 + cc]);
                const float wv = w0[cc] + wa[r];
                const float decay = __expf(-sigmoidf_(wv) * 0.60653066f);
                const float a = sigmoidf_(a0[cc] + aa[r]);
                const size_t o = (size_t)t * RW + cc;
                if (l == 0) p.vfirst[o] = vx;
                else {
                    float s = p.v0[cc];
#pragma unroll
                    for (int jj = 0; jj < 32; ++jj) s += vv[r * 32 + jj] * p.v2[jj * RW + cc];
                    vx = vx + (p.vfirst[o] - vx) * sigmoidf_(s);
                }
                const float kk = kx * k_k[cc];
                const float ss = wave_sum(kk * kk);
                const float kkn = kk / fmaxf(sqrtf(ss), 1e-12f);
                const float kh = kx * (1.0f + (a - 1.0f) * k_a[cc]);
                const float bc = wave_sum(rr * kh * r_k[cc]);
                if (lane == 0) p.bcoef[(size_t)t * 16 + h] = bc;
                p.sr[o] = rr; p.sw[o] = decay; p.sk[o] = kh; p.sv[o] = vx; p.sa[o] = -kkn; p.sb[o] = kkn * a; p.sg[o] = ga[r];
            }
        }
        __syncthreads();
    }
}

__device__ void phase_scan_naive(const Params& p) {
    const int lane = threadIdx.x & 63, gw = (threadIdx.x >> 6) * gridDim.x + blockIdx.x, nw = gridDim.x * (NTHR / 64);
    for (int it = gw; it < 64; it += nw) {
        const int item = rfl(it), b = item >> 4, h = item & 15;
        float st[64];
#pragma unroll
        for (int j = 0; j < 64; ++j) st[j] = 0.f;
        size_t base = (size_t)b * S_ * RW + h * 64 + lane;
        for (int t = 0; t < S_; ++t, base += RW) {
            const float wv = p.sw[base], av = p.sa[base], bv = p.sb[base], kv = p.sk[base], rv = p.sr[base], vi = p.sv[base];
            float sa = 0.f;
#pragma unroll
            for (int j = 0; j < 64; ++j) sa += st[j] * RL(av, j);
            float y = 0.f;
#pragma unroll
            for (int j = 0; j < 64; ++j) { st[j] = st[j] * RL(wv, j) + sa * RL(bv, j) + vi * RL(kv, j); y += st[j] * RL(rv, j); }
            p.sy[base] = y;
        }
    }
}

__device__ void phase_post(const Params& p, int l) {
    const int tid = threadIdx.x, lane = tid & 63, w = tid >> 6;
    const float lam_init = (l == 0) ? 0.2f : 0.35550907f;
    float lam;
    { const float s1 = wave_sum(p.lam_q1[l * 64 + lane] * p.lam_k1[l * 64 + lane]), s2 = wave_sum(p.lam_q2[l * 64 + lane] * p.lam_k2[l * 64 + lane]); lam = __expf(s1) - __expf(s2) + lam_init; }
    const float* tmp = p.mixed;
    for (int t = blockIdx.x; t < T_; t += gridDim.x) {
        for (int h = w; h < 8; h += NTHR / 64) {
            const float* o0 = tmp + (size_t)t * D_ + h * 256 + lane * 2;
            const float x0 = o0[0] - lam * o0[128], x1 = o0[1] - lam * o0[129];
            const float ss = wave_sum(x0 * x0 + x1 * x1);
            const float rstd = rsqrtf(ss * (1.0f / 128.0f) + 1e-5f) * (1.0f - lam_init);
            const float* sg = p.subln_g + l * 128 + lane * 2;
            *(unsigned*)(p.ocat + (size_t)t * D_ + h * 128 + lane * 2) = cvt_pk_bf16(x0 * rstd * sg[0], x1 * rstd * sg[1]);
        }
        for (int h = w; h < 16; h += NTHR / 64) {
            const int cc = h * 64 + lane; const size_t o = (size_t)t * RW + cc;
            const float y = p.sy[o];
            const float mean = wave_sum(y) * (1.0f / 64.0f);
            const float d = y - mean;
            const float var = wave_sum(d * d) * (1.0f / 64.0f);
            const float yn = d * rsqrtf(var + 64e-5f) * p.lnx_w[l * RW + cc] + p.lnx_b[l * RW + cc];
            const float val = (yn + p.bcoef[(size_t)t * 16 + h] * p.sv[o]) * p.sg[o];
            const float nb = __shfl_down(val, 1);
            if ((lane & 1) == 0) *(unsigned*)(p.ocat + (size_t)t * D_ + 1024 + cc) = cvt_pk_bf16(val, nb);
        }
    }
}

__device__ void phase_gemm_out(const Params& p, int l, unsigned char* lds) {
    const float* B = p.w_out + (size_t)l * D_ * D_;
    for (int unit = blockIdx.x; unit < 64 * 16; unit += gridDim.x) {
        const int mt = unit >> 4, nt = unit & 15;
        float* C = p.mixed;
        gemm_tile(lds, p.ocat, D_, [=](int r) { return mt * 128 + r; }, B + nt * 128 + (threadIdx.x & 127), D_, D_,
                  [=](int m, int n, f32x4 v) { *(f32x4*)(C + (size_t)(mt * 128 + m) * D_ + nt * 128 + n) = v; });
    }
}

__device__ void phase_res1_router(const Params& p, int l, unsigned char* lds) {
    const int tid = threadIdx.x, lane = tid & 63, w = tid >> 6, gw = blockIdx.x * (NTHR / 64) + w, nw = gridDim.x * (NTHR / 64);
    float* hrow = (float*)lds + w * D_;
    const float* xin = (l == 0) ? p.x : p.out;
    const float* Wr = p.w_router + (size_t)l * D_ * NE;
    for (int t = gw; t < T_; t += nw) {
        const int b = t / S_;
        const float* md = p.mod + ((size_t)l * 4 + b) * 12288;
        f32x4 xv[8], mv[8]; float ss = 0.f;
#pragma unroll
        for (int i = 0; i < 8; ++i) { const int e = i * 256 + lane * 4; xv[i] = *(const f32x4*)(xin + (size_t)t * D_ + e); mv[i] = *(const f32x4*)(p.mixed + (size_t)t * D_ + e);
            ss += mv[i][0] * mv[i][0] + mv[i][1] * mv[i][1] + mv[i][2] * mv[i][2] + mv[i][3] * mv[i][3]; }
        ss = wave_sum(ss);
        const float rm = rsqrtf(ss * (1.0f / D_) + 1e-6f);
        float s2 = 0.f;
#pragma unroll
        for (int i = 0; i < 8; ++i) { const int e = i * 256 + lane * 4; const f32x4 gp = *(const f32x4*)(p.g_post_mix + l * D_ + e), ga = *(const f32x4*)(md + 4096 + e);
#pragma unroll
            for (int j = 0; j < 4; ++j) { xv[i][j] += ga[j] * (mv[i][j] * rm * gp[j]); s2 += xv[i][j] * xv[i][j]; }
            *(f32x4*)(p.out + (size_t)t * D_ + e) = xv[i]; }
        s2 = wave_sum(s2);
        const float rx = rsqrtf(s2 * (1.0f / D_) + 1e-6f);
        emit_hn(xv, rx, p.g_pre_ffn + l * D_, md + 8192, md + 6144, p.Hn + (size_t)t * D_, lane, hrow);
        __builtin_amdgcn_s_waitcnt(0);
        __builtin_amdgcn_wave_barrier();
        float lg = 0.f;
#pragma unroll 8
        for (int k = 0; k < D_; ++k) lg += hrow[k] * Wr[(size_t)k * NE + lane];
        const float score = sigmoidf_(lg), biased = score + p.router_bias[l * NE + lane];
        int rk = 0;
#pragma unroll
        for (int i = 0; i < 8; ++i) { const int src = (lane & ~7) + i; const float o = __shfl(biased, src); rk += (o > biased || (o == biased && src < lane)) ? 1 : 0; }
        float gs = (rk < 2) ? biased : 0.f;
        gs += __shfl_xor(gs, 1); gs += __shfl_xor(gs, 2); gs += __shfl_xor(gs, 4);
        int grk = 0; const int g = lane >> 3;
#pragma unroll
        for (int i = 0; i < 8; ++i) { const float o = __shfl(gs, i * 8); grk += (o > gs || (o == gs && i < g)) ? 1 : 0; }
        const bool gsel = grk < 4;
        const float mvv = gsel ? biased : -INFINITY;
        int erk = 0;
#pragma unroll
        for (int i = 0; i < 64; ++i) { const float o = __shfl(mvv, i); erk += (o > mvv || (o == mvv && i < lane)) ? 1 : 0; }
        const bool sel = gsel && erk < 8;
        const float gsum = wave_sum(sel ? score : 0.f);
        if (sel) {
            const float gate = score / gsum * 2.5f;
            const unsigned slot = atomicAdd(p.counts + l * NE + lane, 1u);
            p.rowtok[lane * CAP + slot] = t; p.rowg[lane * CAP + slot] = gate; p.tokpos[(size_t)t * 8 + erk] = lane * CAP + (int)slot;
        }
        __builtin_amdgcn_wave_barrier();
    }
}

__device__ __forceinline__ void build_tables(const Params& p, int l, int* tab) {
    if (threadIdx.x == 0) {
        int pb = 0, tb = 0;
        for (int e = 0; e <= NE; ++e) { const int c = (e < NE) ? (int)__hip_atomic_load(p.counts + l * NE + e, __ATOMIC_RELAXED, __HIP_MEMORY_SCOPE_AGENT) : T_;
            tab[e] = c; tab[80 + e] = pb; tab[160 + e] = tb; pb += (c + 255) & ~255; tb += (c + 127) >> 7; }
        tab[80 + NE + 1] = pb; tab[160 + NE + 1] = tb;
    }
    __syncthreads();
}
__device__ __forceinline__ int find_expert(const int* tab, int rt) { int e = 0; while (e < NE && rt >= tab[160 + e + 1]) ++e; return e; }

__device__ void phase_moe_gu(const Params& p, int l, unsigned char* lds) {
    int* tab = (int*)(lds + 2 * 128 * GT_ROWB);
    build_tables(p, l, tab);
    const int ntile = tab[160 + NE + 1];
    for (int unit = blockIdx.x; unit < ntile * 8; unit += gridDim.x) {
        const int rtg = unit >> 3, ct = unit & 7, e = find_expert(tab, rtg), rt = rtg - tab[160 + e], cnt = tab[e], pb = tab[80 + e];
        const float* Bg = (e < NE) ? p.w_eg + ((size_t)(l * NE + e) * D_) * 512 : p.w_sg + (size_t)l * D_ * 512;
        const float* Bu = (e < NE) ? p.w_eu + ((size_t)(l * NE + e) * D_) * 512 : p.w_su + (size_t)l * D_ * 512;
        const int n = threadIdx.x & 127;
        const float* bp = ((n & 1) ? Bu : Bg) + ct * 64 + (n >> 1);
        const int* rtok = p.rowtok + e * CAP;
        bf16_t* H1 = p.H1;
        gemm_tile(lds, p.Hn, D_, [=](int r) { const int slot = rt * 128 + r; return (slot < cnt) ? ((e < NE) ? rtok[slot] : slot) : 0; }, bp, 512, D_,
                  [=](int m, int nn, f32x4 v) { const float h0 = v[0] / (1.0f + __expf(-v[0])) * v[1], h1 = v[2] / (1.0f + __expf(-v[2])) * v[3];
                      *(unsigned*)(H1 + (size_t)(pb + rt * 128 + m) * 512 + ct * 64 + (nn >> 1)) = cvt_pk_bf16(h0, h1); });
    }
}

__device__ void phase_moe_down(const Params& p, int l, unsigned char* lds) {
    int* tab = (int*)(lds + 2 * 128 * GT_ROWB);
    build_tables(p, l, tab);
    const int ntile = tab[160 + NE + 1];
    for (int unit = blockIdx.x; unit < ntile * 16; unit += gridDim.x) {
        const int rtg = unit >> 4, ct = unit & 15, e = find_expert(tab, rtg), rt = rtg - tab[160 + e], cnt = tab[e], pb = tab[80 + e];
        const float* Bd = (e < NE) ? p.w_ed + ((size_t)(l * NE + e) * 512) * D_ : p.w_sd + (size_t)l * 512 * D_;
        const float* rg = p.rowg + e * CAP;
        bf16_t* Y2 = p.Y2;
        gemm_tile(lds, p.H1, 512, [=](int r) { return pb + rt * 128 + r; }, Bd + ct * 128 + (threadIdx.x & 127), D_, 512,
                  [=](int m, int nn, f32x4 v) { const int slot = rt * 128 + m; const float g = (slot < cnt) ? ((e < NE) ? rg[slot] : 1.0f) : 0.f;
                      u32x2 o; o.x = cvt_pk_bf16(v[0] * g, v[1] * g); o.y = cvt_pk_bf16(v[2] * g, v[3] * g);
                      *(u32x2*)(Y2 + (size_t)(pb + slot) * D_ + ct * 128 + nn) = o; });
    }
}

__device__ void phase_combine(const Params& p, int l, unsigned char* lds) {
    int* tab = (int*)lds;
    build_tables(p, l, tab);
    const int lane = threadIdx.x & 63, gw = blockIdx.x * (NTHR / 64) + (threadIdx.x >> 6), nw = gridDim.x * (NTHR / 64);
    for (int t = gw; t < T_; t += nw) {
        const int b = t / S_;
        const float* md = p.mod + ((size_t)l * 4 + b) * 12288;
        f32x4 yv[8];
#pragma unroll
        for (int i = 0; i < 8; ++i) yv[i] = (f32x4){0.f, 0.f, 0.f, 0.f};
        for (int k = 0; k < 9; ++k) {
            int row;
            if (k < 8) { const int tp = p.tokpos[(size_t)t * 8 + k]; row = tab[80 + (tp >> 13)] + (tp & (CAP - 1)); } else row = tab[80 + NE] + t;
            const bf16_t* yr = p.Y2 + (size_t)row * D_;
#pragma unroll
            for (int i = 0; i < 8; ++i) { const u32x2 u = *(const u32x2*)(yr + i * 256 + lane * 4);
                yv[i][0] += __uint_as_float(u.x << 16); yv[i][1] += __uint_as_float(u.x & 0xffff0000u); yv[i][2] += __uint_as_float(u.y << 16); yv[i][3] += __uint_as_float(u.y & 0xffff0000u); }
        }
        float ss = 0.f;
#pragma unroll
        for (int i = 0; i < 8; ++i) ss += yv[i][0] * yv[i][0] + yv[i][1] * yv[i][1] + yv[i][2] * yv[i][2] + yv[i][3] * yv[i][3];
        ss = wave_sum(ss);
        const float ry = rsqrtf(ss * (1.0f / D_) + 1e-6f);
        f32x4 xv[8]; float s2 = 0.f;
#pragma unroll
        for (int i = 0; i < 8; ++i) { const int e = i * 256 + lane * 4; xv[i] = *(const f32x4*)(p.out + (size_t)t * D_ + e);
            const f32x4 gp = *(const f32x4*)(p.g_post_ffn + l * D_ + e), gf = *(const f32x4*)(md + 10240 + e);
#pragma unroll
            for (int j = 0; j < 4; ++j) { xv[i][j] += gf[j] * (yv[i][j] * ry * gp[j]); s2 += xv[i][j] * xv[i][j]; }
            *(f32x4*)(p.out + (size_t)t * D_ + e) = xv[i]; }
        if (l + 1 < 2) {
            s2 = wave_sum(s2);
            const float rx = rsqrtf(s2 * (1.0f / D_) + 1e-6f);
            const float* md1 = p.mod + ((size_t)(l + 1) * 4 + b) * 12288;
            emit_hn(xv, rx, p.g_pre_mix + (l + 1) * D_, md1 + 2048, md1, p.Hn + (size_t)t * D_, lane, nullptr);
        }
    }
}

template <int PH> __global__ __launch_bounds__(NTHR) void k_phase(Params p, int l) {
    extern __shared__ __attribute__((aligned(16))) unsigned char lds[];
    if (PH == 0) phase_adaln(p, lds);
    if (PH == 1) phase_prenorm0(p);
    if (PH == 2) phase_gemm_in(p, l, lds);
    if (PH == 3) phase_attn_naive(p);
    if (PH == 4) phase_rwkv_prep(p, l, lds);
    if (PH == 5) phase_scan_naive(p);
    if (PH == 6) phase_post(p, l);
    if (PH == 7) phase_gemm_out(p, l, lds);
    if (PH == 8) phase_res1_router(p, l, lds);
    if (PH == 9) phase_moe_gu(p, l, lds);
    if (PH == 10) phase_moe_down(p, l, lds);
    if (PH == 11) phase_combine(p, l, lds);
}

extern "C" void kernel_launch(void* const* d_in, const int* in_sizes, int n_in, void* d_out, int out_size, void* d_ws, size_t ws_size, hipStream_t stream) {
    Params p{};
    const float* const* in = (const float* const*)d_in;
    p.x = in[0]; p.c = in[1]; p.w_ada = in[2]; p.b_ada = in[3]; p.g_pre_mix = in[4]; p.g_post_mix = in[5]; p.g_pre_ffn = in[6]; p.g_post_ffn = in[7]; p.w_in = in[8]; p.w_out = in[9];
    p.lam_q1 = in[10]; p.lam_k1 = in[11]; p.lam_q2 = in[12]; p.lam_k2 = in[13]; p.subln_g = in[14]; p.mu = in[15]; p.w0 = in[16]; p.w2 = in[17]; p.a0 = in[18]; p.a2 = in[19]; p.g2 = in[20];
    p.k_k = in[21]; p.k_a = in[22]; p.r_k = in[23]; p.lnx_w = in[24]; p.lnx_b = in[25]; p.v0 = in[26]; p.v1 = in[27]; p.v2 = in[28];
    p.w_router = in[29]; p.router_bias = in[30]; p.w_eg = in[31]; p.w_eu = in[32]; p.w_ed = in[33]; p.w_sg = in[34]; p.w_su = in[35]; p.w_sd = in[36];
    p.out = (float*)d_out;
    unsigned char* ws = (unsigned char*)d_ws; size_t off = 0;
    auto take = [&](size_t bytes) { void* r = ws + off; off += (bytes + 255) & ~(size_t)255; return r; };
    p.bar = (unsigned*)take(16384);
    p.counts = (unsigned*)take(2 * NE * 4);
    p.mod = (float*)take((size_t)2 * 4 * 12288 * 4);
    p.Hn = (bf16_t*)take((size_t)T_ * D_ * 2);
    p.P = (bf16_t*)take((size_t)T_ * NIN * 2);
    p.sr = (float*)take((size_t)T_ * RW * 4); p.sw = (float*)take((size_t)T_ * RW * 4); p.sk = (float*)take((size_t)T_ * RW * 4); p.sv = (float*)take((size_t)T_ * RW * 4);
    p.sa = (float*)take((size_t)T_ * RW * 4); p.sb = (float*)take((size_t)T_ * RW * 4); p.sy = (float*)take((size_t)T_ * RW * 4); p.sg = (float*)take((size_t)T_ * RW * 4);
    p.vfirst = (float*)take((size_t)T_ * RW * 4);
    p.bcoef = (float*)take((size_t)T_ * 16 * 4);
    p.ocat = (bf16_t*)take((size_t)T_ * D_ * 2);
    p.mixed = (float*)take((size_t)T_ * D_ * 4);
    p.rowtok = (int*)take((size_t)NE * CAP * 4);
    p.rowg = (float*)take((size_t)NE * CAP * 4);
    p.tokpos = (int*)take((size_t)T_ * 8 * 4);
    p.H1 = (bf16_t*)take((size_t)PMAX * 512 * 2);
    p.Y2 = (bf16_t*)take((size_t)PMAX * D_ * 2);
    hipMemsetAsync(p.bar, 0, 16384 + 2 * NE * 4 + 256, stream);
    const int G = 1024;
    k_phase<0><<<384, NTHR, LDS_BYTES, stream>>>(p, 0);
    k_phase<1><<<G, NTHR, LDS_BYTES, stream>>>(p, 0);
    for (int l = 0; l < 2; ++l) {
        k_phase<2><<<G, NTHR, LDS_BYTES, stream>>>(p, l);
        k_phase<3><<<512, NTHR, LDS_BYTES, stream>>>(p, l);
        k_phase<4><<<G, NTHR, LDS_BYTES, stream>>>(p, l);
        k_phase<5><<<64, NTHR, LDS_BYTES, stream>>>(p, l);
        k_phase<6><<<G, NTHR, LDS_BYTES, stream>>>(p, l);
        k_phase<7><<<G, NTHR, LDS_BYTES, stream>>>(p, l);
        k_phase<8><<<G, NTHR, LDS_BYTES, stream>>>(p, l);
        k_phase<9><<<G, NTHR, LDS_BYTES, stream>>>(p, l);
        k_phase<10><<<G, NTHR, LDS_BYTES, stream>>>(p, l);
        k_phase<11><<<G, NTHR, LDS_BYTES, stream>>>(p, l);
    }
}
```

```cpp
#include <hip/hip_runtime.h>
#include <stdint.h>

typedef unsigned short bf16_t;
typedef short bf16x8 __attribute__((ext_vector_type(8)));
typedef float f32x4 __attribute__((ext_vector_type(4)));
typedef unsigned u32x4 __attribute__((ext_vector_type(4)));
typedef unsigned u32x2 __attribute__((ext_vector_type(2)));

#define T_    8192
#define D_    2048
#define S_    2048
#define NB_   4
#define NIN   6400
#define RW    1024
#define NE    64
#define CAP   8192
#define PMAX  90112
#define NTHR  512
#define NW_   (NTHR / 64)
#define TAB_OFF 131072
#define LDS_BYTES (131072 + 1024)

struct Params {
    const float *x, *c, *w_ada, *b_ada, *g_pre_mix, *g_post_mix, *g_pre_ffn, *g_post_ffn, *w_in, *w_out;
    const float *lam_q1, *lam_k1, *lam_q2, *lam_k2, *subln_g, *mu, *w0, *w2, *a0, *a2, *g2, *k_k, *k_a, *r_k, *lnx_w, *lnx_b, *v0, *v1, *v2;
    const float *w_router, *router_bias, *w_eg, *w_eu, *w_ed, *w_sg, *w_su, *w_sd;
    float* out;
    unsigned* bar;
    float* mod;
    bf16_t* Hn;
    bf16_t* P;
    float *sr, *sw, *sk, *sv, *sa, *sb, *sy, *sg, *vfirst;
    float* bcoef;
    bf16_t* ocat;
    float* mixed;
    unsigned* counts;
    int* rowtok;
    float* rowg;
    int* tokpos;
    bf16_t* H1;
    bf16_t* Y2;
    bf16_t* Vt;
    bf16_t *WinT, *WoutT, *WguT, *WdT;
};

__device__ __forceinline__ float bf2f(unsigned short h) { return __uint_as_float(((unsigned)h) << 16); }
__device__ __forceinline__ unsigned cvt_pk_bf16(float lo, float hi) { unsigned r; asm volatile("v_cvt_pk_bf16_f32 %0, %1, %2" : "=v"(r) : "v"(lo), "v"(hi)); return r; }
__device__ __forceinline__ float wave_sum(float v) {
#pragma unroll
    for (int o = 32; o > 0; o >>= 1) v += __shfl_xor(v, o);
    return v;
}
__device__ __forceinline__ float sigmoidf_(float x) { return 1.0f / (1.0f + __expf(-x)); }
#define RL(v, j) __int_as_float(__builtin_amdgcn_readlane(__float_as_int(v), (j)))
__device__ __forceinline__ int launder0() { int z = 0; asm volatile("" : "+s"(z)); return z; }
__device__ __forceinline__ int tid_() { int z = 0; asm volatile("" : "+v"(z)); return (int)threadIdx.x + z; }
__device__ __forceinline__ int bid_() { return (int)blockIdx.x + launder0(); }
__device__ __forceinline__ int nblk_() { return (int)gridDim.x + launder0(); }
__device__ __forceinline__ int rfl(int v) { return __builtin_amdgcn_readfirstlane(v); }


#define XB_TMO      128
#define XB_XCNT(j)  (256  + 64 * (j))
#define XB_XSUB(j)  (1280 + 64 * (j))
#define XB_XGEN(j)  (2304 + 64 * (j))
#define XB_TOP      3328
#define XB_TOPGEN   3392
#define XCD_BAR_WORDS 3456
#define XB_SPIN_CAP (1u << 18)
#define LAS __attribute__((address_space(3)))
__device__ __forceinline__ unsigned xb_ld(unsigned* p)              { return __hip_atomic_load(p, __ATOMIC_RELAXED, __HIP_MEMORY_SCOPE_AGENT); }
__device__ __forceinline__ unsigned xb_add(unsigned* p, unsigned v) { return __hip_atomic_fetch_add(p, v, __ATOMIC_RELAXED, __HIP_MEMORY_SCOPE_AGENT); }
__device__ __forceinline__ unsigned xb_xcc_id() { return (unsigned)__builtin_amdgcn_s_getreg((3 << 11) | 20) & 0xFu; }
#define XB_SPIN(cond, bar) do { unsigned _sp = 0; while (cond) { __builtin_amdgcn_s_sleep(1); \
    if ((++_sp & 255u) == 0u) { if (xb_ld(&(bar)[XB_TMO])) break; if (_sp > XB_SPIN_CAP) { atomicAdd(&(bar)[XB_TMO], 1u); break; } } } } while (0)
struct XcdBarrier { unsigned* bar; unsigned x; volatile LAS unsigned* st; };
__device__ __forceinline__ XcdBarrier xcd_barrier_post(unsigned* bar, volatile LAS unsigned* st) {
    XcdBarrier b; b.bar = bar; b.x = xb_xcc_id(); b.st = st;
    if (threadIdx.x == 0) (void)xb_add(&bar[XB_XCNT(b.x)], 1u);
    return b;
}
__device__ __forceinline__ void xcd_barrier_complete(unsigned* bar, unsigned x, unsigned& nloc, unsigned& nx) {
    const unsigned G = gridDim.x * gridDim.y * gridDim.z;
    unsigned sum, cnt, mine, sp = 0u;
    for (;;) {
        sum = 0u; cnt = 0u; mine = 0u;
#pragma unroll
        for (unsigned j = 0; j < 16; ++j) { const unsigned c = xb_ld(&bar[XB_XCNT(j)]); sum += c; cnt += (c > 0u) ? 1u : 0u; mine = (j == x) ? c : mine; }
        if (sum == G) break;
        __builtin_amdgcn_s_sleep(1);
        if ((++sp & 255u) == 0u) { if (xb_ld(&bar[XB_TMO])) break; if (sp > XB_SPIN_CAP) { atomicAdd(&bar[XB_TMO], 1u); break; } }
    }
    nloc = mine > 0u ? mine : 1u; nx = cnt > 0u ? cnt : 1u;
}
__device__ __forceinline__ void xcd_barrier(const XcdBarrier& b) {
    asm volatile("s_waitcnt vmcnt(0)" ::: "memory");
    __syncthreads();
    if (threadIdx.x == 0) {
        unsigned* bar = b.bar;
        __builtin_amdgcn_s_waitcnt(0);
        unsigned nloc = b.st[0], nx = b.st[1];
        if (nloc == 0u) { xcd_barrier_complete(bar, b.x, nloc, nx); b.st[0] = nloc; b.st[1] = nx; }
        const unsigned old = xb_add(&bar[XB_XSUB(b.x)], 1u);
        const unsigned gen = old / nloc;
        if (old + 1u == (gen + 1u) * nloc) {
            __builtin_amdgcn_fence(__ATOMIC_RELEASE, "agent");
            asm volatile("s_waitcnt vmcnt(0)" ::: "memory");
            const unsigned og = xb_add(&bar[XB_TOP], 1u);
            const unsigned tg = og / nx;
            if (og + 1u == (tg + 1u) * nx) xb_add(&bar[XB_TOPGEN], 1u);
            else XB_SPIN(xb_ld(&bar[XB_TOPGEN]) == tg, bar);
            __builtin_amdgcn_fence(__ATOMIC_ACQUIRE, "agent");
            xb_add(&bar[XB_XGEN(b.x)], 1u);
            asm volatile("s_waitcnt vmcnt(0)" ::: "memory");
        } else {
            XB_SPIN(xb_ld(&bar[XB_XGEN(b.x)]) == gen, bar);
            __builtin_amdgcn_fence(__ATOMIC_ACQUIRE, "agent");
            asm volatile("s_waitcnt vmcnt(0)" ::: "memory");
        }
    }
    __syncthreads();
}

#define GT_ROWB 144
template <class ARow, class Epi>
__device__ __forceinline__ void gemm_tile(unsigned char* lds, const bf16_t* A, int lda, ARow arow, const float* bp, int ldb, int K, Epi epi) {
    const int tid = tid_(), lane = tid & 63, wid = tid >> 6, wm = wid >> 1, wn = wid & 1, fr = lane & 15, fq = lane >> 4;
    if (tid >= 256) { for (int i = 0; i < 2 * (K >> 6) + 1; ++i) __syncthreads(); return; }
    unsigned char* sA = lds;
    unsigned char* sB = lds + 128 * GT_ROWB;
    const bf16_t* ap[4];
    int aoff[4];
#pragma unroll
    for (int i = 0; i < 4; ++i) { const int ch = tid + i * 256, r = ch >> 3, kc = ch & 7; ap[i] = A + (size_t)arow(r) * lda + kc * 8; aoff[i] = r * GT_ROWB + kc * 16; }
    const int bn = tid & 127, bkh = tid >> 7;
    const float* bq = bp + (size_t)(bkh * 32) * ldb;
    const int boff = bn * GT_ROWB + bkh * 64;
    f32x4 acc[4][4];
#pragma unroll
    for (int i = 0; i < 4; ++i)
#pragma unroll
        for (int j = 0; j < 4; ++j) acc[i][j] = (f32x4){0.f, 0.f, 0.f, 0.f};
    u32x4 ra[4]; float rb[32];
    const int nk = K >> 6;
#pragma unroll
    for (int i = 0; i < 4; ++i) ra[i] = *(const u32x4*)(ap[i]);
#pragma unroll
    for (int i = 0; i < 32; ++i) rb[i] = bq[(size_t)i * ldb];
    for (int kt = 0; kt < nk; ++kt) {
        __syncthreads();
#pragma unroll
        for (int i = 0; i < 4; ++i) *(u32x4*)(sA + aoff[i]) = ra[i];
#pragma unroll
        for (int g = 0; g < 4; ++g) { u32x4 w; w.x = cvt_pk_bf16(rb[g * 8 + 0], rb[g * 8 + 1]); w.y = cvt_pk_bf16(rb[g * 8 + 2], rb[g * 8 + 3]); w.z = cvt_pk_bf16(rb[g * 8 + 4], rb[g * 8 + 5]); w.w = cvt_pk_bf16(rb[g * 8 + 6], rb[g * 8 + 7]);
            *(u32x4*)(sB + boff + g * 16) = w; }
        __syncthreads();
        if (kt + 1 < nk) {
#pragma unroll
            for (int i = 0; i < 4; ++i) ra[i] = *(const u32x4*)(ap[i] + (size_t)(kt + 1) * 64);
            const float* bqq = bq + (size_t)(kt + 1) * 64 * ldb;
#pragma unroll
            for (int i = 0; i < 32; ++i) rb[i] = bqq[(size_t)i * ldb];
        }
#pragma unroll
        for (int ks = 0; ks < 2; ++ks) {
            bf16x8 af[4], bfr[4];
#pragma unroll
            for (int i = 0; i < 4; ++i) af[i] = *(const bf16x8*)(sA + (wm * 64 + i * 16 + fr) * GT_ROWB + ks * 64 + fq * 16);
#pragma unroll
            for (int j = 0; j < 4; ++j) bfr[j] = *(const bf16x8*)(sB + (wn * 64 + j * 16 + fr) * GT_ROWB + ks * 64 + fq * 16);
#pragma unroll
            for (int i = 0; i < 4; ++i)
#pragma unroll
                for (int j = 0; j < 4; ++j) acc[i][j] = __builtin_amdgcn_mfma_f32_16x16x32_bf16(bfr[j], af[i], acc[i][j], 0, 0, 0);
        }
    }
#pragma unroll
    for (int i = 0; i < 4; ++i)
#pragma unroll
        for (int j = 0; j < 4; ++j) epi(wm * 64 + i * 16 + fr, wn * 64 + j * 16 + fq * 4, acc[i][j]);
    __syncthreads();
}

namespace gp {
constexpr int BM = 256, BK = 64, HALF = 128, HTB = HALF * BK * 2, STAGE_BYTES = 8 * HTB;
__device__ __forceinline__ int lds_byte(int r, int c) { const int st = (r >> 4) * 2 + (c >> 5), rr = r & 15, cc = c & 31, ob = rr * 64 + cc * 2; return st * 1024 + (ob ^ (((ob >> 9) & 1) << 5)); }
__device__ __forceinline__ void stage_rc(int b, int& R, int& C) { const int st = b / 1024, sb = b % 1024, swz = sb ^ (((sb >> 9) & 1) << 5); R = (st >> 1) * 16 + swz / 64; C = (st & 1) * 32 + (swz % 64) / 2; }
__device__ __forceinline__ int perm32(int rho) { const int n = rho >> 4, i = rho & 15; return 8 * (i >> 2) + 4 * n + (i & 3); }
struct Unit { int pm, pn, e; };
typedef f32x4 Acc[2][2][4][2];

template <bool GATHER, bool PERM, class Sched, class Epi>
__device__ __forceinline__ void gemm_phase(LAS unsigned char* lds, const int K, const Sched& S, const Epi& E) {
    const int tid = tid_(), wid = rfl(tid >> 6), lane = tid & 63, wr = wid >> 2, wc = wid & 3, fr = lane & 15, fq = lane >> 4;
    const int nt = K / BK;
    int Rr[2], Cc[2]; unsigned voffB[2];
#pragma unroll
    for (int i = 0; i < 2; ++i) { int R, C; stage_rc(tid * 16 + i * 8192, R, C); Rr[i] = R; Cc[i] = C; const int Rb = PERM ? ((R & ~31) + perm32(R & 31)) : R; voffB[i] = (unsigned)(Rb * K + C) * 2u; }
    const size_t kstep = (size_t)(BK * 2);
    const size_t hstep = (size_t)HALF * K * 2;
    const unsigned ldsw = (unsigned)wid * 1024u;
    const int aoff = lds_byte(wr * 64 + fr, fq * 8), boff = lds_byte(wc * 32 + fr, fq * 8);
#define GP_SA(b, h) (((b) * 2 + (h)) * HTB)
#define GP_SB(b, h) ((4 + (b) * 2 + (h)) * HTB)
#define GP_STAGE(bufoff, gbase, voff) do { _Pragma("unroll") for (int _i = 0; _i < 2; ++_i) \
        __builtin_amdgcn_global_load_lds((const unsigned*)((const char*)(gbase) + (voff)[_i]), (LAS unsigned*)(lds + (bufoff) + ldsw + _i * 8192), 16, 0, 0); } while (0)
#define GP_LDA(dst, b, h) do { _Pragma("unroll") for (int m = 0; m < 4; ++m) _Pragma("unroll") for (int k = 0; k < 2; ++k) dst[m][k] = *(const LAS bf16x8*)(lds + GP_SA(b, h) + aoff + m * 2048 + k * 1024); } while (0)
#define GP_LDB(dst, b, h) do { _Pragma("unroll") for (int n = 0; n < 2; ++n) _Pragma("unroll") for (int k = 0; k < 2; ++k) dst[n][k] = *(const LAS bf16x8*)(lds + GP_SB(b, h) + boff + n * 2048 + k * 1024); } while (0)
#define GP_MMA(ai, bj, At, Bt) do { __builtin_amdgcn_s_setprio(1); _Pragma("unroll") for (int m = 0; m < 4; ++m) _Pragma("unroll") for (int n = 0; n < 2; ++n) _Pragma("unroll") for (int k = 0; k < 2; ++k) \
        acc[ai][bj][m][n] = __builtin_amdgcn_mfma_f32_16x16x32_bf16(Bt[n][k], At[m][k], acc[ai][bj][m][n], 0, 0, 0); __builtin_amdgcn_s_setprio(0); } while (0)
#define GP_WAIT_V(n) asm volatile("s_waitcnt vmcnt(" #n ")" ::: "memory")
#define GP_WAIT_L(n) asm volatile("s_waitcnt lgkmcnt(" #n ")" ::: "memory")
#define GP_BAR __builtin_amdgcn_s_barrier()
#define GP_SCHED __builtin_amdgcn_sched_barrier(0)
#define GP_VOFF(u, v) do { _Pragma("unroll") for (int _h = 0; _h < 2; ++_h) _Pragma("unroll") for (int _i = 0; _i < 2; ++_i) { \
        const int _row = GATHER ? S.a_row(u, _h * 128 + Rr[_i]) : (_h * 128 + Rr[_i]); v[_h][_i] = (unsigned)(_row * K + Cc[_i]) * 2u; } } while (0)
    Unit cur, nxt; int ui = 0;
    if (!S.next(0, cur)) return;
    Acc acc;
#pragma unroll
    for (int a = 0; a < 2; ++a)
#pragma unroll
        for (int b = 0; b < 2; ++b)
#pragma unroll
            for (int m = 0; m < 4; ++m)
#pragma unroll
                for (int n = 0; n < 2; ++n) acc[a][b][m][n] = (f32x4){0.f, 0.f, 0.f, 0.f};
    bf16x8 At[4][2], B0[2][2], B1[2][2];
    unsigned vA[2][2], vAn[2][2];
    const char* cA = S.a_base(cur); const char* cB = S.b_base(cur);
    GP_VOFF(cur, vA);
    GP_STAGE(GP_SB(0, 0), cB, voffB); GP_STAGE(GP_SA(0, 0), cA, vA[0]); GP_STAGE(GP_SB(0, 1), cB + hstep, voffB); GP_STAGE(GP_SA(0, 1), cA, vA[1]);
    if (wr == 1) GP_BAR;
    GP_WAIT_V(4); GP_BAR;
    GP_STAGE(GP_SB(1, 0), cB + kstep, voffB); GP_STAGE(GP_SA(1, 0), cA + kstep, vA[0]); GP_STAGE(GP_SB(1, 1), cB + hstep + kstep, voffB);
    GP_WAIT_V(6); GP_BAR;
    for (;;) {
        const bool has_next = S.next(ui + 1, nxt);
        const char* nA = has_next ? S.a_base(nxt) : cA; const char* nB = has_next ? S.b_base(nxt) : cB;
        if (GATHER) { if (has_next) { GP_VOFF(nxt, vAn); } else { vAn[0][0] = vA[0][0]; vAn[0][1] = vA[0][1]; vAn[1][0] = vA[1][0]; vAn[1][1] = vA[1][1]; } }
        for (int t = 0; t < nt; t += 2) {
            const bool last = (t == nt - 2);
            const char* a1 = cA + (size_t)(t + 1) * kstep;
            const char* a2 = last ? nA : cA + (size_t)(t + 2) * kstep; const char* b2 = last ? nB : cB + (size_t)(t + 2) * kstep;
            const char* a3 = a2 + kstep; const char* b3 = b2 + kstep;
            unsigned v2[2][2];
#pragma unroll
            for (int h = 0; h < 2; ++h)
#pragma unroll
                for (int i = 0; i < 2; ++i) v2[h][i] = (GATHER && last) ? vAn[h][i] : vA[h][i];
            GP_LDB(B0, 0, 0); GP_SCHED; GP_LDA(At, 0, 0); GP_STAGE(GP_SA(1, 1), a1, vA[1]);
            GP_WAIT_L(8); GP_BAR; GP_WAIT_L(0); GP_MMA(0, 0, At, B0); GP_BAR; GP_SCHED;
            GP_LDB(B1, 0, 1); GP_STAGE(GP_SB(0, 0), b2, voffB);
            GP_BAR; GP_WAIT_L(0); GP_MMA(0, 1, At, B1); GP_BAR;
            GP_LDA(At, 0, 1); GP_STAGE(GP_SA(0, 0), a2, v2[0]);
            GP_BAR; GP_WAIT_L(0); GP_MMA(1, 0, At, B0); GP_BAR; GP_SCHED;
            GP_STAGE(GP_SB(0, 1), b2 + hstep, voffB);
            GP_WAIT_V(6); GP_BAR; GP_MMA(1, 1, At, B1); GP_BAR;
            GP_LDB(B0, 1, 0); GP_SCHED; GP_LDA(At, 1, 0); GP_STAGE(GP_SA(0, 1), a2, v2[1]);
            GP_WAIT_L(8); GP_BAR; GP_WAIT_L(0); GP_MMA(0, 0, At, B0); GP_BAR; GP_SCHED;
            GP_LDB(B1, 1, 1); GP_STAGE(GP_SB(1, 0), b3, voffB);
            GP_BAR; GP_WAIT_L(0); GP_MMA(0, 1, At, B1); GP_BAR;
            GP_LDA(At, 1, 1); GP_STAGE(GP_SA(1, 0), a3, v2[0]);
            GP_BAR; GP_WAIT_L(0); GP_MMA(1, 0, At, B0); GP_BAR; GP_SCHED;
            GP_STAGE(GP_SB(1, 1), b3 + hstep, voffB);
            GP_WAIT_V(6); GP_BAR; GP_MMA(1, 1, At, B1); GP_BAR;
        }
        E(acc, cur, wr, wc, fr, fq);
        if (!has_next) break;
#pragma unroll
        for (int a = 0; a < 2; ++a)
#pragma unroll
            for (int b = 0; b < 2; ++b)
#pragma unroll
                for (int m = 0; m < 4; ++m)
#pragma unroll
                    for (int n = 0; n < 2; ++n) acc[a][b][m][n] = (f32x4){0.f, 0.f, 0.f, 0.f};
        cur = nxt; cA = nA; cB = nB; ++ui;
        if (GATHER) { vA[0][0] = vAn[0][0]; vA[0][1] = vAn[0][1]; vA[1][0] = vAn[1][0]; vA[1][1] = vAn[1][1]; }
    }
    GP_WAIT_V(0);
    if (wr == 0) GP_BAR;
    GP_BAR;
#undef GP_SA
#undef GP_SB
#undef GP_STAGE
#undef GP_LDA
#undef GP_LDB
#undef GP_MMA
#undef GP_WAIT_V
#undef GP_WAIT_L
#undef GP_BAR
#undef GP_SCHED
#undef GP_VOFF
}

struct DenseSched {
    const bf16_t* A; const bf16_t* Bt; int K, nM, nN, nwg, G, c;
    __device__ __forceinline__ void init(const bf16_t* A_, const bf16_t* Bt_, int M, int N, int K_, int G_, int c_) { A = A_; Bt = Bt_; K = K_; nM = M / BM; nN = N / BM; nwg = nM * nN; G = G_; c = c_; }
    __device__ __forceinline__ bool next(int i, Unit& u) const {
        const long L = (long)i * G + c; if (L >= nwg) return false;
        int wgid = (int)L; { const int q = nwg / 8, r = nwg % 8, xcd = wgid % 8, off = wgid / 8; wgid = (xcd < r ? xcd * (q + 1) : r * (q + 1) + (xcd - r) * q) + off; }
        const int nig = 8 * nN, gid = wgid / nig, fm = gid * 8, gsz = (nM - fm) < 8 ? (nM - fm) : 8;
        u.pm = fm + ((wgid % nig) % gsz); u.pn = (wgid % nig) / gsz; u.e = 0; return true;
    }
    __device__ __forceinline__ const char* a_base(const Unit& u) const { return (const char*)A + (size_t)u.pm * BM * K * 2; }
    __device__ __forceinline__ const char* b_base(const Unit& u) const { return (const char*)Bt + (size_t)u.pn * BM * K * 2; }
    __device__ __forceinline__ int a_row(const Unit&, int r) const { return r; }
};
}

__device__ __forceinline__ void cvt_item(const float* W, int N, int K, bf16_t* Wt, int rowmul, int rowadd, int it, unsigned char* scr, int lane) {
    const int nkt = K >> 6, ntile = it / nkt, kt = it - ntile * nkt, k0 = kt * 64, n0 = ntile * 64;
    const float* src = W + (size_t)k0 * N + n0 + lane;
    float v[64];
#pragma unroll
    for (int k = 0; k < 64; ++k) v[k] = src[(size_t)k * N];
#pragma unroll
    for (int g = 0; g < 8; ++g) { u32x4 w; w.x = cvt_pk_bf16(v[g * 8 + 0], v[g * 8 + 1]); w.y = cvt_pk_bf16(v[g * 8 + 2], v[g * 8 + 3]); w.z = cvt_pk_bf16(v[g * 8 + 4], v[g * 8 + 5]); w.w = cvt_pk_bf16(v[g * 8 + 6], v[g * 8 + 7]);
        *(u32x4*)(scr + lane * 144 + g * 16) = w; }
    __builtin_amdgcn_s_waitcnt(0); __builtin_amdgcn_wave_barrier();
#pragma unroll
    for (int j = 0; j < 8; ++j) { const int n = (lane >> 3) + 8 * j, kc = lane & 7; const u32x4 w = *(const u32x4*)(scr + n * 144 + kc * 16);
        *(u32x4*)(Wt + (size_t)((n0 + n) * rowmul + rowadd) * K + k0 + kc * 8) = w; }
    __builtin_amdgcn_s_waitcnt(0); __builtin_amdgcn_wave_barrier();
}
__device__ __forceinline__ void phase_convert(const Params& p, unsigned char* lds) {
    const int tid = tid_(), lane = tid & 63, w = tid >> 6, gw = bid_() * NW_ + w, nw = nblk_() * NW_;
    unsigned char* scr = lds + w * 9216;
    constexpr int I_IN = 32 * 100, I_OUT = 32 * 32, I_GU = 32 * 8, I_D = 8 * 32;
    constexpr int PER_L = I_IN + I_OUT + 65 * 2 * I_GU + 65 * I_D;
    for (int it0 = gw; it0 < 2 * PER_L; it0 += nw) {
        const int l = it0 / PER_L; int r = it0 - l * PER_L;
        if (r < I_IN) { cvt_item(p.w_in + (size_t)l * D_ * NIN, NIN, D_, p.WinT + (size_t)l * NIN * D_, 1, 0, r, scr, lane); continue; } r -= I_IN;
        if (r < I_OUT) { cvt_item(p.w_out + (size_t)l * D_ * D_, D_, D_, p.WoutT + (size_t)l * D_ * D_, 1, 0, r, scr, lane); continue; } r -= I_OUT;
        if (r < 65 * 2 * I_GU) { const int e = r / (2 * I_GU), rr = r - e * 2 * I_GU, which = rr / I_GU, ri = rr - which * I_GU;
            const float* src = (e < NE) ? ((which ? p.w_eu : p.w_eg) + (size_t)(l * NE + e) * D_ * 512) : ((which ? p.w_su : p.w_sg) + (size_t)l * D_ * 512);
            cvt_item(src, 512, D_, p.WguT + (size_t)(l * 65 + e) * 1024 * D_, 2, which, ri, scr, lane); continue; } r -= 65 * 2 * I_GU;
        { const int e = r / I_D, ri = r - e * I_D;
            const float* src = (e < NE) ? (p.w_ed + (size_t)(l * NE + e) * 512 * D_) : (p.w_sd + (size_t)l * 512 * D_);
            cvt_item(src, D_, 512, p.WdT + (size_t)(l * 65 + e) * D_ * 512, 1, 0, ri, scr, lane); }
    }
}

struct EpiIn {
    bf16_t* P; bf16_t* Vt;
    __device__ __forceinline__ void operator()(const gp::Acc& acc, const gp::Unit& u, int wr, int wc, int fr, int fq) const {
        const int row0 = u.pm * 256 + wr * 64 + fr, col0 = u.pn * 256 + wc * 32 + 8 * fq;
        const bool isv = (u.pn >= 8 && u.pn < 12);
#pragma unroll
        for (int ai = 0; ai < 2; ++ai)
#pragma unroll
            for (int m = 0; m < 4; ++m) { const int row = row0 + ai * 128 + m * 16; bf16_t* rowp = P + (size_t)row * NIN + col0;
#pragma unroll
                for (int bj = 0; bj < 2; ++bj) { const f32x4 v0 = acc[ai][bj][m][0], v1 = acc[ai][bj][m][1];
                    u32x4 w; w.x = cvt_pk_bf16(v0[0], v0[1]); w.y = cvt_pk_bf16(v0[2], v0[3]); w.z = cvt_pk_bf16(v1[0], v1[1]); w.w = cvt_pk_bf16(v1[2], v1[3]);
                    *(u32x4*)(rowp + bj * 128) = w;
                    if (isv) { const int b = row >> 11, s = row & 2047, h = (u.pn - 8) * 2 + bj, dv = wc * 32 + 8 * fq;
                        bf16_t* vp = Vt + ((size_t)(b * 8 + h) * 128 + dv) * S_ + s;
                        vp[0] = (bf16_t)(w.x & 0xffffu); vp[S_] = (bf16_t)(w.x >> 16); vp[2 * S_] = (bf16_t)(w.y & 0xffffu); vp[3 * S_] = (bf16_t)(w.y >> 16);
                        vp[4 * S_] = (bf16_t)(w.z & 0xffffu); vp[5 * S_] = (bf16_t)(w.z >> 16); vp[6 * S_] = (bf16_t)(w.w & 0xffffu); vp[7 * S_] = (bf16_t)(w.w >> 16); } } }
    }
};
struct EpiF32 {
    float* C; int ldc;
    __device__ __forceinline__ void operator()(const gp::Acc& acc, const gp::Unit& u, int wr, int wc, int fr, int fq) const {
        const int row0 = u.pm * 256 + wr * 64 + fr, col0 = u.pn * 256 + wc * 32 + 4 * fq;
#pragma unroll
        for (int ai = 0; ai < 2; ++ai)
#pragma unroll
            for (int m = 0; m < 4; ++m) { float* rowp = C + (size_t)(row0 + ai * 128 + m * 16) * ldc + col0;
#pragma unroll
                for (int bj = 0; bj < 2; ++bj)
#pragma unroll
                    for (int n = 0; n < 2; ++n) *(f32x4*)(rowp + bj * 128 + n * 16) = acc[ai][bj][m][n]; }
    }
};
__device__ __forceinline__ void phase_gemm_in8(const Params& p, int l, unsigned char* lds) {
    gp::DenseSched S; S.init(p.Hn, p.WinT + (size_t)l * NIN * D_, T_, NIN, D_, nblk_(), bid_());
    EpiIn E{p.P, p.Vt};
    gp::gemm_phase<false, true>((LAS unsigned char*)lds, D_, S, E);
}
__device__ __forceinline__ void phase_gemm_out8(const Params& p, int l, unsigned char* lds) {
    gp::DenseSched S; S.init(p.ocat, p.WoutT + (size_t)l * D_ * D_, T_, D_, D_, nblk_(), bid_());
    EpiF32 E{p.mixed, D_};
    gp::gemm_phase<false, false>((LAS unsigned char*)lds, D_, S, E);
}

__device__ __forceinline__ void build_tables(const Params& p, int l, int* tab, int tshift) {
    if (tid_() == 0) {
        int pb = 0, tb = 0;
        for (int e = 0; e <= NE; ++e) { const int c = (e < NE) ? (int)__hip_atomic_load(p.counts + l * NE + e, __ATOMIC_RELAXED, __HIP_MEMORY_SCOPE_AGENT) : T_;
            tab[e] = c; tab[80 + e] = pb; tab[160 + e] = tb; pb += (c + 255) & ~255; tb += (c + (1 << tshift) - 1) >> tshift; }
        tab[80 + NE + 1] = pb; tab[160 + NE + 1] = tb;
    }
    __syncthreads();
}
__device__ __forceinline__ int find_expert(const int* tab, int rt) { int e = 0; while (e < NE && rt >= tab[160 + e + 1]) ++e; return e; }

struct MoeSched {
    const int* tab; const char* A; const char* Bt; size_t bt_stride; const int* rowtok; int K, nN, nunits, G, c; bool gather;
    __device__ __forceinline__ bool next(int i, gp::Unit& u) const {
        const int L = i * G + c; if (L >= nunits) return false;
        const int rtg = L / nN; u.pn = L - rtg * nN; const int e = find_expert(tab, rtg); u.e = e; u.pm = rtg - tab[160 + e]; return true;
    }
    __device__ __forceinline__ const char* a_base(const gp::Unit& u) const { return gather ? A : A + (size_t)(tab[80 + u.e] + u.pm * 256) * K * 2; }
    __device__ __forceinline__ const char* b_base(const gp::Unit& u) const { return Bt + (size_t)u.e * bt_stride + (size_t)u.pn * 256 * K * 2; }
    __device__ __forceinline__ int a_row(const gp::Unit& u, int r) const { const int slot = u.pm * 256 + r; return (slot < tab[u.e]) ? ((u.e < NE) ? rowtok[u.e * CAP + slot] : slot) : 0; }
};
struct EpiSwiglu {
    bf16_t* H1; const int* tab;
    __device__ __forceinline__ void operator()(const gp::Acc& acc, const gp::Unit& u, int wr, int wc, int fr, int fq) const {
        const int row0 = tab[80 + u.e] + u.pm * 256 + wr * 64 + fr, hid0 = u.pn * 128 + wc * 16 + 4 * fq;
#pragma unroll
        for (int ai = 0; ai < 2; ++ai)
#pragma unroll
            for (int m = 0; m < 4; ++m) { bf16_t* rowp = H1 + (size_t)(row0 + ai * 128 + m * 16) * 512 + hid0;
#pragma unroll
                for (int bj = 0; bj < 2; ++bj) { const f32x4 v0 = acc[ai][bj][m][0], v1 = acc[ai][bj][m][1];
                    const float h0 = v0[0] / (1.0f + __expf(-v0[0])) * v0[1], h1 = v0[2] / (1.0f + __expf(-v0[2])) * v0[3];
                    const float h2 = v1[0] / (1.0f + __expf(-v1[0])) * v1[1], h3 = v1[2] / (1.0f + __expf(-v1[2])) * v1[3];
                    u32x2 o; o.x = cvt_pk_bf16(h0, h1); o.y = cvt_pk_bf16(h2, h3);
                    *(u32x2*)(rowp + bj * 64) = o; } }
    }
};
struct EpiDown {
    bf16_t* Y2; const int* tab; const float* rowg;
    __device__ __forceinline__ void operator()(const gp::Acc& acc, const gp::Unit& u, int wr, int wc, int fr, int fq) const {
        const int slot0 = u.pm * 256 + wr * 64 + fr, pb = tab[80 + u.e], cnt = tab[u.e], col0 = u.pn * 256 + wc * 32 + 8 * fq;
#pragma unroll
        for (int ai = 0; ai < 2; ++ai)
#pragma unroll
            for (int m = 0; m < 4; ++m) { const int slot = slot0 + ai * 128 + m * 16;
                const float g = (slot < cnt) ? ((u.e < NE) ? rowg[u.e * CAP + slot] : 1.0f) : 0.f;
                bf16_t* rowp = Y2 + (size_t)(pb + slot) * D_ + col0;
#pragma unroll
                for (int bj = 0; bj < 2; ++bj) { const f32x4 v0 = acc[ai][bj][m][0] * g, v1 = acc[ai][bj][m][1] * g;
                    u32x4 w; w.x = cvt_pk_bf16(v0[0], v0[1]); w.y = cvt_pk_bf16(v0[2], v0[3]); w.z = cvt_pk_bf16(v1[0], v1[1]); w.w = cvt_pk_bf16(v1[2], v1[3]);
                    *(u32x4*)(rowp + bj * 128) = w; } }
    }
};
__device__ __forceinline__ int xcd_order(int c, int G) { return (G % 8 == 0) ? (c % 8) * (G / 8) + c / 8 : c; }
__device__ __forceinline__ void phase_moe_gu8(const Params& p, int l, unsigned char* lds) {
    int* tab = (int*)(lds + TAB_OFF);
    build_tables(p, l, tab, 8);
    MoeSched S{tab, (const char*)p.Hn, (const char*)(p.WguT + (size_t)l * 65 * 1024 * D_), (size_t)1024 * D_ * 2, p.rowtok, D_, 4, tab[160 + NE + 1] * 4, nblk_(), xcd_order(bid_(), nblk_()), true};
    EpiSwiglu E{p.H1, tab};
    gp::gemm_phase<true, true>((LAS unsigned char*)lds, D_, S, E);
}
__device__ __forceinline__ void phase_moe_down8(const Params& p, int l, unsigned char* lds) {
    int* tab = (int*)(lds + TAB_OFF);
    build_tables(p, l, tab, 8);
    MoeSched S{tab, (const char*)p.H1, (const char*)(p.WdT + (size_t)l * 65 * D_ * 512), (size_t)D_ * 512 * 2, p.rowtok, 512, 8, tab[160 + NE + 1] * 8, nblk_(), xcd_order(bid_(), nblk_()), false};
    EpiDown E{p.Y2, tab, p.rowg};
    gp::gemm_phase<false, true>((LAS unsigned char*)lds, 512, S, E);
}

__device__ __forceinline__ void phase_adaln(const Params& p, unsigned char* lds) {
    float* cond = (float*)lds;
    float* red = cond + 4 * D_;
    const int tid = tid_(), lane = tid & 63, w = tid >> 6;
    for (int i = tid; i < 4 * D_; i += NTHR) { const float v = p.c[i]; cond[i] = v / (1.0f + __expf(-v)); }
    __syncthreads();
    for (int unit = bid_(); unit < 2 * 192; unit += nblk_()) {
        const int l = unit / 192, n = (unit % 192) * 64 + lane;
        const float* W = p.w_ada + (size_t)l * D_ * 12288 + n;
        float a0 = 0.f, a1 = 0.f, a2 = 0.f, a3 = 0.f;
        const int k0 = w * (D_ / NW_);
#pragma unroll 8
        for (int k = k0; k < k0 + D_ / NW_; ++k) { const float wv = W[(size_t)k * 12288]; a0 += cond[k] * wv; a1 += cond[D_ + k] * wv; a2 += cond[2 * D_ + k] * wv; a3 += cond[3 * D_ + k] * wv; }
        red[(w * 4 + 0) * 64 + lane] = a0; red[(w * 4 + 1) * 64 + lane] = a1; red[(w * 4 + 2) * 64 + lane] = a2; red[(w * 4 + 3) * 64 + lane] = a3;
        __syncthreads();
        if (w < 4) {
            float s = 0.f;
#pragma unroll
            for (int ww = 0; ww < NW_; ++ww) s += red[(ww * 4 + w) * 64 + lane];
            p.mod[((size_t)l * 4 + w) * 12288 + n] = s + p.b_ada[(size_t)l * 12288 + n];
        }
        __syncthreads();
    }
}

__device__ __forceinline__ void emit_hn(const f32x4 (&xv)[8], float rstd, const float* g, const float* sc, const float* sh, bf16_t* dst, int lane, float* hf) {
#pragma unroll
    for (int i = 0; i < 8; ++i) {
        const int e = i * 256 + lane * 4;
        const f32x4 gv = *(const f32x4*)(g + e), scv = *(const f32x4*)(sc + e), shv = *(const f32x4*)(sh + e);
        f32x4 h;
#pragma unroll
        for (int j = 0; j < 4; ++j) h[j] = xv[i][j] * rstd * gv[j] * (1.0f + scv[j]) + shv[j];
        u32x2 o; o.x = cvt_pk_bf16(h[0], h[1]); o.y = cvt_pk_bf16(h[2], h[3]);
        *(u32x2*)(dst + e) = o;
        if (hf) *(f32x4*)(hf + e) = h;
    }
}

__device__ __forceinline__ void phase_prenorm0(const Params& p) {
    const int lane = tid_() & 63, gw = bid_() * (NTHR / 64) + (tid_() >> 6), nw = nblk_() * (NTHR / 64);
    for (int t = gw; t < T_; t += nw) {
        const int b = t / S_;
        f32x4 xv[8]; float ss = 0.f;
#pragma unroll
        for (int i = 0; i < 8; ++i) { xv[i] = *(const f32x4*)(p.x + (size_t)t * D_ + i * 256 + lane * 4); ss += xv[i][0] * xv[i][0] + xv[i][1] * xv[i][1] + xv[i][2] * xv[i][2] + xv[i][3] * xv[i][3]; }
        ss = wave_sum(ss);
        const float rstd = rsqrtf(ss * (1.0f / D_) + 1e-6f);
        const float* md = p.mod + (size_t)b * 12288;
        emit_hn(xv, rstd, p.g_pre_mix, md + 2048, md, p.Hn + (size_t)t * D_, lane, nullptr);
    }
}

__device__ __forceinline__ void phase_gemm_in(const Params& p, int l, unsigned char* lds) {
    const float* B = p.w_in + (size_t)l * D_ * NIN;
    for (int unit = bid_(); unit < 64 * 50; unit += nblk_()) {
        const int mt = unit / 50, nt = unit % 50;
        bf16_t* Pp = p.P;
        gemm_tile(lds, p.Hn, D_, [=](int r) { return mt * 128 + r; }, B + nt * 128 + (tid_() & 127), NIN, D_,
                  [=](int m, int n, f32x4 v) { u32x2 o; o.x = cvt_pk_bf16(v[0], v[1]); o.y = cvt_pk_bf16(v[2], v[3]); *(u32x2*)(Pp + (size_t)(mt * 128 + m) * NIN + nt * 128 + n) = o; });
    }
}

__device__ __forceinline__ void phase_attn_naive(const Params& p) {
    const int lane = tid_() & 63, gw = bid_() * (NTHR / 64) + (tid_() >> 6), nw = nblk_() * (NTHR / 64);
    float* tmp = p.mixed;
    for (int it = gw; it < 2048; it += nw) {
        const int item = rfl(it);
        const int qb = 31 - (item >> 6), rest = item & 63, c = rest & 1, h = (rest >> 1) & 7, b = rest >> 4;
        const int q = qb * 64 + lane;
        const bf16_t* Pb = p.P + (size_t)b * S_ * NIN;
        float qv[64];
        {
            const bf16_t* qp = Pb + (size_t)q * NIN + h * 128 + c * 64;
#pragma unroll
            for (int i = 0; i < 8; ++i) { const u32x4 u = *(const u32x4*)(qp + i * 8);
#pragma unroll
                for (int j = 0; j < 4; ++j) { qv[i * 8 + j * 2] = __uint_as_float(u[j] << 16); qv[i * 8 + j * 2 + 1] = __uint_as_float(u[j] & 0xffff0000u); } }
        }
        const float scale2 = 0.125f * 1.44269504f, slope2 = exp2f(-(float)(h + 1)) * 1.44269504f;
        const int jmax = qb * 64 + 63;
        const bf16_t* kbase = Pb + 1024 + h * 128 + c * 64;
        const bf16_t* vbase = Pb + 2048 + h * 128;
        float m = -1e30f;
        for (int j = 0; j <= jmax; ++j) {
            const u32x4* kp = (const u32x4*)(kbase + (size_t)j * NIN);
            float s = 0.f;
#pragma unroll
            for (int i = 0; i < 8; ++i) { const u32x4 u = kp[i];
#pragma unroll
                for (int jj = 0; jj < 4; ++jj) { s += qv[i * 8 + jj * 2] * __uint_as_float(u[jj] << 16); s += qv[i * 8 + jj * 2 + 1] * __uint_as_float(u[jj] & 0xffff0000u); } }
            s = s * scale2 - slope2 * (float)(q - j);
            if (j <= q) m = fmaxf(m, s);
        }
        const float minv = 1.0f;
#pragma unroll 1
        for (int dh = 0; dh < 2; ++dh) {
            float lsum = 0.f; float acc[64];
#pragma unroll
            for (int d = 0; d < 64; ++d) acc[d] = 0.f;
            for (int j = 0; j <= jmax; ++j) {
                const u32x4* kp = (const u32x4*)(kbase + (size_t)j * NIN);
                float s = 0.f;
#pragma unroll
                for (int i = 0; i < 8; ++i) { const u32x4 u = kp[i];
#pragma unroll
                    for (int jj = 0; jj < 4; ++jj) { s += qv[i * 8 + jj * 2] * __uint_as_float(u[jj] << 16); s += qv[i * 8 + jj * 2 + 1] * __uint_as_float(u[jj] & 0xffff0000u); } }
                s = s * scale2 - slope2 * (float)(q - j);
                const float pj = (j <= q) ? exp2f(s - m) : 0.f;
                lsum += pj;
                const u32x4* vp = (const u32x4*)(vbase + (size_t)j * NIN + dh * 64);
#pragma unroll
                for (int i = 0; i < 8; ++i) { const u32x4 u = vp[i];
#pragma unroll
                    for (int jj = 0; jj < 4; ++jj) { acc[i * 8 + jj * 2] += pj * __uint_as_float(u[jj] << 16); acc[i * 8 + jj * 2 + 1] += pj * __uint_as_float(u[jj] & 0xffff0000u); } }
            }
            const float inv = minv / lsum;
            float* op = tmp + (size_t)(b * S_ + q + launder0()) * D_ + h * 256 + c * 128;
#pragma unroll
            for (int d = 0; d < 64; d += 4) *(f32x4*)(op + dh * 64 + d) = (f32x4){acc[d] * inv, acc[d + 1] * inv, acc[d + 2] * inv, acc[d + 3] * inv};
        }
    }
}

__device__ __forceinline__ float shifted(const bf16_t* P, int t, int col, float mu) {
    const float cur = bf2f(P[(size_t)t * NIN + 3072 + col]);
    const float prev = (t % S_) ? bf2f(P[(size_t)(t - 1) * NIN + 3072 + col]) : 0.f;
    return cur + (prev - cur) * mu;
}
#define PREP_RB 2
__device__ __forceinline__ void phase_rwkv_prep(const Params& p, int l, unsigned char* lds) {
    float* lowr = (float*)lds;
    float* vrow = lowr + PREP_RB * 256;
    float* red = vrow + PREP_RB * 1024;
    float* vv = red + PREP_RB * 512;
    const int tid = tid_(), lane = tid & 63;
    const float* mu = p.mu + (size_t)l * 3328;
    const float *w0 = p.w0 + l * RW, *w2 = p.w2 + (size_t)l * 64 * RW, *a0 = p.a0 + l * RW, *a2 = p.a2 + (size_t)l * 64 * RW, *g2 = p.g2 + (size_t)l * 128 * RW;
    const float *k_k = p.k_k + l * RW, *k_a = p.k_a + l * RW, *r_k = p.r_k + l * RW;
    for (int unit = bid_(); unit < T_ / PREP_RB; unit += nblk_()) {
        const int t0 = unit * PREP_RB;
        for (int idx = tid; idx < PREP_RB * 256; idx += NTHR) {
            const int r = idx >> 8, m = idx & 255;
            const float f = shifted(p.P, t0 + r, 3072 + m, mu[3072 + m]);
            lowr[idx] = (m < 64) ? tanhf(f) : (m < 128) ? f : sigmoidf_(f);
        }
        if (l > 0) {
            for (int idx = tid; idx < PREP_RB * 1024; idx += NTHR) { const int r = idx >> 10, cc = idx & 1023; vrow[idx] = shifted(p.P, t0 + r, 2048 + cc, mu[2048 + cc]); }
        }
        __syncthreads();
        if (l > 0) {
            const int j = tid & 31, part = tid >> 5;
            const float* v1 = p.v1;
#pragma unroll
            for (int r = 0; r < PREP_RB; ++r) {
                float s = 0.f;
#pragma unroll 4
                for (int cc = part * 64; cc < part * 64 + 64; ++cc) s += vrow[r * 1024 + cc] * v1[cc * 32 + j];
                red[(r * 16 + part) * 32 + j] = s;
            }
            __syncthreads();
            if (tid < PREP_RB * 32) { const int r = tid >> 5, jj = tid & 31; float s = 0.f;
#pragma unroll
                for (int pp = 0; pp < 16; ++pp) s += red[(r * 16 + pp) * 32 + jj];
                vv[r * 32 + jj] = s; }
            __syncthreads();
        }
#pragma unroll 1
        for (int i = 0; i < 1024 / NTHR; ++i) {
            const int cc = tid + i * NTHR, h = cc >> 6;
            float wa[PREP_RB], aa[PREP_RB], ga[PREP_RB];
#pragma unroll
            for (int r = 0; r < PREP_RB; ++r) { wa[r] = 0.f; aa[r] = 0.f; ga[r] = 0.f; }
#pragma unroll 2
            for (int m = 0; m < 64; ++m) {
                const float w2v = w2[m * RW + cc], a2v = a2[m * RW + cc], g2a = g2[m * RW + cc], g2b = g2[(64 + m) * RW + cc];
#pragma unroll
                for (int r = 0; r < PREP_RB; ++r) { wa[r] += lowr[r * 256 + m] * w2v; aa[r] += lowr[r * 256 + 64 + m] * a2v; ga[r] += lowr[r * 256 + 128 + m] * g2a + lowr[r * 256 + 192 + m] * g2b; }
            }
#pragma unroll
            for (int r = 0; r < PREP_RB; ++r) {
                const int t = t0 + r;
                const float rr = shifted(p.P, t, cc, mu[cc]), kx = shifted(p.P, t, 1024 + cc, mu[1024 + cc]);
                float vx = shifted(p.P, t, 2048 + cc, mu[2048 + cc]);
                const float wv = w0[cc] + wa[r];
                const float decay = __expf(-sigmoidf_(wv) * 0.60653066f);
                const float a = sigmoidf_(a0[cc] + aa[r]);
                const size_t o = (size_t)t * RW + cc;
                if (l == 0) p.vfirst[o] = vx;
                else {
                    float s = p.v0[cc];
#pragma unroll
                    for (int jj = 0; jj < 32; ++jj) s += vv[r * 32 + jj] * p.v2[jj * RW + cc];
                    vx = vx + (p.vfirst[o] - vx) * sigmoidf_(s);
                }
                const float kk = kx * k_k[cc];
                const float ss = wave_sum(kk * kk);
                const float kkn = kk / fmaxf(sqrtf(ss), 1e-12f);
                const float kh = kx * (1.0f + (a - 1.0f) * k_a[cc]);
                const float bc = wave_sum(rr * kh * r_k[cc]);
                if (lane == 0) p.bcoef[(size_t)t * 16 + h] = bc;
                p.sr[o] = rr; p.sw[o] = decay; p.sk[o] = kh; p.sv[o] = vx; p.sa[o] = -kkn; p.sb[o] = kkn * a; p.sg[o] = ga[r];
            }
        }
        __syncthreads();
    }
}

__device__ __forceinline__ void phase_scan_naive(const Params& p) {
    const int lane = tid_() & 63, gw = (tid_() >> 6) * nblk_() + bid_(), nw = nblk_() * (NTHR / 64);
    for (int it = gw; it < 64; it += nw) {
        const int item = rfl(it), b = item >> 4, h = item & 15;
        float st[64];
#pragma unroll
        for (int j = 0; j < 64; ++j) st[j] = 0.f;
        size_t base = (size_t)b * S_ * RW + h * 64 + lane;
        for (int t = 0; t < S_; ++t, base += RW) {
            const float wv = p.sw[base], av = p.sa[base], bv = p.sb[base], kv = p.sk[base], rv = p.sr[base], vi = p.sv[base];
            float sa = 0.f;
#pragma unroll
            for (int j = 0; j < 64; ++j) sa += st[j] * RL(av, j);
            float y = 0.f;
#pragma unroll
            for (int j = 0; j < 64; ++j) { st[j] = st[j] * RL(wv, j) + sa * RL(bv, j) + vi * RL(kv, j); y += st[j] * RL(rv, j); }
            p.sy[base] = y;
        }
    }
}

__device__ __forceinline__ void phase_post(const Params& p, int l) {
    const int tid = tid_(), lane = tid & 63, w = tid >> 6;
    const float lam_init = (l == 0) ? 0.2f : 0.35550907f;
    float lam;
    { const float s1 = wave_sum(p.lam_q1[l * 64 + lane] * p.lam_k1[l * 64 + lane]), s2 = wave_sum(p.lam_q2[l * 64 + lane] * p.lam_k2[l * 64 + lane]); lam = __expf(s1) - __expf(s2) + lam_init; }
    const float* tmp = p.mixed;
    for (int t = bid_(); t < T_; t += nblk_()) {
        for (int h = w; h < 8; h += NTHR / 64) {
            const float* o0 = tmp + (size_t)t * D_ + h * 256 + lane * 2;
            const float x0 = o0[0] - lam * o0[128], x1 = o0[1] - lam * o0[129];
            const float ss = wave_sum(x0 * x0 + x1 * x1);
            const float rstd = rsqrtf(ss * (1.0f / 128.0f) + 1e-5f) * (1.0f - lam_init);
            const float* sg = p.subln_g + l * 128 + lane * 2;
            *(unsigned*)(p.ocat + (size_t)t * D_ + h * 128 + lane * 2) = cvt_pk_bf16(x0 * rstd * sg[0], x1 * rstd * sg[1]);
        }
        for (int h = w; h < 16; h += NTHR / 64) {
            const int cc = h * 64 + lane; const size_t o = (size_t)t * RW + cc;
            const float y = p.sy[o];
            const float mean = wave_sum(y) * (1.0f / 64.0f);
            const float d = y - mean;
            const float var = wave_sum(d * d) * (1.0f / 64.0f);
            const float yn = d * rsqrtf(var + 64e-5f) * p.lnx_w[l * RW + cc] + p.lnx_b[l * RW + cc];
            const float val = (yn + p.bcoef[(size_t)t * 16 + h] * p.sv[o]) * p.sg[o];
            const float nb = __shfl_down(val, 1);
            if ((lane & 1) == 0) *(unsigned*)(p.ocat + (size_t)t * D_ + 1024 + cc) = cvt_pk_bf16(val, nb);
        }
    }
}

__device__ __forceinline__ void phase_gemm_out(const Params& p, int l, unsigned char* lds) {
    const float* B = p.w_out + (size_t)l * D_ * D_;
    for (int unit = bid_(); unit < 64 * 16; unit += nblk_()) {
        const int mt = unit >> 4, nt = unit & 15;
        float* C = p.mixed;
        gemm_tile(lds, p.ocat, D_, [=](int r) { return mt * 128 + r; }, B + nt * 128 + (tid_() & 127), D_, D_,
                  [=](int m, int n, f32x4 v) { *(f32x4*)(C + (size_t)(mt * 128 + m) * D_ + nt * 128 + n) = v; });
    }
}

__device__ __forceinline__ void phase_res1_router(const Params& p, int l, unsigned char* lds) {
    const int tid = tid_(), lane = tid & 63, w = tid >> 6, gw = bid_() * (NTHR / 64) + w, nw = nblk_() * (NTHR / 64);
    float* hrow = (float*)lds + w * D_;
    const float* xin = (l == 0) ? p.x : p.out;
    const float* Wr = p.w_router + (size_t)l * D_ * NE;
    for (int t = gw; t < T_; t += nw) {
        const int b = t / S_;
        const float* md = p.mod + ((size_t)l * 4 + b) * 12288;
        f32x4 xv[8]; float ss = 0.f;
#pragma unroll
        for (int i = 0; i < 8; ++i) { const int e = i * 256 + lane * 4; const f32x4 mv = *(const f32x4*)(p.mixed + (size_t)t * D_ + e);
            ss += mv[0] * mv[0] + mv[1] * mv[1] + mv[2] * mv[2] + mv[3] * mv[3]; }
        ss = wave_sum(ss);
        const float rm = rsqrtf(ss * (1.0f / D_) + 1e-6f);
        float s2 = 0.f;
#pragma unroll
        for (int i = 0; i < 8; ++i) { const int e = i * 256 + lane * 4; const f32x4 gp = *(const f32x4*)(p.g_post_mix + l * D_ + e), ga = *(const f32x4*)(md + 4096 + e);
            const f32x4 mv = *(const f32x4*)(p.mixed + (size_t)t * D_ + e); xv[i] = *(const f32x4*)(xin + (size_t)t * D_ + e);
#pragma unroll
            for (int j = 0; j < 4; ++j) { xv[i][j] += ga[j] * (mv[j] * rm * gp[j]); s2 += xv[i][j] * xv[i][j]; }
            *(f32x4*)(p.out + (size_t)t * D_ + e) = xv[i]; }
        s2 = wave_sum(s2);
        const float rx = rsqrtf(s2 * (1.0f / D_) + 1e-6f);
        emit_hn(xv, rx, p.g_pre_ffn + l * D_, md + 8192, md + 6144, p.Hn + (size_t)t * D_, lane, hrow);
        __builtin_amdgcn_s_waitcnt(0);
        __builtin_amdgcn_wave_barrier();
        float lg = 0.f;
#pragma unroll 8
        for (int k = 0; k < D_; ++k) lg += hrow[k] * Wr[(size_t)k * NE + lane];
        const float score = sigmoidf_(lg), biased = score + p.router_bias[l * NE + lane];
        int rk = 0;
#pragma unroll
        for (int i = 0; i < 8; ++i) { const int src = (lane & ~7) + i; const float o = __shfl(biased, src); rk += (o > biased || (o == biased && src < lane)) ? 1 : 0; }
        float gs = (rk < 2) ? biased : 0.f;
        gs += __shfl_xor(gs, 1); gs += __shfl_xor(gs, 2); gs += __shfl_xor(gs, 4);
        int grk = 0; const int g = lane >> 3;
#pragma unroll
        for (int i = 0; i < 8; ++i) { const float o = RL(gs, i * 8); grk += (o > gs || (o == gs && i < g)) ? 1 : 0; }
        const bool gsel = grk < 4;
        const float mvv = gsel ? biased : -INFINITY;
        int erk = 0;
#pragma unroll
        for (int i = 0; i < 64; ++i) { const float o = RL(mvv, i); erk += (o > mvv || (o == mvv && i < lane)) ? 1 : 0; }
        const bool sel = gsel && erk < 8;
        const float gsum = wave_sum(sel ? score : 0.f);
        if (sel) {
            const float gate = score / gsum * 2.5f;
            const unsigned slot = atomicAdd(p.counts + l * NE + lane, 1u);
            p.rowtok[lane * CAP + slot] = t; p.rowg[lane * CAP + slot] = gate; p.tokpos[(size_t)t * 8 + erk] = lane * CAP + (int)slot;
        }
        __builtin_amdgcn_wave_barrier();
    }
}

__device__ __forceinline__ void phase_moe_gu(const Params& p, int l, unsigned char* lds) {
    int* tab = (int*)(lds + TAB_OFF);
    build_tables(p, l, tab, 7);
    const int ntile = tab[160 + NE + 1];
    for (int unit = bid_(); unit < ntile * 8; unit += nblk_()) {
        const int rtg = unit >> 3, ct = unit & 7, e = find_expert(tab, rtg), rt = rtg - tab[160 + e], cnt = tab[e], pb = tab[80 + e];
        const float* Bg = (e < NE) ? p.w_eg + ((size_t)(l * NE + e) * D_) * 512 : p.w_sg + (size_t)l * D_ * 512;
        const float* Bu = (e < NE) ? p.w_eu + ((size_t)(l * NE + e) * D_) * 512 : p.w_su + (size_t)l * D_ * 512;
        const int n = tid_() & 127;
        const float* bp = ((n & 1) ? Bu : Bg) + ct * 64 + (n >> 1);
        const int* rtok = p.rowtok + e * CAP;
        bf16_t* H1 = p.H1;
        gemm_tile(lds, p.Hn, D_, [=](int r) { const int slot = rt * 128 + r; return (slot < cnt) ? ((e < NE) ? rtok[slot] : slot) : 0; }, bp, 512, D_,
                  [=](int m, int nn, f32x4 v) { const float h0 = v[0] / (1.0f + __expf(-v[0])) * v[1], h1 = v[2] / (1.0f + __expf(-v[2])) * v[3];
                      *(unsigned*)(H1 + (size_t)(pb + rt * 128 + m) * 512 + ct * 64 + (nn >> 1)) = cvt_pk_bf16(h0, h1); });
    }
}

__device__ __forceinline__ void phase_moe_down(const Params& p, int l, unsigned char* lds) {
    int* tab = (int*)(lds + TAB_OFF);
    build_tables(p, l, tab, 7);
    const int ntile = tab[160 + NE + 1];
    for (int unit = bid_(); unit < ntile * 16; unit += nblk_()) {
        const int rtg = unit >> 4, ct = unit & 15, e = find_expert(tab, rtg), rt = rtg - tab[160 + e], cnt = tab[e], pb = tab[80 + e];
        const float* Bd = (e < NE) ? p.w_ed + ((size_t)(l * NE + e) * 512) * D_ : p.w_sd + (size_t)l * 512 * D_;
        const float* rg = p.rowg + e * CAP;
        bf16_t* Y2 = p.Y2;
        gemm_tile(lds, p.H1, 512, [=](int r) { return pb + rt * 128 + r; }, Bd + ct * 128 + (tid_() & 127), D_, 512,
                  [=](int m, int nn, f32x4 v) { const int slot = rt * 128 + m; const float g = (slot < cnt) ? ((e < NE) ? rg[slot] : 1.0f) : 0.f;
                      u32x2 o; o.x = cvt_pk_bf16(v[0] * g, v[1] * g); o.y = cvt_pk_bf16(v[2] * g, v[3] * g);
                      *(u32x2*)(Y2 + (size_t)(pb + slot) * D_ + ct * 128 + nn) = o; });
    }
}

__device__ __forceinline__ void phase_combine(const Params& p, int l, unsigned char* lds) {
    int* tab = (int*)(lds + TAB_OFF);
    build_tables(p, l, tab, 8);
    const int lane = tid_() & 63, gw = bid_() * (NTHR / 64) + (tid_() >> 6), nw = nblk_() * (NTHR / 64);
    for (int t = gw; t < T_; t += nw) {
        const int b = t / S_;
        const float* md = p.mod + ((size_t)l * 4 + b) * 12288;
        f32x4 yv[8];
#pragma unroll
        for (int i = 0; i < 8; ++i) yv[i] = (f32x4){0.f, 0.f, 0.f, 0.f};
        for (int k = 0; k < 9; ++k) {
            int row;
            if (k < 8) { const int tp = p.tokpos[(size_t)t * 8 + k]; row = tab[80 + (tp >> 13)] + (tp & (CAP - 1)); } else row = tab[80 + NE] + t;
            const bf16_t* yr = p.Y2 + (size_t)row * D_;
#pragma unroll
            for (int i = 0; i < 8; ++i) { const u32x2 u = *(const u32x2*)(yr + i * 256 + lane * 4);
                yv[i][0] += __uint_as_float(u.x << 16); yv[i][1] += __uint_as_float(u.x & 0xffff0000u); yv[i][2] += __uint_as_float(u.y << 16); yv[i][3] += __uint_as_float(u.y & 0xffff0000u); }
        }
        float ss = 0.f;
#pragma unroll
        for (int i = 0; i < 8; ++i) ss += yv[i][0] * yv[i][0] + yv[i][1] * yv[i][1] + yv[i][2] * yv[i][2] + yv[i][3] * yv[i][3];
        ss = wave_sum(ss);
        const float ry = rsqrtf(ss * (1.0f / D_) + 1e-6f);
        float s2 = 0.f;
#pragma unroll
        for (int i = 0; i < 8; ++i) { const int e = i * 256 + lane * 4; const f32x4 xo = *(const f32x4*)(p.out + (size_t)t * D_ + e);
            const f32x4 gp = *(const f32x4*)(p.g_post_ffn + l * D_ + e), gf = *(const f32x4*)(md + 10240 + e);
#pragma unroll
            for (int j = 0; j < 4; ++j) { yv[i][j] = xo[j] + gf[j] * (yv[i][j] * ry * gp[j]); s2 += yv[i][j] * yv[i][j]; }
            *(f32x4*)(p.out + (size_t)t * D_ + e) = yv[i]; }
        if (l + 1 < 2) {
            s2 = wave_sum(s2);
            const float rx = rsqrtf(s2 * (1.0f / D_) + 1e-6f);
            const float* md1 = p.mod + ((size_t)(l + 1) * 4 + b) * 12288;
            emit_hn(yv, rx, p.g_pre_mix + (l + 1) * D_, md1 + 2048, md1, p.Hn + (size_t)t * D_, lane, nullptr);
        }
    }
}

#ifndef USE8_IN
#define USE8_IN 1
#endif
#ifndef USE8_OUT
#define USE8_OUT 1
#endif
#ifndef USE8_GU
#define USE8_GU 1
#endif
#ifndef USE8_DOWN
#define USE8_DOWN 1
#endif
__global__ __launch_bounds__(NTHR, 2) void k_fwd(Params p) {
#define PP() (*(const Params*)((const char*)&p + launder0()))
    extern __shared__ __attribute__((aligned(16))) unsigned char lds[];
    volatile LAS unsigned* xbw = (volatile LAS unsigned*)(lds + LDS_BYTES);
    if (threadIdx.x == 0) { xbw[0] = 0u; xbw[1] = 0u; xbw[2] = 0u; xbw[3] = 0u; }
    __syncthreads();
    (void)xcd_barrier_post(p.bar, xbw);
#define GRIDBAR() do { XcdBarrier _b; _b.bar = PP().bar; _b.x = xb_xcc_id(); _b.st = (volatile LAS unsigned*)(lds + LDS_BYTES); xcd_barrier(_b); } while (0)
    phase_adaln(PP(), lds);
    phase_convert(PP(), lds);
    GRIDBAR();
    phase_prenorm0(PP());
    GRIDBAR();
#pragma unroll 1
    for (int l = 0; l < 2; ++l) {
        if (USE8_IN) phase_gemm_in8(PP(), l, lds); else phase_gemm_in(PP(), l, lds);
        GRIDBAR();
        phase_attn_naive(PP());
        phase_rwkv_prep(PP(), l, lds);    GRIDBAR();
        phase_scan_naive(PP());           GRIDBAR();
        phase_post(PP(), l);              GRIDBAR();
        if (USE8_OUT) phase_gemm_out8(PP(), l, lds); else phase_gemm_out(PP(), l, lds);
        GRIDBAR();
        phase_res1_router(PP(), l, lds);  GRIDBAR();
        if (USE8_GU) phase_moe_gu8(PP(), l, lds); else phase_moe_gu(PP(), l, lds);
        GRIDBAR();
        if (USE8_DOWN) phase_moe_down8(PP(), l, lds); else phase_moe_down(PP(), l, lds);
        GRIDBAR();
        phase_combine(PP(), l, lds);      GRIDBAR();
    }
}

extern "C" void kernel_launch(void* const* d_in, const int* in_sizes, int n_in, void* d_out, int out_size, void* d_ws, size_t ws_size, hipStream_t stream) {
    Params p{};
    const float* const* in = (const float* const*)d_in;
    p.x = in[0]; p.c = in[1]; p.w_ada = in[2]; p.b_ada = in[3]; p.g_pre_mix = in[4]; p.g_post_mix = in[5]; p.g_pre_ffn = in[6]; p.g_post_ffn = in[7]; p.w_in = in[8]; p.w_out = in[9];
    p.lam_q1 = in[10]; p.lam_k1 = in[11]; p.lam_q2 = in[12]; p.lam_k2 = in[13]; p.subln_g = in[14]; p.mu = in[15]; p.w0 = in[16]; p.w2 = in[17]; p.a0 = in[18]; p.a2 = in[19]; p.g2 = in[20];
    p.k_k = in[21]; p.k_a = in[22]; p.r_k = in[23]; p.lnx_w = in[24]; p.lnx_b = in[25]; p.v0 = in[26]; p.v1 = in[27]; p.v2 = in[28];
    p.w_router = in[29]; p.router_bias = in[30]; p.w_eg = in[31]; p.w_eu = in[32]; p.w_ed = in[33]; p.w_sg = in[34]; p.w_su = in[35]; p.w_sd = in[36];
    p.out = (float*)d_out;
    unsigned char* ws = (unsigned char*)d_ws; size_t off = 0;
    auto take = [&](size_t bytes) { void* r = ws + off; off += (bytes + 255) & ~(size_t)255; return r; };
    p.bar = (unsigned*)take(16384);
    p.counts = (unsigned*)take(2 * NE * 4);
    p.mod = (float*)take((size_t)2 * 4 * 12288 * 4);
    p.Hn = (bf16_t*)take((size_t)T_ * D_ * 2);
    p.P = (bf16_t*)take((size_t)T_ * NIN * 2);
    p.sr = (float*)take((size_t)T_ * RW * 4); p.sw = (float*)take((size_t)T_ * RW * 4); p.sk = (float*)take((size_t)T_ * RW * 4); p.sv = (float*)take((size_t)T_ * RW * 4);
    p.sa = (float*)take((size_t)T_ * RW * 4); p.sb = (float*)take((size_t)T_ * RW * 4); p.sy = (float*)take((size_t)T_ * RW * 4); p.sg = (float*)take((size_t)T_ * RW * 4);
    p.vfirst = (float*)take((size_t)T_ * RW * 4);
    p.bcoef = (float*)take((size_t)T_ * 16 * 4);
    p.ocat = (bf16_t*)take((size_t)T_ * D_ * 2);
    p.mixed = (float*)take((size_t)T_ * D_ * 4);
    p.rowtok = (int*)take((size_t)NE * CAP * 4);
    p.rowg = (float*)take((size_t)NE * CAP * 4);
    p.tokpos = (int*)take((size_t)T_ * 8 * 4);
    p.H1 = (bf16_t*)take((size_t)PMAX * 512 * 2);
    p.Y2 = (bf16_t*)take((size_t)PMAX * D_ * 2);
    p.Vt = (bf16_t*)take((size_t)T_ * 1024 * 2);
    p.WinT = (bf16_t*)take((size_t)2 * NIN * D_ * 2);
    p.WoutT = (bf16_t*)take((size_t)2 * D_ * D_ * 2);
    p.WguT = (bf16_t*)take((size_t)2 * 65 * 1024 * D_ * 2);
    p.WdT = (bf16_t*)take((size_t)2 * 65 * D_ * 512 * 2);
    (void)hipMemsetAsync(p.bar, 0, 16384 + 2 * NE * 4 + 256, stream);
    static int grid = 0;
    if (!grid) {
        int dev = 0, cus = 0, per_cu = 0;
        (void)hipGetDevice(&dev);
        (void)hipDeviceGetAttribute(&cus, hipDeviceAttributeMultiprocessorCount, dev);
        (void)hipFuncSetAttribute((const void*)k_fwd, hipFuncAttributeMaxDynamicSharedMemorySize, LDS_BYTES + 16);
        (void)hipOccupancyMaxActiveBlocksPerMultiprocessor(&per_cu, k_fwd, NTHR, LDS_BYTES + 16);
        if (per_cu < 1) per_cu = 1;
        grid = cus;
    }
    k_fwd<<<grid, NTHR, LDS_BYTES + 16, stream>>>(p);
}
```

```cpp
#include <hip/hip_runtime.h>
#include <stdint.h>

typedef unsigned short bf16_t;
typedef short bf16x8 __attribute__((ext_vector_type(8)));
typedef float f32x4 __attribute__((ext_vector_type(4)));
typedef unsigned u32x4 __attribute__((ext_vector_type(4)));
typedef unsigned u32x2 __attribute__((ext_vector_type(2)));

#define T_    8192
#define D_    2048
#define S_    2048
#define NB_   4
#define NIN   6400
#define RW    1024
#define NE    64
#define CAP   8192
#define PMAX  90112
#define NTHR  512
#define NW_   (NTHR / 64)
#define TAB_OFF 131072
#define LDS_BYTES (131072 + 1024)

struct Params {
    const float *x, *c, *w_ada, *b_ada, *g_pre_mix, *g_post_mix, *g_pre_ffn, *g_post_ffn, *w_in, *w_out;
    const float *lam_q1, *lam_k1, *lam_q2, *lam_k2, *subln_g, *mu, *w0, *w2, *a0, *a2, *g2, *k_k, *k_a, *r_k, *lnx_w, *lnx_b, *v0, *v1, *v2;
    const float *w_router, *router_bias, *w_eg, *w_eu, *w_ed, *w_sg, *w_su, *w_sd;
    float* out;
    unsigned* bar;
    float* mod;
    bf16_t* Hn;
    bf16_t* P;
    float *sr, *sw, *sk, *sv, *sa, *sb, *sy, *sg, *vfirst;
    float* bcoef;
    bf16_t* ocat;
    float* mixed;
    unsigned* counts;
    int* rowtok;
    float* rowg;
    int* tokpos;
    bf16_t* H1;
    bf16_t* Y2;
    bf16_t* Vt;
    bf16_t* LRT;
    bf16_t *WinT, *WoutT, *WguT, *WdT;
};

__device__ __forceinline__ float bf2f(unsigned short h) { return __uint_as_float(((unsigned)h) << 16); }
__device__ __forceinline__ unsigned cvt_pk_bf16(float lo, float hi) { unsigned r; asm volatile("v_cvt_pk_bf16_f32 %0, %1, %2" : "=v"(r) : "v"(lo), "v"(hi)); return r; }
__device__ __forceinline__ float wave_sum(float v) {
#pragma unroll
    for (int o = 32; o > 0; o >>= 1) v += __shfl_xor(v, o);
    return v;
}
__device__ __forceinline__ float sigmoidf_(float x) { return 1.0f / (1.0f + __expf(-x)); }
#define RL(v, j) __int_as_float(__builtin_amdgcn_readlane(__float_as_int(v), (j)))
__device__ __forceinline__ int launder0() { int z = 0; asm volatile("" : "+s"(z)); return z; }
__device__ __forceinline__ int tid_() { int z = 0; asm volatile("" : "+v"(z)); return (int)threadIdx.x + z; }
__device__ __forceinline__ int bid_() { return (int)blockIdx.x + launder0(); }
__device__ __forceinline__ int nblk_() { return (int)gridDim.x + launder0(); }
__device__ __forceinline__ int rfl(int v) { return __builtin_amdgcn_readfirstlane(v); }


#define XB_TMO      128
#define XB_XCNT(j)  (256  + 64 * (j))
#define XB_XSUB(j)  (1280 + 64 * (j))
#define XB_XGEN(j)  (2304 + 64 * (j))
#define XB_TOP      3328
#define XB_TOPGEN   3392
#define XCD_BAR_WORDS 3456
#define XB_SPIN_CAP (1u << 18)
#define LAS __attribute__((address_space(3)))
__device__ __forceinline__ unsigned xb_ld(unsigned* p)              { return __hip_atomic_load(p, __ATOMIC_RELAXED, __HIP_MEMORY_SCOPE_AGENT); }
__device__ __forceinline__ unsigned xb_add(unsigned* p, unsigned v) { return __hip_atomic_fetch_add(p, v, __ATOMIC_RELAXED, __HIP_MEMORY_SCOPE_AGENT); }
__device__ __forceinline__ unsigned xb_xcc_id() { return (unsigned)__builtin_amdgcn_s_getreg((3 << 11) | 20) & 0xFu; }
#define XB_SPIN(cond, bar) do { unsigned _sp = 0; while (cond) { __builtin_amdgcn_s_sleep(1); \
    if ((++_sp & 255u) == 0u) { if (xb_ld(&(bar)[XB_TMO])) break; if (_sp > XB_SPIN_CAP) { atomicAdd(&(bar)[XB_TMO], 1u); break; } } } } while (0)
struct XcdBarrier { unsigned* bar; unsigned x; volatile LAS unsigned* st; };
__device__ __forceinline__ XcdBarrier xcd_barrier_post(unsigned* bar, volatile LAS unsigned* st) {
    XcdBarrier b; b.bar = bar; b.x = xb_xcc_id(); b.st = st;
    if (threadIdx.x == 0) (void)xb_add(&bar[XB_XCNT(b.x)], 1u);
    return b;
}
__device__ __forceinline__ void xcd_barrier_complete(unsigned* bar, unsigned x, unsigned& nloc, unsigned& nx) {
    const unsigned G = gridDim.x * gridDim.y * gridDim.z;
    unsigned sum, cnt, mine, sp = 0u;
    for (;;) {
        sum = 0u; cnt = 0u; mine = 0u;
#pragma unroll
        for (unsigned j = 0; j < 16; ++j) { const unsigned c = xb_ld(&bar[XB_XCNT(j)]); sum += c; cnt += (c > 0u) ? 1u : 0u; mine = (j == x) ? c : mine; }
        if (sum == G) break;
        __builtin_amdgcn_s_sleep(1);
        if ((++sp & 255u) == 0u) { if (xb_ld(&bar[XB_TMO])) break; if (sp > XB_SPIN_CAP) { atomicAdd(&bar[XB_TMO], 1u); break; } }
    }
    nloc = mine > 0u ? mine : 1u; nx = cnt > 0u ? cnt : 1u;
}
__device__ __forceinline__ void xcd_barrier(const XcdBarrier& b) {
    asm volatile("s_waitcnt vmcnt(0)" ::: "memory");
    __syncthreads();
    if (threadIdx.x == 0) {
        unsigned* bar = b.bar;
        __builtin_amdgcn_s_waitcnt(0);
        unsigned nloc = b.st[0], nx = b.st[1];
        if (nloc == 0u) { xcd_barrier_complete(bar, b.x, nloc, nx); b.st[0] = nloc; b.st[1] = nx; }
        const unsigned old = xb_add(&bar[XB_XSUB(b.x)], 1u);
        const unsigned gen = old / nloc;
        if (old + 1u == (gen + 1u) * nloc) {
            __builtin_amdgcn_fence(__ATOMIC_RELEASE, "agent");
            asm volatile("s_waitcnt vmcnt(0)" ::: "memory");
            const unsigned og = xb_add(&bar[XB_TOP], 1u);
            const unsigned tg = og / nx;
            if (og + 1u == (tg + 1u) * nx) xb_add(&bar[XB_TOPGEN], 1u);
            else XB_SPIN(xb_ld(&bar[XB_TOPGEN]) == tg, bar);
            __builtin_amdgcn_fence(__ATOMIC_ACQUIRE, "agent");
            xb_add(&bar[XB_XGEN(b.x)], 1u);
            asm volatile("s_waitcnt vmcnt(0)" ::: "memory");
        } else {
            XB_SPIN(xb_ld(&bar[XB_XGEN(b.x)]) == gen, bar);
            __builtin_amdgcn_fence(__ATOMIC_ACQUIRE, "agent");
            asm volatile("s_waitcnt vmcnt(0)" ::: "memory");
        }
    }
    __syncthreads();
}

#define GT_ROWB 144
template <class ARow, class Epi>
__device__ __forceinline__ void gemm_tile(unsigned char* lds, const bf16_t* A, int lda, ARow arow, const float* bp, int ldb, int K, Epi epi) {
    const int tid = tid_(), lane = tid & 63, wid = tid >> 6, wm = wid >> 1, wn = wid & 1, fr = lane & 15, fq = lane >> 4;
    if (tid >= 256) { for (int i = 0; i < 2 * (K >> 6) + 1; ++i) __syncthreads(); return; }
    unsigned char* sA = lds;
    unsigned char* sB = lds + 128 * GT_ROWB;
    const bf16_t* ap[4];
    int aoff[4];
#pragma unroll
    for (int i = 0; i < 4; ++i) { const int ch = tid + i * 256, r = ch >> 3, kc = ch & 7; ap[i] = A + (size_t)arow(r) * lda + kc * 8; aoff[i] = r * GT_ROWB + kc * 16; }
    const int bn = tid & 127, bkh = tid >> 7;
    const float* bq = bp + (size_t)(bkh * 32) * ldb;
    const int boff = bn * GT_ROWB + bkh * 64;
    f32x4 acc[4][4];
#pragma unroll
    for (int i = 0; i < 4; ++i)
#pragma unroll
        for (int j = 0; j < 4; ++j) acc[i][j] = (f32x4){0.f, 0.f, 0.f, 0.f};
    u32x4 ra[4]; float rb[32];
    const int nk = K >> 6;
#pragma unroll
    for (int i = 0; i < 4; ++i) ra[i] = *(const u32x4*)(ap[i]);
#pragma unroll
    for (int i = 0; i < 32; ++i) rb[i] = bq[(size_t)i * ldb];
    for (int kt = 0; kt < nk; ++kt) {
        __syncthreads();
#pragma unroll
        for (int i = 0; i < 4; ++i) *(u32x4*)(sA + aoff[i]) = ra[i];
#pragma unroll
        for (int g = 0; g < 4; ++g) { u32x4 w; w.x = cvt_pk_bf16(rb[g * 8 + 0], rb[g * 8 + 1]); w.y = cvt_pk_bf16(rb[g * 8 + 2], rb[g * 8 + 3]); w.z = cvt_pk_bf16(rb[g * 8 + 4], rb[g * 8 + 5]); w.w = cvt_pk_bf16(rb[g * 8 + 6], rb[g * 8 + 7]);
            *(u32x4*)(sB + boff + g * 16) = w; }
        __syncthreads();
        if (kt + 1 < nk) {
#pragma unroll
            for (int i = 0; i < 4; ++i) ra[i] = *(const u32x4*)(ap[i] + (size_t)(kt + 1) * 64);
            const float* bqq = bq + (size_t)(kt + 1) * 64 * ldb;
#pragma unroll
            for (int i = 0; i < 32; ++i) rb[i] = bqq[(size_t)i * ldb];
        }
#pragma unroll
        for (int ks = 0; ks < 2; ++ks) {
            bf16x8 af[4], bfr[4];
#pragma unroll
            for (int i = 0; i < 4; ++i) af[i] = *(const bf16x8*)(sA + (wm * 64 + i * 16 + fr) * GT_ROWB + ks * 64 + fq * 16);
#pragma unroll
            for (int j = 0; j < 4; ++j) bfr[j] = *(const bf16x8*)(sB + (wn * 64 + j * 16 + fr) * GT_ROWB + ks * 64 + fq * 16);
#pragma unroll
            for (int i = 0; i < 4; ++i)
#pragma unroll
                for (int j = 0; j < 4; ++j) acc[i][j] = __builtin_amdgcn_mfma_f32_16x16x32_bf16(bfr[j], af[i], acc[i][j], 0, 0, 0);
        }
    }
#pragma unroll
    for (int i = 0; i < 4; ++i)
#pragma unroll
        for (int j = 0; j < 4; ++j) epi(wm * 64 + i * 16 + fr, wn * 64 + j * 16 + fq * 4, acc[i][j]);
    __syncthreads();
}

namespace gp {
constexpr int BM = 256, BK = 64, HALF = 128, HTB = HALF * BK * 2, STAGE_BYTES = 8 * HTB;
__device__ __forceinline__ int lds_byte(int r, int c) { const int st = (r >> 4) * 2 + (c >> 5), rr = r & 15, cc = c & 31, ob = rr * 64 + cc * 2; return st * 1024 + (ob ^ (((ob >> 9) & 1) << 5)); }
__device__ __forceinline__ void stage_rc(int b, int& R, int& C) { const int st = b / 1024, sb = b % 1024, swz = sb ^ (((sb >> 9) & 1) << 5); R = (st >> 1) * 16 + swz / 64; C = (st & 1) * 32 + (swz % 64) / 2; }
__device__ __forceinline__ int perm32(int rho) { const int n = rho >> 4, i = rho & 15; return 8 * (i >> 2) + 4 * n + (i & 3); }
struct Unit { int pm, pn, e; };
typedef f32x4 Acc[2][2][4][2];

template <bool GATHER, bool PERM, class Sched, class Epi>
__device__ __forceinline__ void gemm_phase(LAS unsigned char* lds, const int K, const Sched& S, const Epi& E) {
    const int tid = tid_(), wid = rfl(tid >> 6), lane = tid & 63, wr = wid >> 2, wc = wid & 3, fr = lane & 15, fq = lane >> 4;
    const int nt = K / BK;
    int Rr[2], Cc[2]; unsigned voffB[2];
#pragma unroll
    for (int i = 0; i < 2; ++i) { int R, C; stage_rc(tid * 16 + i * 8192, R, C); Rr[i] = R; Cc[i] = C; const int Rb = PERM ? ((R & ~31) + perm32(R & 31)) : R; voffB[i] = (unsigned)(Rb * K + C) * 2u; }
    const size_t kstep = (size_t)(BK * 2);
    const size_t hstep = (size_t)HALF * K * 2;
    const unsigned ldsw = (unsigned)wid * 1024u;
    const int aoff = lds_byte(wr * 64 + fr, fq * 8), boff = lds_byte(wc * 32 + fr, fq * 8);
#define GP_SA(b, h) (((b) * 2 + (h)) * HTB)
#define GP_SB(b, h) ((4 + (b) * 2 + (h)) * HTB)
#define GP_STAGE(bufoff, gbase, voff) do { _Pragma("unroll") for (int _i = 0; _i < 2; ++_i) \
        __builtin_amdgcn_global_load_lds((const unsigned*)((const char*)(gbase) + (voff)[_i]), (LAS unsigned*)(lds + (bufoff) + ldsw + _i * 8192), 16, 0, 0); } while (0)
#define GP_LDA(dst, b, h) do { _Pragma("unroll") for (int m = 0; m < 4; ++m) _Pragma("unroll") for (int k = 0; k < 2; ++k) dst[m][k] = *(const LAS bf16x8*)(lds + GP_SA(b, h) + aoff + m * 2048 + k * 1024); } while (0)
#define GP_LDB(dst, b, h) do { _Pragma("unroll") for (int n = 0; n < 2; ++n) _Pragma("unroll") for (int k = 0; k < 2; ++k) dst[n][k] = *(const LAS bf16x8*)(lds + GP_SB(b, h) + boff + n * 2048 + k * 1024); } while (0)
#define GP_MMA(ai, bj, At, Bt) do { __builtin_amdgcn_s_setprio(1); _Pragma("unroll") for (int m = 0; m < 4; ++m) _Pragma("unroll") for (int n = 0; n < 2; ++n) _Pragma("unroll") for (int k = 0; k < 2; ++k) \
        acc[ai][bj][m][n] = __builtin_amdgcn_mfma_f32_16x16x32_bf16(Bt[n][k], At[m][k], acc[ai][bj][m][n], 0, 0, 0); __builtin_amdgcn_s_setprio(0); } while (0)
#define GP_WAIT_V(n) asm volatile("s_waitcnt vmcnt(" #n ")" ::: "memory")
#define GP_WAIT_L(n) asm volatile("s_waitcnt lgkmcnt(" #n ")" ::: "memory")
#define GP_BAR __builtin_amdgcn_s_barrier()
#define GP_SCHED __builtin_amdgcn_sched_barrier(0)
#define GP_VOFF(u, v) do { _Pragma("unroll") for (int _h = 0; _h < 2; ++_h) _Pragma("unroll") for (int _i = 0; _i < 2; ++_i) { \
        const int _row = GATHER ? S.a_row(u, _h * 128 + Rr[_i]) : (_h * 128 + Rr[_i]); v[_h][_i] = (unsigned)(_row * K + Cc[_i]) * 2u; } } while (0)
    Unit cur, nxt; int ui = 0;
    if (!S.next(0, cur)) return;
    Acc acc;
#pragma unroll
    for (int a = 0; a < 2; ++a)
#pragma unroll
        for (int b = 0; b < 2; ++b)
#pragma unroll
            for (int m = 0; m < 4; ++m)
#pragma unroll
                for (int n = 0; n < 2; ++n) acc[a][b][m][n] = (f32x4){0.f, 0.f, 0.f, 0.f};
    bf16x8 At[4][2], B0[2][2], B1[2][2];
    unsigned vA[2][2], vAn[2][2];
    const char* cA = S.a_base(cur); const char* cB = S.b_base(cur);
    GP_VOFF(cur, vA);
    GP_STAGE(GP_SB(0, 0), cB, voffB); GP_STAGE(GP_SA(0, 0), cA, vA[0]); GP_STAGE(GP_SB(0, 1), cB + hstep, voffB); GP_STAGE(GP_SA(0, 1), cA, vA[1]);
    if (wr == 1) GP_BAR;
    GP_WAIT_V(4); GP_BAR;
    GP_STAGE(GP_SB(1, 0), cB + kstep, voffB); GP_STAGE(GP_SA(1, 0), cA + kstep, vA[0]); GP_STAGE(GP_SB(1, 1), cB + hstep + kstep, voffB);
    GP_WAIT_V(6); GP_BAR;
    for (;;) {
        const bool has_next = S.next(ui + 1, nxt);
        const char* nA = has_next ? S.a_base(nxt) : cA; const char* nB = has_next ? S.b_base(nxt) : cB;
        if (GATHER) { if (has_next) { GP_VOFF(nxt, vAn); } else { vAn[0][0] = vA[0][0]; vAn[0][1] = vA[0][1]; vAn[1][0] = vA[1][0]; vAn[1][1] = vA[1][1]; } }
        for (int t = 0; t < nt; t += 2) {
            const bool last = (t == nt - 2);
            const char* a1 = cA + (size_t)(t + 1) * kstep;
            const char* a2 = last ? nA : cA + (size_t)(t + 2) * kstep; const char* b2 = last ? nB : cB + (size_t)(t + 2) * kstep;
            const char* a3 = a2 + kstep; const char* b3 = b2 + kstep;
            unsigned v2[2][2];
#pragma unroll
            for (int h = 0; h < 2; ++h)
#pragma unroll
                for (int i = 0; i < 2; ++i) v2[h][i] = (GATHER && last) ? vAn[h][i] : vA[h][i];
            GP_LDB(B0, 0, 0); GP_SCHED; GP_LDA(At, 0, 0); GP_STAGE(GP_SA(1, 1), a1, vA[1]);
            GP_WAIT_L(8); GP_BAR; GP_WAIT_L(0); GP_MMA(0, 0, At, B0); GP_BAR; GP_SCHED;
            GP_LDB(B1, 0, 1); GP_STAGE(GP_SB(0, 0), b2, voffB);
            GP_BAR; GP_WAIT_L(0); GP_MMA(0, 1, At, B1); GP_BAR;
            GP_LDA(At, 0, 1); GP_STAGE(GP_SA(0, 0), a2, v2[0]);
            GP_BAR; GP_WAIT_L(0); GP_MMA(1, 0, At, B0); GP_BAR; GP_SCHED;
            GP_STAGE(GP_SB(0, 1), b2 + hstep, voffB);
            GP_WAIT_V(6); GP_BAR; GP_MMA(1, 1, At, B1); GP_BAR;
            GP_LDB(B0, 1, 0); GP_SCHED; GP_LDA(At, 1, 0); GP_STAGE(GP_SA(0, 1), a2, v2[1]);
            GP_WAIT_L(8); GP_BAR; GP_WAIT_L(0); GP_MMA(0, 0, At, B0); GP_BAR; GP_SCHED;
            GP_LDB(B1, 1, 1); GP_STAGE(GP_SB(1, 0), b3, voffB);
            GP_BAR; GP_WAIT_L(0); GP_MMA(0, 1, At, B1); GP_BAR;
            GP_LDA(At, 1, 1); GP_STAGE(GP_SA(1, 0), a3, v2[0]);
            GP_BAR; GP_WAIT_L(0); GP_MMA(1, 0, At, B0); GP_BAR; GP_SCHED;
            GP_STAGE(GP_SB(1, 1), b3 + hstep, voffB);
            GP_WAIT_V(6); GP_BAR; GP_MMA(1, 1, At, B1); GP_BAR;
        }
        E(acc, cur, wr, wc, fr, fq);
        if (!has_next) break;
#pragma unroll
        for (int a = 0; a < 2; ++a)
#pragma unroll
            for (int b = 0; b < 2; ++b)
#pragma unroll
                for (int m = 0; m < 4; ++m)
#pragma unroll
                    for (int n = 0; n < 2; ++n) acc[a][b][m][n] = (f32x4){0.f, 0.f, 0.f, 0.f};
        cur = nxt; cA = nA; cB = nB; ++ui;
        if (GATHER) { vA[0][0] = vAn[0][0]; vA[0][1] = vAn[0][1]; vA[1][0] = vAn[1][0]; vA[1][1] = vAn[1][1]; }
    }
    GP_WAIT_V(0);
    if (wr == 0) GP_BAR;
    GP_BAR;
#undef GP_SA
#undef GP_SB
#undef GP_STAGE
#undef GP_LDA
#undef GP_LDB
#undef GP_MMA
#undef GP_WAIT_V
#undef GP_WAIT_L
#undef GP_BAR
#undef GP_SCHED
#undef GP_VOFF
}

struct DenseSched {
    const bf16_t* A; const bf16_t* Bt; int K, nM, nN, nwg, G, c;
    __device__ __forceinline__ void init(const bf16_t* A_, const bf16_t* Bt_, int M, int N, int K_, int G_, int c_) { A = A_; Bt = Bt_; K = K_; nM = M / BM; nN = N / BM; nwg = nM * nN; G = G_; c = c_; }
    __device__ __forceinline__ bool next(int i, Unit& u) const {
        const long L = (long)i * G + c; if (L >= nwg) return false;
        int wgid = (int)L; { const int q = nwg / 8, r = nwg % 8, xcd = wgid % 8, off = wgid / 8; wgid = (xcd < r ? xcd * (q + 1) : r * (q + 1) + (xcd - r) * q) + off; }
        const int nig = 8 * nN, gid = wgid / nig, fm = gid * 8, gsz = (nM - fm) < 8 ? (nM - fm) : 8;
        u.pm = fm + ((wgid % nig) % gsz); u.pn = (wgid % nig) / gsz; u.e = 0; return true;
    }
    __device__ __forceinline__ const char* a_base(const Unit& u) const { return (const char*)A + (size_t)u.pm * BM * K * 2; }
    __device__ __forceinline__ const char* b_base(const Unit& u) const { return (const char*)Bt + (size_t)u.pn * BM * K * 2; }
    __device__ __forceinline__ int a_row(const Unit&, int r) const { return r; }
};
}

__device__ __forceinline__ void cvt_item(const float* W, int N, int K, bf16_t* Wt, int rowmul, int rowadd, int it, unsigned char* scr, int lane) {
    const int nkt = K >> 6, ntile = it / nkt, kt = it - ntile * nkt, k0 = kt * 64, n0 = ntile * 64;
    const float* src = W + (size_t)k0 * N + n0 + lane;
    float v[64];
#pragma unroll
    for (int k = 0; k < 64; ++k) v[k] = src[(size_t)k * N];
#pragma unroll
    for (int g = 0; g < 8; ++g) { u32x4 w; w.x = cvt_pk_bf16(v[g * 8 + 0], v[g * 8 + 1]); w.y = cvt_pk_bf16(v[g * 8 + 2], v[g * 8 + 3]); w.z = cvt_pk_bf16(v[g * 8 + 4], v[g * 8 + 5]); w.w = cvt_pk_bf16(v[g * 8 + 6], v[g * 8 + 7]);
        *(u32x4*)(scr + lane * 144 + g * 16) = w; }
    __builtin_amdgcn_s_waitcnt(0); __builtin_amdgcn_wave_barrier();
#pragma unroll
    for (int j = 0; j < 8; ++j) { const int n = (lane >> 3) + 8 * j, kc = lane & 7; const u32x4 w = *(const u32x4*)(scr + n * 144 + kc * 16);
        *(u32x4*)(Wt + (size_t)((n0 + n) * rowmul + rowadd) * K + k0 + kc * 8) = w; }
    __builtin_amdgcn_s_waitcnt(0); __builtin_amdgcn_wave_barrier();
}
__device__ __forceinline__ void phase_convert(const Params& p, unsigned char* lds) {
    const int tid = tid_(), lane = tid & 63, w = tid >> 6, gw = bid_() * NW_ + w, nw = nblk_() * NW_;
    unsigned char* scr = lds + w * 9216;
    constexpr int I_IN = 32 * 100, I_OUT = 32 * 32, I_GU = 32 * 8, I_D = 8 * 32;
    constexpr int PER_L = I_IN + I_OUT + 65 * 2 * I_GU + 65 * I_D;
    for (int it0 = gw; it0 < 2 * PER_L; it0 += nw) {
        const int l = it0 / PER_L; int r = it0 - l * PER_L;
        if (r < I_IN) { cvt_item(p.w_in + (size_t)l * D_ * NIN, NIN, D_, p.WinT + (size_t)l * NIN * D_, 1, 0, r, scr, lane); continue; } r -= I_IN;
        if (r < I_OUT) { cvt_item(p.w_out + (size_t)l * D_ * D_, D_, D_, p.WoutT + (size_t)l * D_ * D_, 1, 0, r, scr, lane); continue; } r -= I_OUT;
        if (r < 65 * 2 * I_GU) { const int e = r / (2 * I_GU), rr = r - e * 2 * I_GU, which = rr / I_GU, ri = rr - which * I_GU;
            const float* src = (e < NE) ? ((which ? p.w_eu : p.w_eg) + (size_t)(l * NE + e) * D_ * 512) : ((which ? p.w_su : p.w_sg) + (size_t)l * D_ * 512);
            cvt_item(src, 512, D_, p.WguT + (size_t)(l * 65 + e) * 1024 * D_, 2, which, ri, scr, lane); continue; } r -= 65 * 2 * I_GU;
        { const int e = r / I_D, ri = r - e * I_D;
            const float* src = (e < NE) ? (p.w_ed + (size_t)(l * NE + e) * 512 * D_) : (p.w_sd + (size_t)l * 512 * D_);
            cvt_item(src, D_, 512, p.WdT + (size_t)(l * 65 + e) * D_ * 512, 1, 0, ri, scr, lane); }
    }
    for (int idx = bid_() * NTHR + tid; idx < 2 * 1024 * 288; idx += nblk_() * NTHR) {
        const int l = idx / (1024 * 288), r = idx - l * (1024 * 288), col = r / 288, k = r - col * 288;
        float v;
        if (k < 64) v = p.w2[((size_t)l * 64 + k) * RW + col]; else if (k < 128) v = p.a2[((size_t)l * 64 + (k - 64)) * RW + col]; else if (k < 256) v = p.g2[((size_t)l * 128 + (k - 128)) * RW + col];
        else v = (l > 0) ? p.v2[(size_t)(k - 256) * RW + col] : 0.f;
        p.LRT[idx] = (bf16_t)(cvt_pk_bf16(v, v) & 0xffffu);
    }
}

struct EpiIn {
    bf16_t* P; bf16_t* Vt;
    __device__ __forceinline__ void operator()(const gp::Acc& acc, const gp::Unit& u, int wr, int wc, int fr, int fq) const {
        const int row0 = u.pm * 256 + wr * 64 + fr, col0 = u.pn * 256 + wc * 32 + 8 * fq;
        const bool isv = (u.pn >= 8 && u.pn < 12);
#pragma unroll
        for (int ai = 0; ai < 2; ++ai)
#pragma unroll
            for (int m = 0; m < 4; ++m) { const int row = row0 + ai * 128 + m * 16; bf16_t* rowp = P + (size_t)row * NIN + col0;
#pragma unroll
                for (int bj = 0; bj < 2; ++bj) { const f32x4 v0 = acc[ai][bj][m][0], v1 = acc[ai][bj][m][1];
                    u32x4 w; w.x = cvt_pk_bf16(v0[0], v0[1]); w.y = cvt_pk_bf16(v0[2], v0[3]); w.z = cvt_pk_bf16(v1[0], v1[1]); w.w = cvt_pk_bf16(v1[2], v1[3]);
                    *(u32x4*)(rowp + bj * 128) = w;
                    if (isv) { const int b = row >> 11, s = row & 2047, h = (u.pn - 8) * 2 + bj, dv = wc * 32 + 8 * fq;
                        bf16_t* vp = Vt + ((size_t)(b * 8 + h) * 128 + dv) * S_ + s;
                        vp[0] = (bf16_t)(w.x & 0xffffu); vp[S_] = (bf16_t)(w.x >> 16); vp[2 * S_] = (bf16_t)(w.y & 0xffffu); vp[3 * S_] = (bf16_t)(w.y >> 16);
                        vp[4 * S_] = (bf16_t)(w.z & 0xffffu); vp[5 * S_] = (bf16_t)(w.z >> 16); vp[6 * S_] = (bf16_t)(w.w & 0xffffu); vp[7 * S_] = (bf16_t)(w.w >> 16); } } }
    }
};
struct EpiF32 {
    float* C; int ldc;
    __device__ __forceinline__ void operator()(const gp::Acc& acc, const gp::Unit& u, int wr, int wc, int fr, int fq) const {
        const int row0 = u.pm * 256 + wr * 64 + fr, col0 = u.pn * 256 + wc * 32 + 4 * fq;
#pragma unroll
        for (int ai = 0; ai < 2; ++ai)
#pragma unroll
            for (int m = 0; m < 4; ++m) { float* rowp = C + (size_t)(row0 + ai * 128 + m * 16) * ldc + col0;
#pragma unroll
                for (int bj = 0; bj < 2; ++bj)
#pragma unroll
                    for (int n = 0; n < 2; ++n) *(f32x4*)(rowp + bj * 128 + n * 16) = acc[ai][bj][m][n]; }
    }
};
__device__ __forceinline__ void phase_gemm_in8(const Params& p, int l, unsigned char* lds) {
    gp::DenseSched S; S.init(p.Hn, p.WinT + (size_t)l * NIN * D_, T_, NIN, D_, nblk_(), bid_());
    EpiIn E{p.P, p.Vt};
    gp::gemm_phase<false, true>((LAS unsigned char*)lds, D_, S, E);
}
__device__ __forceinline__ void phase_gemm_out8(const Params& p, int l, unsigned char* lds) {
    gp::DenseSched S; S.init(p.ocat, p.WoutT + (size_t)l * D_ * D_, T_, D_, D_, nblk_(), bid_());
    EpiF32 E{p.mixed, D_};
    gp::gemm_phase<false, false>((LAS unsigned char*)lds, D_, S, E);
}

__device__ __forceinline__ void build_tables(const Params& p, int l, int* tab, int tshift) {
    if (tid_() == 0) {
        int pb = 0, tb = 0;
        for (int e = 0; e <= NE; ++e) { const int c = (e < NE) ? (int)__hip_atomic_load(p.counts + l * NE + e, __ATOMIC_RELAXED, __HIP_MEMORY_SCOPE_AGENT) : T_;
            tab[e] = c; tab[80 + e] = pb; tab[160 + e] = tb; pb += (c + 255) & ~255; tb += (c + (1 << tshift) - 1) >> tshift; }
        tab[80 + NE + 1] = pb; tab[160 + NE + 1] = tb;
    }
    __syncthreads();
}
__device__ __forceinline__ int find_expert(const int* tab, int rt) { int e = 0; while (e < NE && rt >= tab[160 + e + 1]) ++e; return e; }

struct MoeSched {
    const int* tab; const char* A; const char* Bt; size_t bt_stride; const int* rowtok; int K, nN, nunits, G, c; bool gather;
    __device__ __forceinline__ bool next(int i, gp::Unit& u) const {
        const int L = i * G + c; if (L >= nunits) return false;
        const int rtg = L / nN; u.pn = L - rtg * nN; const int e = find_expert(tab, rtg); u.e = e; u.pm = rtg - tab[160 + e]; return true;
    }
    __device__ __forceinline__ const char* a_base(const gp::Unit& u) const { return gather ? A : A + (size_t)(tab[80 + u.e] + u.pm * 256) * K * 2; }
    __device__ __forceinline__ const char* b_base(const gp::Unit& u) const { return Bt + (size_t)u.e * bt_stride + (size_t)u.pn * 256 * K * 2; }
    __device__ __forceinline__ int a_row(const gp::Unit& u, int r) const { const int slot = u.pm * 256 + r; return (slot < tab[u.e]) ? ((u.e < NE) ? rowtok[u.e * CAP + slot] : slot) : 0; }
};
struct EpiSwiglu {
    bf16_t* H1; const int* tab;
    __device__ __forceinline__ void operator()(const gp::Acc& acc, const gp::Unit& u, int wr, int wc, int fr, int fq) const {
        const int row0 = tab[80 + u.e] + u.pm * 256 + wr * 64 + fr, hid0 = u.pn * 128 + wc * 16 + 4 * fq;
#pragma unroll
        for (int ai = 0; ai < 2; ++ai)
#pragma unroll
            for (int m = 0; m < 4; ++m) { bf16_t* rowp = H1 + (size_t)(row0 + ai * 128 + m * 16) * 512 + hid0;
#pragma unroll
                for (int bj = 0; bj < 2; ++bj) { const f32x4 v0 = acc[ai][bj][m][0], v1 = acc[ai][bj][m][1];
                    const float h0 = v0[0] / (1.0f + __expf(-v0[0])) * v0[1], h1 = v0[2] / (1.0f + __expf(-v0[2])) * v0[3];
                    const float h2 = v1[0] / (1.0f + __expf(-v1[0])) * v1[1], h3 = v1[2] / (1.0f + __expf(-v1[2])) * v1[3];
                    u32x2 o; o.x = cvt_pk_bf16(h0, h1); o.y = cvt_pk_bf16(h2, h3);
                    *(u32x2*)(rowp + bj * 64) = o; } }
    }
};
struct EpiDown {
    bf16_t* Y2; const int* tab; const float* rowg;
    __device__ __forceinline__ void operator()(const gp::Acc& acc, const gp::Unit& u, int wr, int wc, int fr, int fq) const {
        const int slot0 = u.pm * 256 + wr * 64 + fr, pb = tab[80 + u.e], cnt = tab[u.e], col0 = u.pn * 256 + wc * 32 + 8 * fq;
#pragma unroll
        for (int ai = 0; ai < 2; ++ai)
#pragma unroll
            for (int m = 0; m < 4; ++m) { const int slot = slot0 + ai * 128 + m * 16;
                const float g = (slot < cnt) ? ((u.e < NE) ? rowg[u.e * CAP + slot] : 1.0f) : 0.f;
                bf16_t* rowp = Y2 + (size_t)(pb + slot) * D_ + col0;
#pragma unroll
                for (int bj = 0; bj < 2; ++bj) { const f32x4 v0 = acc[ai][bj][m][0] * g, v1 = acc[ai][bj][m][1] * g;
                    u32x4 w; w.x = cvt_pk_bf16(v0[0], v0[1]); w.y = cvt_pk_bf16(v0[2], v0[3]); w.z = cvt_pk_bf16(v1[0], v1[1]); w.w = cvt_pk_bf16(v1[2], v1[3]);
                    *(u32x4*)(rowp + bj * 128) = w; } }
    }
};
__device__ __forceinline__ int xcd_order(int c, int G) { return (G % 8 == 0) ? (c % 8) * (G / 8) + c / 8 : c; }
__device__ __forceinline__ void phase_moe_gu8(const Params& p, int l, unsigned char* lds) {
    int* tab = (int*)(lds + TAB_OFF);
    build_tables(p, l, tab, 8);
    MoeSched S{tab, (const char*)p.Hn, (const char*)(p.WguT + (size_t)l * 65 * 1024 * D_), (size_t)1024 * D_ * 2, p.rowtok, D_, 4, tab[160 + NE + 1] * 4, nblk_(), xcd_order(bid_(), nblk_()), true};
    EpiSwiglu E{p.H1, tab};
    gp::gemm_phase<true, true>((LAS unsigned char*)lds, D_, S, E);
}
__device__ __forceinline__ void phase_moe_down8(const Params& p, int l, unsigned char* lds) {
    int* tab = (int*)(lds + TAB_OFF);
    build_tables(p, l, tab, 8);
    MoeSched S{tab, (const char*)p.H1, (const char*)(p.WdT + (size_t)l * 65 * D_ * 512), (size_t)D_ * 512 * 2, p.rowtok, 512, 8, tab[160 + NE + 1] * 8, nblk_(), xcd_order(bid_(), nblk_()), false};
    EpiDown E{p.Y2, tab, p.rowg};
    gp::gemm_phase<false, true>((LAS unsigned char*)lds, 512, S, E);
}

__device__ __forceinline__ void phase_adaln(const Params& p, unsigned char* lds) {
    float* cond = (float*)lds;
    float* red = cond + 4 * D_;
    const int tid = tid_(), lane = tid & 63, w = tid >> 6;
    for (int i = tid; i < 4 * D_; i += NTHR) { const float v = p.c[i]; cond[i] = v / (1.0f + __expf(-v)); }
    __syncthreads();
    for (int unit = bid_(); unit < 2 * 192; unit += nblk_()) {
        const int l = unit / 192, n = (unit % 192) * 64 + lane;
        const float* W = p.w_ada + (size_t)l * D_ * 12288 + n;
        float a0 = 0.f, a1 = 0.f, a2 = 0.f, a3 = 0.f;
        const int k0 = w * (D_ / NW_);
#pragma unroll 8
        for (int k = k0; k < k0 + D_ / NW_; ++k) { const float wv = W[(size_t)k * 12288]; a0 += cond[k] * wv; a1 += cond[D_ + k] * wv; a2 += cond[2 * D_ + k] * wv; a3 += cond[3 * D_ + k] * wv; }
        red[(w * 4 + 0) * 64 + lane] = a0; red[(w * 4 + 1) * 64 + lane] = a1; red[(w * 4 + 2) * 64 + lane] = a2; red[(w * 4 + 3) * 64 + lane] = a3;
        __syncthreads();
        if (w < 4) {
            float s = 0.f;
#pragma unroll
            for (int ww = 0; ww < NW_; ++ww) s += red[(ww * 4 + w) * 64 + lane];
            p.mod[((size_t)l * 4 + w) * 12288 + n] = s + p.b_ada[(size_t)l * 12288 + n];
        }
        __syncthreads();
    }
}

__device__ __forceinline__ void emit_hn(const f32x4 (&xv)[8], float rstd, const float* g, const float* sc, const float* sh, bf16_t* dst, int lane, float* hf) {
#pragma unroll
    for (int i = 0; i < 8; ++i) {
        const int e = i * 256 + lane * 4;
        const f32x4 gv = *(const f32x4*)(g + e), scv = *(const f32x4*)(sc + e), shv = *(const f32x4*)(sh + e);
        f32x4 h;
#pragma unroll
        for (int j = 0; j < 4; ++j) h[j] = xv[i][j] * rstd * gv[j] * (1.0f + scv[j]) + shv[j];
        u32x2 o; o.x = cvt_pk_bf16(h[0], h[1]); o.y = cvt_pk_bf16(h[2], h[3]);
        *(u32x2*)(dst + e) = o;
        if (hf) *(f32x4*)(hf + e) = h;
    }
}

__device__ __forceinline__ void phase_prenorm0(const Params& p) {
    const int lane = tid_() & 63, gw = bid_() * (NTHR / 64) + (tid_() >> 6), nw = nblk_() * (NTHR / 64);
    for (int t = gw; t < T_; t += nw) {
        const int b = t / S_;
        f32x4 xv[8]; float ss = 0.f;
#pragma unroll
        for (int i = 0; i < 8; ++i) { xv[i] = *(const f32x4*)(p.x + (size_t)t * D_ + i * 256 + lane * 4); ss += xv[i][0] * xv[i][0] + xv[i][1] * xv[i][1] + xv[i][2] * xv[i][2] + xv[i][3] * xv[i][3]; }
        ss = wave_sum(ss);
        const float rstd = rsqrtf(ss * (1.0f / D_) + 1e-6f);
        const float* md = p.mod + (size_t)b * 12288;
        emit_hn(xv, rstd, p.g_pre_mix, md + 2048, md, p.Hn + (size_t)t * D_, lane, nullptr);
    }
}

__device__ __forceinline__ void phase_gemm_in(const Params& p, int l, unsigned char* lds) {
    const float* B = p.w_in + (size_t)l * D_ * NIN;
    for (int unit = bid_(); unit < 64 * 50; unit += nblk_()) {
        const int mt = unit / 50, nt = unit % 50;
        bf16_t* Pp = p.P;
        gemm_tile(lds, p.Hn, D_, [=](int r) { return mt * 128 + r; }, B + nt * 128 + (tid_() & 127), NIN, D_,
                  [=](int m, int n, f32x4 v) { u32x2 o; o.x = cvt_pk_bf16(v[0], v[1]); o.y = cvt_pk_bf16(v[2], v[3]); *(u32x2*)(Pp + (size_t)(mt * 128 + m) * NIN + nt * 128 + n) = o; });
    }
}

__device__ __forceinline__ void phase_attn_naive(const Params& p) {
    const int lane = tid_() & 63, gw = bid_() * (NTHR / 64) + (tid_() >> 6), nw = nblk_() * (NTHR / 64);
    float* tmp = p.mixed;
    for (int it = gw; it < 2048; it += nw) {
        const int item = rfl(it);
        const int qb = 31 - (item >> 6), rest = item & 63, c = rest & 1, h = (rest >> 1) & 7, b = rest >> 4;
        const int q = qb * 64 + lane;
        const bf16_t* Pb = p.P + (size_t)b * S_ * NIN;
        float qv[64];
        {
            const bf16_t* qp = Pb + (size_t)q * NIN + h * 128 + c * 64;
#pragma unroll
            for (int i = 0; i < 8; ++i) { const u32x4 u = *(const u32x4*)(qp + i * 8);
#pragma unroll
                for (int j = 0; j < 4; ++j) { qv[i * 8 + j * 2] = __uint_as_float(u[j] << 16); qv[i * 8 + j * 2 + 1] = __uint_as_float(u[j] & 0xffff0000u); } }
        }
        const float scale2 = 0.125f * 1.44269504f, slope2 = exp2f(-(float)(h + 1)) * 1.44269504f;
        const int jmax = qb * 64 + 63;
        const bf16_t* kbase = Pb + 1024 + h * 128 + c * 64;
        const bf16_t* vbase = Pb + 2048 + h * 128;
        float m = -1e30f;
        for (int j = 0; j <= jmax; ++j) {
            const u32x4* kp = (const u32x4*)(kbase + (size_t)j * NIN);
            float s = 0.f;
#pragma unroll
            for (int i = 0; i < 8; ++i) { const u32x4 u = kp[i];
#pragma unroll
                for (int jj = 0; jj < 4; ++jj) { s += qv[i * 8 + jj * 2] * __uint_as_float(u[jj] << 16); s += qv[i * 8 + jj * 2 + 1] * __uint_as_float(u[jj] & 0xffff0000u); } }
            s = s * scale2 - slope2 * (float)(q - j);
            if (j <= q) m = fmaxf(m, s);
        }
        const float minv = 1.0f;
#pragma unroll 1
        for (int dh = 0; dh < 2; ++dh) {
            float lsum = 0.f; float acc[64];
#pragma unroll
            for (int d = 0; d < 64; ++d) acc[d] = 0.f;
            for (int j = 0; j <= jmax; ++j) {
                const u32x4* kp = (const u32x4*)(kbase + (size_t)j * NIN);
                float s = 0.f;
#pragma unroll
                for (int i = 0; i < 8; ++i) { const u32x4 u = kp[i];
#pragma unroll
                    for (int jj = 0; jj < 4; ++jj) { s += qv[i * 8 + jj * 2] * __uint_as_float(u[jj] << 16); s += qv[i * 8 + jj * 2 + 1] * __uint_as_float(u[jj] & 0xffff0000u); } }
                s = s * scale2 - slope2 * (float)(q - j);
                const float pj = (j <= q) ? exp2f(s - m) : 0.f;
                lsum += pj;
                const u32x4* vp = (const u32x4*)(vbase + (size_t)j * NIN + dh * 64);
#pragma unroll
                for (int i = 0; i < 8; ++i) { const u32x4 u = vp[i];
#pragma unroll
                    for (int jj = 0; jj < 4; ++jj) { acc[i * 8 + jj * 2] += pj * __uint_as_float(u[jj] << 16); acc[i * 8 + jj * 2 + 1] += pj * __uint_as_float(u[jj] & 0xffff0000u); } }
            }
            const float inv = minv / lsum;
            float* op = tmp + (size_t)(b * S_ + q + launder0()) * D_ + h * 256 + c * 128;
#pragma unroll
            for (int d = 0; d < 64; d += 4) *(f32x4*)(op + dh * 64 + d) = (f32x4){acc[d] * inv, acc[d + 1] * inv, acc[d + 2] * inv, acc[d + 3] * inv};
        }
    }
}

typedef float f32x16 __attribute__((ext_vector_type(16)));
#define AT_ROWB 144
#define AT_BUFB (64 * AT_ROWB + 128 * AT_ROWB)
__device__ __forceinline__ void phase_attn8(const Params& p, unsigned char* lds) {
    const int tid = tid_(), lane = tid & 63, w = tid >> 6, r32 = lane & 31, hh = lane >> 5;
    float* tmp = p.mixed;
    const int srow = tid >> 3, sch = tid & 7;
    for (int unit = bid_(); unit < 256; unit += nblk_()) {
        const int jp = unit & 3, c = (unit >> 2) & 1, h = (unit >> 3) & 7, b = unit >> 6;
        const bf16_t* Pb = p.P + (size_t)b * S_ * NIN;
        const bf16_t* Kg = Pb + 1024 + h * 128 + c * 64 + sch * 8;
        const bf16_t* Vg = p.Vt + ((size_t)(b * 8 + h) * 128 + srow) * S_ + sch * 8;
        const float slope2 = exp2f(-(float)(h + 1)) * 1.44269504f, scale2 = 0.125f * 1.44269504f;
#pragma unroll 1
        for (int half = 0; half < 2; ++half) {
            const int qb = half ? jp : 7 - jp;
            const int q0 = qb * 256 + w * 32, q = q0 + r32;
            bf16x8 qf[4];
            { const bf16_t* qp = Pb + (size_t)q * NIN + h * 128 + c * 64 + 8 * hh;
#pragma unroll
              for (int ks = 0; ks < 4; ++ks) qf[ks] = *(const bf16x8*)(qp + 16 * ks); }
            f32x16 O[4];
#pragma unroll
            for (int d = 0; d < 4; ++d)
#pragma unroll
                for (int r = 0; r < 16; ++r) O[d][r] = 0.f;
            float m = -1e30f, lsum = 0.f;
            const int ntiles = 4 * qb + 4;
            u32x4 rk, rv0, rv1;
            rk = *(const u32x4*)(Kg + (size_t)srow * NIN); rv0 = *(const u32x4*)(Vg); rv1 = *(const u32x4*)(Vg + (size_t)64 * S_);
            *(u32x4*)(lds + srow * AT_ROWB + sch * 16) = rk; *(u32x4*)(lds + (64 + srow) * AT_ROWB + sch * 16) = rv0; *(u32x4*)(lds + (128 + srow) * AT_ROWB + sch * 16) = rv1;
            __syncthreads();
#pragma unroll 1
            for (int kt = 0; kt < ntiles; ++kt) {
                unsigned char* bufp = lds + (kt & 1) * AT_BUFB;
                if (kt + 1 < ntiles) { rk = *(const u32x4*)(Kg + (size_t)((kt + 1) * 64 + srow) * NIN); rv0 = *(const u32x4*)(Vg + (kt + 1) * 64); rv1 = *(const u32x4*)(Vg + (size_t)64 * S_ + (kt + 1) * 64); }
                if (kt * 64 <= q0 + 31) {
                    f32x16 st[2];
#pragma unroll
                    for (int kb = 0; kb < 2; ++kb) {
                        f32x16 a;
#pragma unroll
                        for (int r = 0; r < 16; ++r) a[r] = 0.f;
#pragma unroll
                        for (int ks = 0; ks < 4; ++ks) { const bf16x8 kf = *(const bf16x8*)(bufp + (32 * kb + r32) * AT_ROWB + (16 * ks + 8 * hh) * 2); a = __builtin_amdgcn_mfma_f32_32x32x16_bf16(kf, qf[ks], a, 0, 0, 0); }
                        st[kb] = a;
                    }
                    const bool diag = (kt * 64 + 63 > q0);
                    float mx = -1e30f;
#pragma unroll
                    for (int kb = 0; kb < 2; ++kb)
#pragma unroll
                        for (int r = 0; r < 16; ++r) { const int key = kt * 64 + 32 * kb + (r & 3) + 8 * (r >> 2) + 4 * hh;
                            float s = st[kb][r] * scale2 + slope2 * (float)(key - q);
                            if (diag && key > q) s = -1e30f;
                            st[kb][r] = s; mx = fmaxf(mx, s); }
                    mx = fmaxf(mx, __shfl_xor(mx, 32));
                    const float mn = fmaxf(m, mx), alpha = __builtin_amdgcn_exp2f(m - mn);
                    m = mn;
                    float rs = 0.f;
#pragma unroll
                    for (int kb = 0; kb < 2; ++kb)
#pragma unroll
                        for (int r = 0; r < 16; ++r) { const float pe = __builtin_amdgcn_exp2f(st[kb][r] - mn); st[kb][r] = pe; rs += pe; }
                    rs += __shfl_xor(rs, 32);
                    lsum = lsum * alpha + rs;
#pragma unroll
                    for (int d = 0; d < 4; ++d)
#pragma unroll
                        for (int r = 0; r < 16; ++r) O[d][r] *= alpha;
                    bf16x8 pf[2][2];
#pragma unroll
                    for (int kb = 0; kb < 2; ++kb)
#pragma unroll
                        for (int s2 = 0; s2 < 2; ++s2) { u32x4 u; u.x = cvt_pk_bf16(st[kb][8 * s2 + 0], st[kb][8 * s2 + 1]); u.y = cvt_pk_bf16(st[kb][8 * s2 + 2], st[kb][8 * s2 + 3]);
                            u.z = cvt_pk_bf16(st[kb][8 * s2 + 4], st[kb][8 * s2 + 5]); u.w = cvt_pk_bf16(st[kb][8 * s2 + 6], st[kb][8 * s2 + 7]); pf[kb][s2] = __builtin_bit_cast(bf16x8, u); }
#pragma unroll
                    for (int d = 0; d < 4; ++d)
#pragma unroll
                        for (int kb = 0; kb < 2; ++kb)
#pragma unroll
                            for (int s2 = 0; s2 < 2; ++s2) { const unsigned char* vp = bufp + (64 + 32 * d + r32) * AT_ROWB + (32 * kb + 16 * s2 + 4 * hh) * 2;
                                const u32x2 lo = *(const u32x2*)vp, hi = *(const u32x2*)(vp + 16);
                                u32x4 u; u.x = lo.x; u.y = lo.y; u.z = hi.x; u.w = hi.y;
                                O[d] = __builtin_amdgcn_mfma_f32_32x32x16_bf16(__builtin_bit_cast(bf16x8, u), pf[kb][s2], O[d], 0, 0, 0); }
                }
                if (kt + 1 < ntiles) { unsigned char* nb = lds + ((kt + 1) & 1) * AT_BUFB;
                    *(u32x4*)(nb + srow * AT_ROWB + sch * 16) = rk; *(u32x4*)(nb + (64 + srow) * AT_ROWB + sch * 16) = rv0; *(u32x4*)(nb + (128 + srow) * AT_ROWB + sch * 16) = rv1; }
                __syncthreads();
            }
            const float inv = 1.0f / lsum;
            float* op = tmp + (size_t)(b * S_ + q) * D_ + h * 256 + c * 128 + 4 * hh;
#pragma unroll
            for (int d = 0; d < 4; ++d)
#pragma unroll
                for (int g = 0; g < 4; ++g) *(f32x4*)(op + 32 * d + 8 * g) = (f32x4){O[d][4 * g] * inv, O[d][4 * g + 1] * inv, O[d][4 * g + 2] * inv, O[d][4 * g + 3] * inv};
        }
    }
}

__device__ __forceinline__ float shifted(const bf16_t* P, int t, int col, float mu) {
    const float cur = bf2f(P[(size_t)t * NIN + 3072 + col]);
    const float prev = (t % S_) ? bf2f(P[(size_t)(t - 1) * NIN + 3072 + col]) : 0.f;
    return cur + (prev - cur) * mu;
}
#define PREP_RB 2
__device__ __forceinline__ void phase_rwkv_prep(const Params& p, int l, unsigned char* lds) {
    float* lowr = (float*)lds;
    float* vrow = lowr + PREP_RB * 256;
    float* red = vrow + PREP_RB * 1024;
    float* vv = red + PREP_RB * 512;
    const int tid = tid_(), lane = tid & 63;
    const float* mu = p.mu + (size_t)l * 3328;
    const float *w0 = p.w0 + l * RW, *w2 = p.w2 + (size_t)l * 64 * RW, *a0 = p.a0 + l * RW, *a2 = p.a2 + (size_t)l * 64 * RW, *g2 = p.g2 + (size_t)l * 128 * RW;
    const float *k_k = p.k_k + l * RW, *k_a = p.k_a + l * RW, *r_k = p.r_k + l * RW;
    for (int unit = bid_(); unit < T_ / PREP_RB; unit += nblk_()) {
        const int t0 = unit * PREP_RB;
        for (int idx = tid; idx < PREP_RB * 256; idx += NTHR) {
            const int r = idx >> 8, m = idx & 255;
            const float f = shifted(p.P, t0 + r, 3072 + m, mu[3072 + m]);
            lowr[idx] = (m < 64) ? tanhf(f) : (m < 128) ? f : sigmoidf_(f);
        }
        if (l > 0) {
            for (int idx = tid; idx < PREP_RB * 1024; idx += NTHR) { const int r = idx >> 10, cc = idx & 1023; vrow[idx] = shifted(p.P, t0 + r, 2048 + cc, mu[2048 + cc]); }
        }
        __syncthreads();
        if (l > 0) {
            const int j = tid & 31, part = tid >> 5;
            const float* v1 = p.v1;
#pragma unroll
            for (int r = 0; r < PREP_RB; ++r) {
                float s = 0.f;
#pragma unroll 4
                for (int cc = part * 64; cc < part * 64 + 64; ++cc) s += vrow[r * 1024 + cc] * v1[cc * 32 + j];
                red[(r * 16 + part) * 32 + j] = s;
            }
            __syncthreads();
            if (tid < PREP_RB * 32) { const int r = tid >> 5, jj = tid & 31; float s = 0.f;
#pragma unroll
                for (int pp = 0; pp < 16; ++pp) s += red[(r * 16 + pp) * 32 + jj];
                vv[r * 32 + jj] = s; }
            __syncthreads();
        }
#pragma unroll 1
        for (int i = 0; i < 1024 / NTHR; ++i) {
            const int cc = tid + i * NTHR, h = cc >> 6;
            float wa[PREP_RB], aa[PREP_RB], ga[PREP_RB];
#pragma unroll
            for (int r = 0; r < PREP_RB; ++r) { wa[r] = 0.f; aa[r] = 0.f; ga[r] = 0.f; }
#pragma unroll 2
            for (int m = 0; m < 64; ++m) {
                const float w2v = w2[m * RW + cc], a2v = a2[m * RW + cc], g2a = g2[m * RW + cc], g2b = g2[(64 + m) * RW + cc];
#pragma unroll
                for (int r = 0; r < PREP_RB; ++r) { wa[r] += lowr[r * 256 + m] * w2v; aa[r] += lowr[r * 256 + 64 + m] * a2v; ga[r] += lowr[r * 256 + 128 + m] * g2a + lowr[r * 256 + 192 + m] * g2b; }
            }
#pragma unroll
            for (int r = 0; r < PREP_RB; ++r) {
                const int t = t0 + r;
                const float rr = shifted(p.P, t, cc, mu[cc]), kx = shifted(p.P, t, 1024 + cc, mu[1024 + cc]);
                float vx = shifted(p.P, t, 2048 + cc, mu[2048 + cc]);
                const float wv = w0[cc] + wa[r];
                const float decay = __expf(-sigmoidf_(wv) * 0.60653066f);
                const float a = sigmoidf_(a0[cc] + aa[r]);
                const size_t o = (size_t)t * RW + cc;
                if (l == 0) p.vfirst[o] = vx;
                else {
                    float s = p.v0[cc];
#pragma unroll
                    for (int jj = 0; jj < 32; ++jj) s += vv[r * 32 + jj] * p.v2[jj * RW + cc];
                    vx = vx + (p.vfirst[o] - vx) * sigmoidf_(s);
                }
                const float kk = kx * k_k[cc];
                const float ss = wave_sum(kk * kk);
                const float kkn = kk / fmaxf(sqrtf(ss), 1e-12f);
                const float kh = kx * (1.0f + (a - 1.0f) * k_a[cc]);
                const float bc = wave_sum(rr * kh * r_k[cc]);
                if (lane == 0) p.bcoef[(size_t)t * 16 + h] = bc;
                p.sr[o] = rr; p.sw[o] = decay; p.sk[o] = kh; p.sv[o] = vx; p.sa[o] = -kkn; p.sb[o] = kkn * a; p.sg[o] = ga[r];
            }
        }
        __syncthreads();
    }
}

__device__ __forceinline__ void phase_scan_naive(const Params& p) {
    const int lane = tid_() & 63, gw = (tid_() >> 6) * nblk_() + bid_(), nw = nblk_() * (NTHR / 64);
    for (int it = gw; it < 64; it += nw) {
        const int item = rfl(it), b = item >> 4, h = item & 15;
        float st[64];
#pragma unroll
        for (int j = 0; j < 64; ++j) st[j] = 0.f;
        size_t base = (size_t)b * S_ * RW + h * 64 + lane;
        for (int t = 0; t < S_; ++t, base += RW) {
            const float wv = p.sw[base], av = p.sa[base], bv = p.sb[base], kv = p.sk[base], rv = p.sr[base], vi = p.sv[base];
            float sa = 0.f;
#pragma unroll
            for (int j = 0; j < 64; ++j) sa += st[j] * RL(av, j);
            float y = 0.f;
#pragma unroll
            for (int j = 0; j < 64; ++j) { st[j] = st[j] * RL(wv, j) + sa * RL(bv, j) + vi * RL(kv, j); y += st[j] * RL(rv, j); }
            p.sy[base] = y;
        }
    }
}

#define SC_CH 32
#define SC_BUFB (5 * SC_CH * 256 + SC_CH * 64)
__device__ __forceinline__ float dpp_add16(float x) {
    x += __int_as_float(__builtin_amdgcn_update_dpp(0, __float_as_int(x), 0xB1, 0xF, 0xF, true));
    x += __int_as_float(__builtin_amdgcn_update_dpp(0, __float_as_int(x), 0x4E, 0xF, 0xF, true));
    x += __int_as_float(__builtin_amdgcn_update_dpp(0, __float_as_int(x), 0x141, 0xF, 0xF, true));
    x += __int_as_float(__builtin_amdgcn_update_dpp(0, __float_as_int(x), 0x140, 0xF, 0xF, true));
    return x;
}
__device__ __forceinline__ void phase_scan8(const Params& p, unsigned char* lds) {
    const int tid = tid_(), lane = tid & 63, w = tid >> 6, l16 = lane & 15, rs = lane >> 4;
    for (int unit = bid_(); unit < 256; unit += nblk_()) {
        const int bh = unit >> 2, rg = unit & 3, b = bh >> 4, h = bh & 15;
        const size_t gbase = (size_t)b * S_ * RW + h * 64;
        const float* srcs[5] = {p.sw, p.sa, p.sb, p.sk, p.sr};
        auto load_chunk = [&](int c, unsigned char* buf) {
            const int lt = tid - 256;
            for (int idx = lt; idx < 5 * SC_CH * 16 + SC_CH * 4; idx += 256) {
                if (idx < 5 * SC_CH * 16) { const int a = idx / (SC_CH * 16), rem = idx - a * (SC_CH * 16), s = rem >> 4, q4 = rem & 15;
                    const f32x4 v = *(const f32x4*)(srcs[a] + gbase + (size_t)(c * SC_CH + s) * RW + q4 * 4);
                    *(f32x4*)(buf + a * (SC_CH * 256) + s * 256 + q4 * 16) = v;
                } else { const int rem = idx - 5 * SC_CH * 16, s = rem >> 2, q4 = rem & 3;
                    const f32x4 v = *(const f32x4*)(p.sv + gbase + (size_t)(c * SC_CH + s) * RW + rg * 16 + q4 * 4);
                    *(f32x4*)(buf + 5 * SC_CH * 256 + s * 64 + q4 * 16) = v; }
            }
        };
        if (w >= 4) load_chunk(0, lds);
        __syncthreads();
        float s0 = 0.f, s1 = 0.f, s2 = 0.f, s3 = 0.f;
        const int irow = rg * 16 + w * 4 + rs;
#pragma unroll 1
        for (int c = 0; c < S_ / SC_CH; ++c) {
            unsigned char* buf = lds + (c & 1) * SC_BUFB;
            if (w >= 4) { if (c + 1 < S_ / SC_CH) load_chunk(c + 1, lds + ((c + 1) & 1) * SC_BUFB); }
            else {
                float* yp = p.sy + gbase + (size_t)(c * SC_CH) * RW + irow;
#pragma unroll 4
                for (int s = 0; s < SC_CH; ++s) {
                    const f32x4 wv = *(const f32x4*)(buf + 0 * (SC_CH * 256) + s * 256 + l16 * 16);
                    const f32x4 av = *(const f32x4*)(buf + 1 * (SC_CH * 256) + s * 256 + l16 * 16);
                    const f32x4 bv = *(const f32x4*)(buf + 2 * (SC_CH * 256) + s * 256 + l16 * 16);
                    const f32x4 kv = *(const f32x4*)(buf + 3 * (SC_CH * 256) + s * 256 + l16 * 16);
                    const f32x4 rv = *(const f32x4*)(buf + 4 * (SC_CH * 256) + s * 256 + l16 * 16);
                    const float vi = *(const float*)(buf + 5 * SC_CH * 256 + s * 64 + (w * 4 + rs) * 4);
                    float sa = (s0 * av[0] + s1 * av[1]) + (s2 * av[2] + s3 * av[3]);
                    sa = dpp_add16(sa);
                    s0 = s0 * wv[0] + (sa * bv[0] + vi * kv[0]);
                    s1 = s1 * wv[1] + (sa * bv[1] + vi * kv[1]);
                    s2 = s2 * wv[2] + (sa * bv[2] + vi * kv[2]);
                    s3 = s3 * wv[3] + (sa * bv[3] + vi * kv[3]);
                    float y = (s0 * rv[0] + s1 * rv[1]) + (s2 * rv[2] + s3 * rv[3]);
                    y = dpp_add16(y);
                    if (l16 == 0) yp[(size_t)s * RW] = y;
                }
            }
            __syncthreads();
        }
    }
}

#define LR_K 288
#define LR_ROWB 592
__device__ __forceinline__ float bflo(unsigned u) { return __uint_as_float(u << 16); }
__device__ __forceinline__ float bfhi(unsigned u) { return __uint_as_float(u & 0xffff0000u); }
__device__ __forceinline__ void phase_prep8(const Params& p, int l, unsigned char* lds) {
    const int tid = tid_(), lane = tid & 63, w = tid >> 6, fr = lane & 15, fq = lane >> 4;
    const float* mu = p.mu + (size_t)l * 3328;
    const bf16_t* LRT = p.LRT + (size_t)l * 1024 * LR_K;
    for (int unit = bid_(); unit < T_ / 32; unit += nblk_()) {
        const int t0 = unit * 32;
        {
            const int tok = tid >> 4, cg = tid & 15, t = t0 + tok; const bool first = (t % S_) == 0;
            const bf16_t* pc = p.P + (size_t)t * NIN + 6144 + cg * 16;
            const u32x4 c0 = *(const u32x4*)pc, c1 = *(const u32x4*)(pc + 8);
            u32x4 p0 = (u32x4){0u, 0u, 0u, 0u}, p1 = p0;
            if (!first) { p0 = *(const u32x4*)(pc - NIN); p1 = *(const u32x4*)(pc - NIN + 8); }
            const float* mm = mu + 3072 + cg * 16;
            float f[16];
#pragma unroll
            for (int e = 0; e < 4; ++e) { f[2 * e] = bflo(c0[e]) + (bflo(p0[e]) - bflo(c0[e])) * mm[2 * e]; f[2 * e + 1] = bfhi(c0[e]) + (bfhi(p0[e]) - bfhi(c0[e])) * mm[2 * e + 1];
                f[8 + 2 * e] = bflo(c1[e]) + (bflo(p1[e]) - bflo(c1[e])) * mm[8 + 2 * e]; f[8 + 2 * e + 1] = bfhi(c1[e]) + (bfhi(p1[e]) - bfhi(c1[e])) * mm[8 + 2 * e + 1]; }
            if (cg < 4) {
#pragma unroll
                for (int e = 0; e < 16; ++e) f[e] = tanhf(f[e]);
            } else if (cg >= 8) {
#pragma unroll
                for (int e = 0; e < 16; ++e) f[e] = sigmoidf_(f[e]);
            }
            u32x4 o0, o1; o0.x = cvt_pk_bf16(f[0], f[1]); o0.y = cvt_pk_bf16(f[2], f[3]); o0.z = cvt_pk_bf16(f[4], f[5]); o0.w = cvt_pk_bf16(f[6], f[7]);
            o1.x = cvt_pk_bf16(f[8], f[9]); o1.y = cvt_pk_bf16(f[10], f[11]); o1.z = cvt_pk_bf16(f[12], f[13]); o1.w = cvt_pk_bf16(f[14], f[15]);
            *(u32x4*)(lds + tok * LR_ROWB + cg * 32) = o0; *(u32x4*)(lds + tok * LR_ROWB + cg * 32 + 16) = o1;
            if (l > 0) {
                const int part = cg;
                float acc[32];
#pragma unroll
                for (int j = 0; j < 32; ++j) acc[j] = 0.f;
                const bf16_t* vc = p.P + (size_t)t * NIN + 5120 + part * 64;
#pragma unroll 2
                for (int ci = 0; ci < 64; ci += 2) {
                    const unsigned cu = *(const unsigned*)(vc + ci), pu = first ? 0u : *(const unsigned*)(vc - NIN + ci);
                    const float v0_ = bflo(cu) + (bflo(pu) - bflo(cu)) * mu[2048 + part * 64 + ci], v1_ = bfhi(cu) + (bfhi(pu) - bfhi(cu)) * mu[2048 + part * 64 + ci + 1];
                    const f32x4* r0 = (const f32x4*)(p.v1 + (size_t)(part * 64 + ci) * 32);
#pragma unroll
                    for (int q = 0; q < 8; ++q) { const f32x4 x0 = r0[q], x1 = r0[8 + q];
#pragma unroll
                        for (int j = 0; j < 4; ++j) acc[4 * q + j] += v0_ * x0[j] + v1_ * x1[j]; }
                }
#pragma unroll
                for (int j = 0; j < 32; ++j) acc[j] = dpp_add16(acc[j]);
                float oa = acc[0], ob = acc[16];
#pragma unroll
                for (int j = 1; j < 16; ++j) { oa = (part == j) ? acc[j] : oa; ob = (part == j) ? acc[16 + j] : ob; }
                bf16_t* vvp = (bf16_t*)(lds + tok * LR_ROWB + 512);
                vvp[part] = (bf16_t)(cvt_pk_bf16(oa, oa) & 0xffffu); vvp[16 + part] = (bf16_t)(cvt_pk_bf16(ob, ob) & 0xffffu);
            }
        }
        __syncthreads();
#pragma unroll 1
        for (int it = 0; it < 4; ++it) {
            const int hd = it >> 1, mt = it & 1, head = 2 * w + hd;
            const int t = t0 + 16 * mt + fr; const bool first = (t % S_) == 0;
            f32x4 aw[4], aa[4], ag[4], av[4];
#pragma unroll
            for (int nt = 0; nt < 4; ++nt) { aw[nt] = (f32x4){0.f, 0.f, 0.f, 0.f}; aa[nt] = aw[nt]; ag[nt] = aw[nt]; av[nt] = aw[nt]; }
            bf16x8 af[9];
#pragma unroll
            for (int ks = 0; ks < 9; ++ks) af[ks] = *(const bf16x8*)(lds + (mt * 16 + fr) * LR_ROWB + ks * 64 + fq * 16);
#pragma unroll
            for (int nt = 0; nt < 4; ++nt) {
                const bf16_t* bp = LRT + (size_t)(head * 64 + nt * 16 + fr) * LR_K + fq * 8;
                bf16x8 bfv[9];
#pragma unroll
                for (int ks = 0; ks < 9; ++ks) bfv[ks] = *(const bf16x8*)(bp + ks * 32);
                aw[nt] = __builtin_amdgcn_mfma_f32_16x16x32_bf16(bfv[0], af[0], aw[nt], 0, 0, 0); aw[nt] = __builtin_amdgcn_mfma_f32_16x16x32_bf16(bfv[1], af[1], aw[nt], 0, 0, 0);
                aa[nt] = __builtin_amdgcn_mfma_f32_16x16x32_bf16(bfv[2], af[2], aa[nt], 0, 0, 0); aa[nt] = __builtin_amdgcn_mfma_f32_16x16x32_bf16(bfv[3], af[3], aa[nt], 0, 0, 0);
#pragma unroll
                for (int ks = 4; ks < 8; ++ks) ag[nt] = __builtin_amdgcn_mfma_f32_16x16x32_bf16(bfv[ks], af[ks], ag[nt], 0, 0, 0);
                if (l > 0) av[nt] = __builtin_amdgcn_mfma_f32_16x16x32_bf16(bfv[8], af[8], av[nt], 0, 0, 0);
            }
            f32x4 kkv[4], aav[4]; float ss = 0.f, bc = 0.f;
            const bf16_t* prow = p.P + (size_t)t * NIN + 3072;
#pragma unroll
            for (int nt = 0; nt < 4; ++nt) {
                const int c = head * 64 + nt * 16 + 4 * fq; const size_t o = (size_t)t * RW + c;
                const u32x2 cr = *(const u32x2*)(prow + c), ck = *(const u32x2*)(prow + 1024 + c), cv = *(const u32x2*)(prow + 2048 + c);
                u32x2 qr = (u32x2){0u, 0u}, qk = qr, qv = qr;
                if (!first) { qr = *(const u32x2*)(prow - NIN + c); qk = *(const u32x2*)(prow - NIN + 1024 + c); qv = *(const u32x2*)(prow - NIN + 2048 + c); }
                const f32x4 mr = *(const f32x4*)(mu + c), mk = *(const f32x4*)(mu + 1024 + c), mv = *(const f32x4*)(mu + 2048 + c);
                f32x4 rr, kx, vx;
                rr[0] = bflo(cr.x) + (bflo(qr.x) - bflo(cr.x)) * mr[0]; rr[1] = bfhi(cr.x) + (bfhi(qr.x) - bfhi(cr.x)) * mr[1]; rr[2] = bflo(cr.y) + (bflo(qr.y) - bflo(cr.y)) * mr[2]; rr[3] = bfhi(cr.y) + (bfhi(qr.y) - bfhi(cr.y)) * mr[3];
                kx[0] = bflo(ck.x) + (bflo(qk.x) - bflo(ck.x)) * mk[0]; kx[1] = bfhi(ck.x) + (bfhi(qk.x) - bfhi(ck.x)) * mk[1]; kx[2] = bflo(ck.y) + (bflo(qk.y) - bflo(ck.y)) * mk[2]; kx[3] = bfhi(ck.y) + (bfhi(qk.y) - bfhi(ck.y)) * mk[3];
                vx[0] = bflo(cv.x) + (bflo(qv.x) - bflo(cv.x)) * mv[0]; vx[1] = bfhi(cv.x) + (bfhi(qv.x) - bfhi(cv.x)) * mv[1]; vx[2] = bflo(cv.y) + (bflo(qv.y) - bflo(cv.y)) * mv[2]; vx[3] = bfhi(cv.y) + (bfhi(qv.y) - bfhi(cv.y)) * mv[3];
                const f32x4 w0v = *(const f32x4*)(p.w0 + l * RW + c), a0v = *(const f32x4*)(p.a0 + l * RW + c), kkw = *(const f32x4*)(p.k_k + l * RW + c), kaw = *(const f32x4*)(p.k_a + l * RW + c), rkw = *(const f32x4*)(p.r_k + l * RW + c);
                f32x4 dec, av_, kh;
#pragma unroll
                for (int j = 0; j < 4; ++j) { dec[j] = __expf(-sigmoidf_(w0v[j] + aw[nt][j]) * 0.60653066f); av_[j] = sigmoidf_(a0v[j] + aa[nt][j]); }
                if (l == 0) *(f32x4*)(p.vfirst + o) = vx;
                else { const f32x4 vf = *(const f32x4*)(p.vfirst + o), v0v = *(const f32x4*)(p.v0 + c);
#pragma unroll
                    for (int j = 0; j < 4; ++j) vx[j] = vx[j] + (vf[j] - vx[j]) * sigmoidf_(v0v[j] + av[nt][j]); }
#pragma unroll
                for (int j = 0; j < 4; ++j) { const float kk = kx[j] * kkw[j]; kkv[nt][j] = kk; ss += kk * kk; kh[j] = kx[j] * (1.0f + (av_[j] - 1.0f) * kaw[j]); bc += rr[j] * kh[j] * rkw[j]; }
                aav[nt] = av_;
                *(f32x4*)(p.sr + o) = rr; *(f32x4*)(p.sw + o) = dec; *(f32x4*)(p.sk + o) = kh; *(f32x4*)(p.sv + o) = vx; *(f32x4*)(p.sg + o) = ag[nt];
            }
            ss += __shfl_xor(ss, 16); ss += __shfl_xor(ss, 32); bc += __shfl_xor(bc, 16); bc += __shfl_xor(bc, 32);
            const float rn = 1.0f / fmaxf(sqrtf(ss), 1e-12f);
            if (fq == 0) p.bcoef[(size_t)t * 16 + head] = bc;
#pragma unroll
            for (int nt = 0; nt < 4; ++nt) { const size_t o = (size_t)t * RW + head * 64 + nt * 16 + 4 * fq;
                f32x4 sa_, sb_;
#pragma unroll
                for (int j = 0; j < 4; ++j) { const float kn = kkv[nt][j] * rn; sa_[j] = -kn; sb_[j] = kn * aav[nt][j]; }
                *(f32x4*)(p.sa + o) = sa_; *(f32x4*)(p.sb + o) = sb_; }
        }
        __syncthreads();
    }
}

__device__ __forceinline__ void phase_post(const Params& p, int l) {
    const int tid = tid_(), lane = tid & 63, w = tid >> 6;
    const float lam_init = (l == 0) ? 0.2f : 0.35550907f;
    float lam;
    { const float s1 = wave_sum(p.lam_q1[l * 64 + lane] * p.lam_k1[l * 64 + lane]), s2 = wave_sum(p.lam_q2[l * 64 + lane] * p.lam_k2[l * 64 + lane]); lam = __expf(s1) - __expf(s2) + lam_init; }
    const float* tmp = p.mixed;
    for (int t = bid_(); t < T_; t += nblk_()) {
        for (int h = w; h < 8; h += NTHR / 64) {
            const float* o0 = tmp + (size_t)t * D_ + h * 256 + lane * 2;
            const float x0 = o0[0] - lam * o0[128], x1 = o0[1] - lam * o0[129];
            const float ss = wave_sum(x0 * x0 + x1 * x1);
            const float rstd = rsqrtf(ss * (1.0f / 128.0f) + 1e-5f) * (1.0f - lam_init);
            const float* sg = p.subln_g + l * 128 + lane * 2;
            *(unsigned*)(p.ocat + (size_t)t * D_ + h * 128 + lane * 2) = cvt_pk_bf16(x0 * rstd * sg[0], x1 * rstd * sg[1]);
        }
        for (int h = w; h < 16; h += NTHR / 64) {
            const int cc = h * 64 + lane; const size_t o = (size_t)t * RW + cc;
            const float y = p.sy[o];
            const float mean = wave_sum(y) * (1.0f / 64.0f);
            const float d = y - mean;
            const float var = wave_sum(d * d) * (1.0f / 64.0f);
            const float yn = d * rsqrtf(var + 64e-5f) * p.lnx_w[l * RW + cc] + p.lnx_b[l * RW + cc];
            const float val = (yn + p.bcoef[(size_t)t * 16 + h] * p.sv[o]) * p.sg[o];
            const float nb = __shfl_down(val, 1);
            if ((lane & 1) == 0) *(unsigned*)(p.ocat + (size_t)t * D_ + 1024 + cc) = cvt_pk_bf16(val, nb);
        }
    }
}

__device__ __forceinline__ void phase_gemm_out(const Params& p, int l, unsigned char* lds) {
    const float* B = p.w_out + (size_t)l * D_ * D_;
    for (int unit = bid_(); unit < 64 * 16; unit += nblk_()) {
        const int mt = unit >> 4, nt = unit & 15;
        float* C = p.mixed;
        gemm_tile(lds, p.ocat, D_, [=](int r) { return mt * 128 + r; }, B + nt * 128 + (tid_() & 127), D_, D_,
                  [=](int m, int n, f32x4 v) { *(f32x4*)(C + (size_t)(mt * 128 + m) * D_ + nt * 128 + n) = v; });
    }
}

__device__ __forceinline__ void phase_res1_router(const Params& p, int l, unsigned char* lds) {
    const int tid = tid_(), lane = tid & 63, w = tid >> 6, gw = bid_() * (NTHR / 64) + w, nw = nblk_() * (NTHR / 64);
    float* hrow = (float*)lds + w * D_;
    const float* xin = (l == 0) ? p.x : p.out;
    const float* Wr = p.w_router + (size_t)l * D_ * NE;
    for (int t = gw; t < T_; t += nw) {
        const int b = t / S_;
        const float* md = p.mod + ((size_t)l * 4 + b) * 12288;
        f32x4 xv[8]; float ss = 0.f;
#pragma unroll
        for (int i = 0; i < 8; ++i) { const int e = i * 256 + lane * 4; const f32x4 mv = *(const f32x4*)(p.mixed + (size_t)t * D_ + e);
            ss += mv[0] * mv[0] + mv[1] * mv[1] + mv[2] * mv[2] + mv[3] * mv[3]; }
        ss = wave_sum(ss);
        const float rm = rsqrtf(ss * (1.0f / D_) + 1e-6f);
        float s2 = 0.f;
#pragma unroll
        for (int i = 0; i < 8; ++i) { const int e = i * 256 + lane * 4; const f32x4 gp = *(const f32x4*)(p.g_post_mix + l * D_ + e), ga = *(const f32x4*)(md + 4096 + e);
            const f32x4 mv = *(const f32x4*)(p.mixed + (size_t)t * D_ + e); xv[i] = *(const f32x4*)(xin + (size_t)t * D_ + e);
#pragma unroll
            for (int j = 0; j < 4; ++j) { xv[i][j] += ga[j] * (mv[j] * rm * gp[j]); s2 += xv[i][j] * xv[i][j]; }
            *(f32x4*)(p.out + (size_t)t * D_ + e) = xv[i]; }
        s2 = wave_sum(s2);
        const float rx = rsqrtf(s2 * (1.0f / D_) + 1e-6f);
        emit_hn(xv, rx, p.g_pre_ffn + l * D_, md + 8192, md + 6144, p.Hn + (size_t)t * D_, lane, hrow);
        __builtin_amdgcn_s_waitcnt(0);
        __builtin_amdgcn_wave_barrier();
        float lg = 0.f;
#pragma unroll 8
        for (int k = 0; k < D_; ++k) lg += hrow[k] * Wr[(size_t)k * NE + lane];
        const float score = sigmoidf_(lg), biased = score + p.router_bias[l * NE + lane];
        int rk = 0;
#pragma unroll
        for (int i = 0; i < 8; ++i) { const int src = (lane & ~7) + i; const float o = __shfl(biased, src); rk += (o > biased || (o == biased && src < lane)) ? 1 : 0; }
        float gs = (rk < 2) ? biased : 0.f;
        gs += __shfl_xor(gs, 1); gs += __shfl_xor(gs, 2); gs += __shfl_xor(gs, 4);
        int grk = 0; const int g = lane >> 3;
#pragma unroll
        for (int i = 0; i < 8; ++i) { const float o = RL(gs, i * 8); grk += (o > gs || (o == gs && i < g)) ? 1 : 0; }
        const bool gsel = grk < 4;
        const float mvv = gsel ? biased : -INFINITY;
        int erk = 0;
#pragma unroll
        for (int i = 0; i < 64; ++i) { const float o = RL(mvv, i); erk += (o > mvv || (o == mvv && i < lane)) ? 1 : 0; }
        const bool sel = gsel && erk < 8;
        const float gsum = wave_sum(sel ? score : 0.f);
        if (sel) {
            const float gate = score / gsum * 2.5f;
            const unsigned slot = atomicAdd(p.counts + l * NE + lane, 1u);
            p.rowtok[lane * CAP + slot] = t; p.rowg[lane * CAP + slot] = gate; p.tokpos[(size_t)t * 8 + erk] = lane * CAP + (int)slot;
        }
        __builtin_amdgcn_wave_barrier();
    }
}

__device__ __forceinline__ void phase_moe_gu(const Params& p, int l, unsigned char* lds) {
    int* tab = (int*)(lds + TAB_OFF);
    build_tables(p, l, tab, 7);
    const int ntile = tab[160 + NE + 1];
    for (int unit = bid_(); unit < ntile * 8; unit += nblk_()) {
        const int rtg = unit >> 3, ct = unit & 7, e = find_expert(tab, rtg), rt = rtg - tab[160 + e], cnt = tab[e], pb = tab[80 + e];
        const float* Bg = (e < NE) ? p.w_eg + ((size_t)(l * NE + e) * D_) * 512 : p.w_sg + (size_t)l * D_ * 512;
        const float* Bu = (e < NE) ? p.w_eu + ((size_t)(l * NE + e) * D_) * 512 : p.w_su + (size_t)l * D_ * 512;
        const int n = tid_() & 127;
        const float* bp = ((n & 1) ? Bu : Bg) + ct * 64 + (n >> 1);
        const int* rtok = p.rowtok + e * CAP;
        bf16_t* H1 = p.H1;
        gemm_tile(lds, p.Hn, D_, [=](int r) { const int slot = rt * 128 + r; return (slot < cnt) ? ((e < NE) ? rtok[slot] : slot) : 0; }, bp, 512, D_,
                  [=](int m, int nn, f32x4 v) { const float h0 = v[0] / (1.0f + __expf(-v[0])) * v[1], h1 = v[2] / (1.0f + __expf(-v[2])) * v[3];
                      *(unsigned*)(H1 + (size_t)(pb + rt * 128 + m) * 512 + ct * 64 + (nn >> 1)) = cvt_pk_bf16(h0, h1); });
    }
}

__device__ __forceinline__ void phase_moe_down(const Params& p, int l, unsigned char* lds) {
    int* tab = (int*)(lds + TAB_OFF);
    build_tables(p, l, tab, 7);
    const int ntile = tab[160 + NE + 1];
    for (int unit = bid_(); unit < ntile * 16; unit += nblk_()) {
        const int rtg = unit >> 4, ct = unit & 15, e = find_expert(tab, rtg), rt = rtg - tab[160 + e], cnt = tab[e], pb = tab[80 + e];
        const float* Bd = (e < NE) ? p.w_ed + ((size_t)(l * NE + e) * 512) * D_ : p.w_sd + (size_t)l * 512 * D_;
        const float* rg = p.rowg + e * CAP;
        bf16_t* Y2 = p.Y2;
        gemm_tile(lds, p.H1, 512, [=](int r) { return pb + rt * 128 + r; }, Bd + ct * 128 + (tid_() & 127), D_, 512,
                  [=](int m, int nn, f32x4 v) { const int slot = rt * 128 + m; const float g = (slot < cnt) ? ((e < NE) ? rg[slot] : 1.0f) : 0.f;
                      u32x2 o; o.x = cvt_pk_bf16(v[0] * g, v[1] * g); o.y = cvt_pk_bf16(v[2] * g, v[3] * g);
                      *(u32x2*)(Y2 + (size_t)(pb + slot) * D_ + ct * 128 + nn) = o; });
    }
}

__device__ __forceinline__ void phase_combine(const Params& p, int l, unsigned char* lds) {
    int* tab = (int*)(lds + TAB_OFF);
    build_tables(p, l, tab, 8);
    const int lane = tid_() & 63, gw = bid_() * (NTHR / 64) + (tid_() >> 6), nw = nblk_() * (NTHR / 64);
    for (int t = gw; t < T_; t += nw) {
        const int b = t / S_;
        const float* md = p.mod + ((size_t)l * 4 + b) * 12288;
        f32x4 yv[8];
#pragma unroll
        for (int i = 0; i < 8; ++i) yv[i] = (f32x4){0.f, 0.f, 0.f, 0.f};
        for (int k = 0; k < 9; ++k) {
            int row;
            if (k < 8) { const int tp = p.tokpos[(size_t)t * 8 + k]; row = tab[80 + (tp >> 13)] + (tp & (CAP - 1)); } else row = tab[80 + NE] + t;
            const bf16_t* yr = p.Y2 + (size_t)row * D_;
#pragma unroll
            for (int i = 0; i < 8; ++i) { const u32x2 u = *(const u32x2*)(yr + i * 256 + lane * 4);
                yv[i][0] += __uint_as_float(u.x << 16); yv[i][1] += __uint_as_float(u.x & 0xffff0000u); yv[i][2] += __uint_as_float(u.y << 16); yv[i][3] += __uint_as_float(u.y & 0xffff0000u); }
        }
        float ss = 0.f;
#pragma unroll
        for (int i = 0; i < 8; ++i) ss += yv[i][0] * yv[i][0] + yv[i][1] * yv[i][1] + yv[i][2] * yv[i][2] + yv[i][3] * yv[i][3];
        ss = wave_sum(ss);
        const float ry = rsqrtf(ss * (1.0f / D_) + 1e-6f);
        float s2 = 0.f;
#pragma unroll
        for (int i = 0; i < 8; ++i) { const int e = i * 256 + lane * 4; const f32x4 xo = *(const f32x4*)(p.out + (size_t)t * D_ + e);
            const f32x4 gp = *(const f32x4*)(p.g_post_ffn + l * D_ + e), gf = *(const f32x4*)(md + 10240 + e);
#pragma unroll
            for (int j = 0; j < 4; ++j) { yv[i][j] = xo[j] + gf[j] * (yv[i][j] * ry * gp[j]); s2 += yv[i][j] * yv[i][j]; }
            *(f32x4*)(p.out + (size_t)t * D_ + e) = yv[i]; }
        if (l + 1 < 2) {
            s2 = wave_sum(s2);
            const float rx = rsqrtf(s2 * (1.0f / D_) + 1e-6f);
            const float* md1 = p.mod + ((size_t)(l + 1) * 4 + b) * 12288;
            emit_hn(yv, rx, p.g_pre_mix + (l + 1) * D_, md1 + 2048, md1, p.Hn + (size_t)t * D_, lane, nullptr);
        }
    }
}

#ifndef USE_ATTN8
#define USE_ATTN8 1
#endif
#ifndef USE_SCAN8
#define USE_SCAN8 1
#endif
#ifndef USE_PREP8
#define USE_PREP8 1
#endif
#ifndef USE8_IN
#define USE8_IN 1
#endif
#ifndef USE8_OUT
#define USE8_OUT 1
#endif
#ifndef USE8_GU
#define USE8_GU 1
#endif
#ifndef USE8_DOWN
#define USE8_DOWN 1
#endif
__global__ __launch_bounds__(NTHR, 2) void k_fwd(Params p) {
#define PP() (*(const Params*)((const char*)&p + launder0()))
    extern __shared__ __attribute__((aligned(16))) unsigned char lds[];
    volatile LAS unsigned* xbw = (volatile LAS unsigned*)(lds + LDS_BYTES);
    if (threadIdx.x == 0) { xbw[0] = 0u; xbw[1] = 0u; xbw[2] = 0u; xbw[3] = 0u; }
    __syncthreads();
    (void)xcd_barrier_post(p.bar, xbw);
#define GRIDBAR() do { XcdBarrier _b; _b.bar = PP().bar; _b.x = xb_xcc_id(); _b.st = (volatile LAS unsigned*)(lds + LDS_BYTES); xcd_barrier(_b); } while (0)
    phase_adaln(PP(), lds);
    phase_convert(PP(), lds);
    GRIDBAR();
    phase_prenorm0(PP());
    GRIDBAR();
#pragma unroll 1
    for (int l = 0; l < 2; ++l) {
        if (USE8_IN) phase_gemm_in8(PP(), l, lds); else phase_gemm_in(PP(), l, lds);
        GRIDBAR();
        if (USE_ATTN8) phase_attn8(PP(), lds); else phase_attn_naive(PP());
        if (USE_PREP8) phase_prep8(PP(), l, lds); else phase_rwkv_prep(PP(), l, lds);
        GRIDBAR();
        if (USE_SCAN8) phase_scan8(PP(), lds); else phase_scan_naive(PP());
        GRIDBAR();
        phase_post(PP(), l);              GRIDBAR();
        if (USE8_OUT) phase_gemm_out8(PP(), l, lds); else phase_gemm_out(PP(), l, lds);
        GRIDBAR();
        phase_res1_router(PP(), l, lds);  GRIDBAR();
        if (USE8_GU) phase_moe_gu8(PP(), l, lds); else phase_moe_gu(PP(), l, lds);
        GRIDBAR();
        if (USE8_DOWN) phase_moe_down8(PP(), l, lds); else phase_moe_down(PP(), l, lds);
        GRIDBAR();
        phase_combine(PP(), l, lds);      GRIDBAR();
    }
}

extern "C" void kernel_launch(void* const* d_in, const int* in_sizes, int n_in, void* d_out, int out_size, void* d_ws, size_t ws_size, hipStream_t stream) {
    Params p{};
    const float* const* in = (const float* const*)d_in;
    p.x = in[0]; p.c = in[1]; p.w_ada = in[2]; p.b_ada = in[3]; p.g_pre_mix = in[4]; p.g_post_mix = in[5]; p.g_pre_ffn = in[6]; p.g_post_ffn = in[7]; p.w_in = in[8]; p.w_out = in[9];
    p.lam_q1 = in[10]; p.lam_k1 = in[11]; p.lam_q2 = in[12]; p.lam_k2 = in[13]; p.subln_g = in[14]; p.mu = in[15]; p.w0 = in[16]; p.w2 = in[17]; p.a0 = in[18]; p.a2 = in[19]; p.g2 = in[20];
    p.k_k = in[21]; p.k_a = in[22]; p.r_k = in[23]; p.lnx_w = in[24]; p.lnx_b = in[25]; p.v0 = in[26]; p.v1 = in[27]; p.v2 = in[28];
    p.w_router = in[29]; p.router_bias = in[30]; p.w_eg = in[31]; p.w_eu = in[32]; p.w_ed = in[33]; p.w_sg = in[34]; p.w_su = in[35]; p.w_sd = in[36];
    p.out = (float*)d_out;
    unsigned char* ws = (unsigned char*)d_ws; size_t off = 0;
    auto take = [&](size_t bytes) { void* r = ws + off; off += (bytes + 255) & ~(size_t)255; return r; };
    p.bar = (unsigned*)take(16384);
    p.counts = (unsigned*)take(2 * NE * 4);
    p.mod = (float*)take((size_t)2 * 4 * 12288 * 4);
    p.Hn = (bf16_t*)take((size_t)T_ * D_ * 2);
    p.P = (bf16_t*)take((size_t)T_ * NIN * 2);
    p.sr = (float*)take((size_t)T_ * RW * 4); p.sw = (float*)take((size_t)T_ * RW * 4); p.sk = (float*)take((size_t)T_ * RW * 4); p.sv = (float*)take((size_t)T_ * RW * 4);
    p.sa = (float*)take((size_t)T_ * RW * 4); p.sb = (float*)take((size_t)T_ * RW * 4); p.sy = (float*)take((size_t)T_ * RW * 4); p.sg = (float*)take((size_t)T_ * RW * 4);
    p.vfirst = (float*)take((size_t)T_ * RW * 4);
    p.bcoef = (float*)take((size_t)T_ * 16 * 4);
    p.ocat = (bf16_t*)take((size_t)T_ * D_ * 2);
    p.mixed = (float*)take((size_t)T_ * D_ * 4);
    p.rowtok = (int*)take((size_t)NE * CAP * 4);
    p.rowg = (float*)take((size_t)NE * CAP * 4);
    p.tokpos = (int*)take((size_t)T_ * 8 * 4);
    p.H1 = (bf16_t*)take((size_t)PMAX * 512 * 2);
    p.Y2 = (bf16_t*)take((size_t)PMAX * D_ * 2);
    p.Vt = (bf16_t*)take((size_t)T_ * 1024 * 2);
    p.LRT = (bf16_t*)take((size_t)2 * 1024 * 288 * 2);
    p.WinT = (bf16_t*)take((size_t)2 * NIN * D_ * 2);
    p.WoutT = (bf16_t*)take((size_t)2 * D_ * D_ * 2);
    p.WguT = (bf16_t*)take((size_t)2 * 65 * 1024 * D_ * 2);
    p.WdT = (bf16_t*)take((size_t)2 * 65 * D_ * 512 * 2);
    (void)hipMemsetAsync(p.bar, 0, 16384 + 2 * NE * 4 + 256, stream);
    static int grid = 0;
    if (!grid) {
        int dev = 0, cus = 0, per_cu = 0;
        (void)hipGetDevice(&dev);
        (void)hipDeviceGetAttribute(&cus, hipDeviceAttributeMultiprocessorCount, dev);
        (void)hipFuncSetAttribute((const void*)k_fwd, hipFuncAttributeMaxDynamicSharedMemorySize, LDS_BYTES + 16);
        (void)hipOccupancyMaxActiveBlocksPerMultiprocessor(&per_cu, k_fwd, NTHR, LDS_BYTES + 16);
        if (per_cu < 1) per_cu = 1;
        grid = cus;
    }
    k_fwd<<<grid, NTHR, LDS_BYTES + 16, stream>>>(p);
}
```

```cpp
#include <hip/hip_runtime.h>
#include <stdint.h>

typedef unsigned short bf16_t;
typedef short bf16x8 __attribute__((ext_vector_type(8)));
typedef float f32x4 __attribute__((ext_vector_type(4)));
typedef unsigned u32x4 __attribute__((ext_vector_type(4)));
typedef unsigned u32x2 __attribute__((ext_vector_type(2)));

#define T_    8192
#define D_    2048
#define S_    2048
#define NB_   4
#define NIN   6400
#define NINX  6656
#define RW    1024
#define NE    64
#define CAP   8192
#define PMAX  90112
#define USE_ATTN8 1
#define NTHR  512
#define NW_   (NTHR / 64)
#define TAB_OFF 131072
#define RSEL_OFF 133120
#define LDS_BYTES (133120 + 10240)

struct Params {
    const float *x, *c, *w_ada, *b_ada, *g_pre_mix, *g_post_mix, *g_pre_ffn, *g_post_ffn, *w_in, *w_out;
    const float *lam_q1, *lam_k1, *lam_q2, *lam_k2, *subln_g, *mu, *w0, *w2, *a0, *a2, *g2, *k_k, *k_a, *r_k, *lnx_w, *lnx_b, *v0, *v1, *v2;
    const float *w_router, *router_bias, *w_eg, *w_eu, *w_ed, *w_sg, *w_su, *w_sd;
    float* out;
    unsigned* bar;
    float* mod;
    bf16_t* Hn;
    bf16_t* P;
    float *sr, *sw, *sk, *sv, *sa, *sb, *sy, *sg, *vfirst;
    bf16_t *hr, *hk, *hv, *ha, *hb, *hg;
    float* bcoef;
    bf16_t* ocat;
    float* mixed;
    unsigned* counts;
    int* rowtok;
    float* rowg;
    int* tokpos;
    float* tokgate;
    bf16_t* H1;
    bf16_t* Y2;
    bf16_t* Vt;
    unsigned* cvprog;
    float* VV;
    bf16_t* WrT;
    bf16_t* LRT;
    bf16_t *WinT, *WoutT, *WguT, *WdT;
};

__device__ __forceinline__ float bf2f(unsigned short h) { return __uint_as_float(((unsigned)h) << 16); }
__device__ __forceinline__ unsigned cvt_pk_bf16(float lo, float hi) { unsigned r; asm volatile("v_cvt_pk_bf16_f32 %0, %1, %2" : "=v"(r) : "v"(lo), "v"(hi)); return r; }
__device__ __forceinline__ float bflo(unsigned u) { return __uint_as_float(u << 16); }
__device__ __forceinline__ float bfhi(unsigned u) { return __uint_as_float(u & 0xffff0000u); }
__device__ __forceinline__ float wave_sum(float v) {
#pragma unroll
    for (int o = 32; o > 0; o >>= 1) v += __shfl_xor(v, o);
    return v;
}
__device__ __forceinline__ float frcp_(float x) { return __builtin_amdgcn_rcpf(x); }
__device__ __forceinline__ float sigmoidf_(float x) { return frcp_(1.0f + __expf(-x)); }
__device__ __forceinline__ float tanhf_(float x) { return 1.0f - 2.0f * frcp_(1.0f + __expf(2.0f * x)); }
#define RL(v, j) __int_as_float(__builtin_amdgcn_readlane(__float_as_int(v), (j)))
__device__ __forceinline__ int launder0() { int z = 0; asm volatile("" : "+s"(z)); return z; }
__device__ __forceinline__ int tid_() { int z = 0; asm volatile("" : "+v"(z)); return (int)threadIdx.x + z; }
__device__ __forceinline__ int bid_() { return (int)blockIdx.x + launder0(); }
__device__ __forceinline__ int nblk_() { return (int)gridDim.x + launder0(); }
__device__ __forceinline__ int rfl(int v) { return __builtin_amdgcn_readfirstlane(v); }


#define XB_TMO      128
#define XB_XCNT(j)  (256  + 64 * (j))
#define XB_XSUB(j)  (1280 + 64 * (j))
#define XB_XGEN(j)  (2304 + 64 * (j))
#define XB_TOP      3328
#define XB_TOPGEN   3392
#define XCD_BAR_WORDS 3456
#define XB_SPIN_CAP (1u << 18)
#define LAS __attribute__((address_space(3)))
__device__ __forceinline__ unsigned xb_ld(unsigned* p)              { return __hip_atomic_load(p, __ATOMIC_RELAXED, __HIP_MEMORY_SCOPE_AGENT); }
__device__ __forceinline__ unsigned xb_add(unsigned* p, unsigned v) { return __hip_atomic_fetch_add(p, v, __ATOMIC_RELAXED, __HIP_MEMORY_SCOPE_AGENT); }
__device__ __forceinline__ unsigned xb_xcc_id() { return (unsigned)__builtin_amdgcn_s_getreg((3 << 11) | 20) & 0xFu; }
#define XB_SPIN(cond, bar) do { unsigned _sp = 0; while (cond) { __builtin_amdgcn_s_sleep(1); \
    if ((++_sp & 255u) == 0u) { if (xb_ld(&(bar)[XB_TMO])) break; if (_sp > XB_SPIN_CAP) { atomicAdd(&(bar)[XB_TMO], 1u); break; } } } } while (0)
struct XcdBarrier { unsigned* bar; unsigned x; volatile LAS unsigned* st; };
__device__ __forceinline__ XcdBarrier xcd_barrier_post(unsigned* bar, volatile LAS unsigned* st) {
    XcdBarrier b; b.bar = bar; b.x = xb_xcc_id(); b.st = st;
    if (threadIdx.x == 0) (void)xb_add(&bar[XB_XCNT(b.x)], 1u);
    return b;
}
__device__ __forceinline__ void xcd_barrier_complete(unsigned* bar, unsigned x, unsigned& nloc, unsigned& nx) {
    const unsigned G = gridDim.x * gridDim.y * gridDim.z;
    unsigned sum, cnt, mine, sp = 0u;
    for (;;) {
        sum = 0u; cnt = 0u; mine = 0u;
#pragma unroll
        for (unsigned j = 0; j < 16; ++j) { const unsigned c = xb_ld(&bar[XB_XCNT(j)]); sum += c; cnt += (c > 0u) ? 1u : 0u; mine = (j == x) ? c : mine; }
        if (sum == G) break;
        __builtin_amdgcn_s_sleep(1);
        if ((++sp & 255u) == 0u) { if (xb_ld(&bar[XB_TMO])) break; if (sp > XB_SPIN_CAP) { atomicAdd(&bar[XB_TMO], 1u); break; } }
    }
    nloc = mine > 0u ? mine : 1u; nx = cnt > 0u ? cnt : 1u;
}
__device__ __forceinline__ void xcd_barrier(const XcdBarrier& b) {
    asm volatile("s_waitcnt vmcnt(0)" ::: "memory");
    __syncthreads();
    if (threadIdx.x == 0) {
        unsigned* bar = b.bar;
        __builtin_amdgcn_s_waitcnt(0);
        unsigned nloc = b.st[0], nx = b.st[1];
        if (nloc == 0u) { xcd_barrier_complete(bar, b.x, nloc, nx); b.st[0] = nloc; b.st[1] = nx; }
        const unsigned old = xb_add(&bar[XB_XSUB(b.x)], 1u);
        const unsigned gen = old / nloc;
        if (old + 1u == (gen + 1u) * nloc) {
            __builtin_amdgcn_fence(__ATOMIC_RELEASE, "agent");
            asm volatile("s_waitcnt vmcnt(0)" ::: "memory");
            const unsigned og = xb_add(&bar[XB_TOP], 1u);
            const unsigned tg = og / nx;
            if (og + 1u == (tg + 1u) * nx) xb_add(&bar[XB_TOPGEN], 1u);
            else XB_SPIN(xb_ld(&bar[XB_TOPGEN]) == tg, bar);
            __builtin_amdgcn_fence(__ATOMIC_ACQUIRE, "agent");
            xb_add(&bar[XB_XGEN(b.x)], 1u);
            asm volatile("s_waitcnt vmcnt(0)" ::: "memory");
        } else {
            XB_SPIN(xb_ld(&bar[XB_XGEN(b.x)]) == gen, bar);
            __builtin_amdgcn_fence(__ATOMIC_ACQUIRE, "agent");
            asm volatile("s_waitcnt vmcnt(0)" ::: "memory");
        }
    }
    __syncthreads();
}

#define GT_ROWB 144
template <class ARow, class Epi>
__device__ __forceinline__ void gemm_tile(unsigned char* lds, const bf16_t* A, int lda, ARow arow, const float* bp, int ldb, int K, Epi epi) {
    const int tid = tid_(), lane = tid & 63, wid = tid >> 6, wm = wid >> 1, wn = wid & 1, fr = lane & 15, fq = lane >> 4;
    if (tid >= 256) { for (int i = 0; i < 2 * (K >> 6) + 1; ++i) __syncthreads(); return; }
    unsigned char* sA = lds;
    unsigned char* sB = lds + 128 * GT_ROWB;
    const bf16_t* ap[4];
    int aoff[4];
#pragma unroll
    for (int i = 0; i < 4; ++i) { const int ch = tid + i * 256, r = ch >> 3, kc = ch & 7; ap[i] = A + (size_t)arow(r) * lda + kc * 8; aoff[i] = r * GT_ROWB + kc * 16; }
    const int bn = tid & 127, bkh = tid >> 7;
    const float* bq = bp + (size_t)(bkh * 32) * ldb;
    const int boff = bn * GT_ROWB + bkh * 64;
    f32x4 acc[4][4];
#pragma unroll
    for (int i = 0; i < 4; ++i)
#pragma unroll
        for (int j = 0; j < 4; ++j) acc[i][j] = (f32x4){0.f, 0.f, 0.f, 0.f};
    u32x4 ra[4]; float rb[32];
    const int nk = K >> 6;
#pragma unroll
    for (int i = 0; i < 4; ++i) ra[i] = *(const u32x4*)(ap[i]);
#pragma unroll
    for (int i = 0; i < 32; ++i) rb[i] = bq[(size_t)i * ldb];
    for (int kt = 0; kt < nk; ++kt) {
        __syncthreads();
#pragma unroll
        for (int i = 0; i < 4; ++i) *(u32x4*)(sA + aoff[i]) = ra[i];
#pragma unroll
        for (int g = 0; g < 4; ++g) { u32x4 w; w.x = cvt_pk_bf16(rb[g * 8 + 0], rb[g * 8 + 1]); w.y = cvt_pk_bf16(rb[g * 8 + 2], rb[g * 8 + 3]); w.z = cvt_pk_bf16(rb[g * 8 + 4], rb[g * 8 + 5]); w.w = cvt_pk_bf16(rb[g * 8 + 6], rb[g * 8 + 7]);
            *(u32x4*)(sB + boff + g * 16) = w; }
        __syncthreads();
        if (kt + 1 < nk) {
#pragma unroll
            for (int i = 0; i < 4; ++i) ra[i] = *(const u32x4*)(ap[i] + (size_t)(kt + 1) * 64);
            const float* bqq = bq + (size_t)(kt + 1) * 64 * ldb;
#pragma unroll
            for (int i = 0; i < 32; ++i) rb[i] = bqq[(size_t)i * ldb];
        }
#pragma unroll
        for (int ks = 0; ks < 2; ++ks) {
            bf16x8 af[4], bfr[4];
#pragma unroll
            for (int i = 0; i < 4; ++i) af[i] = *(const bf16x8*)(sA + (wm * 64 + i * 16 + fr) * GT_ROWB + ks * 64 + fq * 16);
#pragma unroll
            for (int j = 0; j < 4; ++j) bfr[j] = *(const bf16x8*)(sB + (wn * 64 + j * 16 + fr) * GT_ROWB + ks * 64 + fq * 16);
#pragma unroll
            for (int i = 0; i < 4; ++i)
#pragma unroll
                for (int j = 0; j < 4; ++j) acc[i][j] = __builtin_amdgcn_mfma_f32_16x16x32_bf16(bfr[j], af[i], acc[i][j], 0, 0, 0);
        }
    }
#pragma unroll
    for (int i = 0; i < 4; ++i)
#pragma unroll
        for (int j = 0; j < 4; ++j) epi(wm * 64 + i * 16 + fr, wn * 64 + j * 16 + fq * 4, acc[i][j]);
    __syncthreads();
}

#ifndef GP_SP2
#define GP_SP2 true
#endif
#ifndef GP_ALIGN
#define GP_ALIGN true
#endif
namespace gp {
constexpr int BM = 256, BK = 64, HALF = 128, HTB = HALF * BK * 2, STAGE_BYTES = 8 * HTB;
__device__ __forceinline__ int lds_byte(int r, int c) { const int st = (r >> 4) * 2 + (c >> 5), rr = r & 15, cc = c & 31, ob = rr * 64 + cc * 2; return st * 1024 + (ob ^ (((ob >> 9) & 1) << 5)); }
__device__ __forceinline__ void stage_rc(int b, int& R, int& C) { const int st = b / 1024, sb = b % 1024, swz = sb ^ (((sb >> 9) & 1) << 5); R = (st >> 1) * 16 + swz / 64; C = (st & 1) * 32 + (swz % 64) / 2; }
__device__ __forceinline__ int perm32(int rho) { const int n = rho >> 4, i = rho & 15; return 8 * (i >> 2) + 4 * n + (i & 3); }
struct Unit { int pm, pn, e; };
typedef f32x4 Acc[2][2][4][2];

template <bool GATHER, int PERM  , bool SP2, bool ALIGN_EPI, class Sched, class Epi>
__device__ __forceinline__ void gemm_phase(LAS unsigned char* lds, const int K, const Sched& S, const Epi& E) {
    const int tid = tid_(), wid = rfl(tid >> 6), lane = tid & 63, wr = wid >> 2, wc = wid & 3, fr = lane & 15, fq = lane >> 4;
    const int nt = K / BK;
    int Rr[2], Cc[2]; unsigned voffB[2], voffB1[2];
#pragma unroll
    for (int i = 0; i < 2; ++i) { int R, C; stage_rc(tid * 16 + i * 8192, R, C); Rr[i] = R; Cc[i] = C;
        if (PERM == 2) { const int wcs = R >> 5, nn = (R >> 4) & 1, ii = R & 15, cb = 64 * wcs + 16 * (ii >> 2) + 4 * nn + (ii & 3);
            voffB[i] = (unsigned)(cb * K + C) * 2u; voffB1[i] = (unsigned)((cb + 8) * K + C) * 2u; }
        else { const int Rb = (PERM == 1) ? ((R & ~31) + perm32(R & 31)) : R; voffB[i] = (unsigned)(Rb * K + C) * 2u; voffB1[i] = voffB[i]; } }
    const size_t hstepB = (PERM == 2) ? 0 : (size_t)HALF * K * 2;
    const size_t kstep = (size_t)(BK * 2);
    const size_t hstep = (size_t)HALF * K * 2;
    const unsigned ldsw = (unsigned)wid * 1024u;
    const int aoff = lds_byte(wr * 64 + fr, fq * 8), boff = lds_byte(wc * 32 + fr, fq * 8);
#define GP_SA(b, h) (((b) * 2 + (h)) * HTB)
#define GP_SB(b, h) ((4 + (b) * 2 + (h)) * HTB)
#define GP_STAGE(bufoff, gbase, voff) do { _Pragma("unroll") for (int _i = 0; _i < 2; ++_i) \
        __builtin_amdgcn_global_load_lds((const unsigned*)((const char*)(gbase) + (voff)[_i]), (LAS unsigned*)(lds + (bufoff) + ldsw + _i * 8192), 16, 0, 0); } while (0)
#define GP_LDA(dst, b, h) do { _Pragma("unroll") for (int m = 0; m < 4; ++m) _Pragma("unroll") for (int k = 0; k < 2; ++k) dst[m][k] = *(const LAS bf16x8*)(lds + GP_SA(b, h) + aoff + m * 2048 + k * 1024); } while (0)
#define GP_LDB(dst, b, h) do { _Pragma("unroll") for (int n = 0; n < 2; ++n) _Pragma("unroll") for (int k = 0; k < 2; ++k) dst[n][k] = *(const LAS bf16x8*)(lds + GP_SB(b, h) + boff + n * 2048 + k * 1024); } while (0)
#define GP_MMA(ai, bj, At, Bt) do { __builtin_amdgcn_s_setprio(1); _Pragma("unroll") for (int m = 0; m < 4; ++m) _Pragma("unroll") for (int n = 0; n < 2; ++n) _Pragma("unroll") for (int k = 0; k < 2; ++k) \
        acc[ai][bj][m][n] = __builtin_amdgcn_mfma_f32_16x16x32_bf16(Bt[n][k], At[m][k], acc[ai][bj][m][n], 0, 0, 0); __builtin_amdgcn_s_setprio(0); } while (0)
#define GP_WAIT_V(n) asm volatile("s_waitcnt vmcnt(" #n ")" ::: "memory")
#define GP_WAIT_L(n) asm volatile("s_waitcnt lgkmcnt(" #n ")" ::: "memory")
#define GP_BAR __builtin_amdgcn_s_barrier()
#define GP_SCHED __builtin_amdgcn_sched_barrier(0)
#define GP_VOFF(u, v) do { _Pragma("unroll") for (int _h = 0; _h < 2; ++_h) _Pragma("unroll") for (int _i = 0; _i < 2; ++_i) { \
        const int _row = GATHER ? S.a_row(u, _h * 128 + Rr[_i]) : (_h * 128 + Rr[_i]); v[_h][_i] = (unsigned)(_row * K + Cc[_i]) * 2u; } } while (0)
    Unit cur, nxt; int ui = 0;
    if (!S.next(0, cur)) return;
    Acc acc;
#pragma unroll
    for (int a = 0; a < 2; ++a)
#pragma unroll
        for (int b = 0; b < 2; ++b)
#pragma unroll
            for (int m = 0; m < 4; ++m)
#pragma unroll
                for (int n = 0; n < 2; ++n) acc[a][b][m][n] = (f32x4){0.f, 0.f, 0.f, 0.f};
    bf16x8 At[4][2], B0[2][2], B1[2][2];
    unsigned vA[2][2], vAn[2][2];
    const char* cA = S.a_base(cur); const char* cB = S.b_base(cur);
    GP_VOFF(cur, vA);
    if constexpr (SP2) {
        GP_STAGE(GP_SB(0, 0), cB, voffB); GP_STAGE(GP_SB(0, 1), cB + hstepB, voffB1); GP_STAGE(GP_SA(0, 0), cA, vA[0]); GP_STAGE(GP_SA(0, 1), cA, vA[1]);
        if (wr == 1) GP_BAR;
        GP_WAIT_V(2); GP_BAR;
        GP_STAGE(GP_SB(1, 0), cB + kstep, voffB); GP_STAGE(GP_SA(1, 0), cA + kstep, vA[0]); GP_STAGE(GP_SB(1, 1), cB + hstepB + kstep, voffB1);
        GP_WAIT_V(6); GP_BAR;
    } else {
        GP_STAGE(GP_SB(0, 0), cB, voffB); GP_STAGE(GP_SA(0, 0), cA, vA[0]); GP_STAGE(GP_SB(0, 1), cB + hstepB, voffB1); GP_STAGE(GP_SA(0, 1), cA, vA[1]);
        if (wr == 1) GP_BAR;
        GP_WAIT_V(4); GP_BAR;
        GP_STAGE(GP_SB(1, 0), cB + kstep, voffB); GP_STAGE(GP_SA(1, 0), cA + kstep, vA[0]); GP_STAGE(GP_SB(1, 1), cB + hstepB + kstep, voffB1);
        GP_WAIT_V(6); GP_BAR;
    }
    for (;;) {
        const bool has_next = S.next(ui + 1, nxt);
        const char* nA = has_next ? S.a_base(nxt) : cA; const char* nB = has_next ? S.b_base(nxt) : cB;
        if (GATHER) { if (has_next) { GP_VOFF(nxt, vAn); } else { vAn[0][0] = vA[0][0]; vAn[0][1] = vA[0][1]; vAn[1][0] = vA[1][0]; vAn[1][1] = vA[1][1]; } }
        for (int t = 0; t < nt; t += 2) {
            const bool last = (t == nt - 2);
            const char* a1 = cA + (size_t)(t + 1) * kstep;
            const char* a2 = last ? nA : cA + (size_t)(t + 2) * kstep; const char* b2 = last ? nB : cB + (size_t)(t + 2) * kstep;
            const char* a3 = a2 + kstep; const char* b3 = b2 + kstep;
            unsigned v2[2][2];
#pragma unroll
            for (int h = 0; h < 2; ++h)
#pragma unroll
                for (int i = 0; i < 2; ++i) v2[h][i] = (GATHER && last) ? vAn[h][i] : vA[h][i];
            if constexpr (SP2) {
            GP_LDB(B0, 0, 0); GP_LDB(B1, 0, 1); GP_SCHED; GP_LDA(At, 0, 0); GP_STAGE(GP_SA(1, 1), a1, vA[1]);
            GP_WAIT_V(8); GP_WAIT_L(0); GP_BAR; GP_MMA(0, 0, At, B0); GP_MMA(0, 1, At, B1); GP_BAR; GP_SCHED;
            GP_LDA(At, 0, 1); GP_STAGE(GP_SB(0, 0), b2, voffB); GP_STAGE(GP_SB(0, 1), b2 + hstepB, voffB1); GP_STAGE(GP_SA(0, 0), a2, v2[0]);
            GP_WAIT_V(8); GP_WAIT_L(0); GP_BAR; GP_MMA(1, 0, At, B0); GP_MMA(1, 1, At, B1); GP_BAR; GP_SCHED;
            GP_LDB(B0, 1, 0); GP_LDB(B1, 1, 1); GP_SCHED; GP_LDA(At, 1, 0); GP_STAGE(GP_SA(0, 1), a2, v2[1]);
            GP_WAIT_V(8); GP_WAIT_L(0); GP_BAR; GP_MMA(0, 0, At, B0); GP_MMA(0, 1, At, B1); GP_BAR; GP_SCHED;
            GP_LDA(At, 1, 1); GP_STAGE(GP_SB(1, 0), b3, voffB); GP_STAGE(GP_SB(1, 1), b3 + hstepB, voffB1); GP_STAGE(GP_SA(1, 0), a3, v2[0]);
            GP_WAIT_V(8); GP_WAIT_L(0); GP_BAR; GP_MMA(1, 0, At, B0); GP_MMA(1, 1, At, B1); GP_BAR; GP_SCHED;
            } else {
            GP_LDB(B0, 0, 0); GP_SCHED; GP_LDA(At, 0, 0); GP_STAGE(GP_SA(1, 1), a1, vA[1]);
            GP_WAIT_L(8); GP_BAR; GP_WAIT_L(0); GP_MMA(0, 0, At, B0); GP_BAR; GP_SCHED;
            GP_LDB(B1, 0, 1); GP_STAGE(GP_SB(0, 0), b2, voffB);
            GP_BAR; GP_WAIT_L(0); GP_MMA(0, 1, At, B1); GP_BAR;
            GP_LDA(At, 0, 1); GP_STAGE(GP_SA(0, 0), a2, v2[0]);
            GP_BAR; GP_WAIT_L(0); GP_MMA(1, 0, At, B0); GP_BAR; GP_SCHED;
            GP_STAGE(GP_SB(0, 1), b2 + hstepB, voffB1);
            GP_WAIT_V(6); GP_BAR; GP_MMA(1, 1, At, B1); GP_BAR;
            GP_LDB(B0, 1, 0); GP_SCHED; GP_LDA(At, 1, 0); GP_STAGE(GP_SA(0, 1), a2, v2[1]);
            GP_WAIT_L(8); GP_BAR; GP_WAIT_L(0); GP_MMA(0, 0, At, B0); GP_BAR; GP_SCHED;
            GP_LDB(B1, 1, 1); GP_STAGE(GP_SB(1, 0), b3, voffB);
            GP_BAR; GP_WAIT_L(0); GP_MMA(0, 1, At, B1); GP_BAR;
            GP_LDA(At, 1, 1); GP_STAGE(GP_SA(1, 0), a3, v2[0]);
            GP_BAR; GP_WAIT_L(0); GP_MMA(1, 0, At, B0); GP_BAR; GP_SCHED;
            GP_STAGE(GP_SB(1, 1), b3 + hstepB, voffB1);
            GP_WAIT_V(6); GP_BAR; GP_MMA(1, 1, At, B1); GP_BAR;
            }
        }
        if constexpr (ALIGN_EPI) { if (wr == 0) GP_BAR; }
        E(acc, cur, wr, wc, fr, fq);
        if (!has_next) break;
#pragma unroll
        for (int a = 0; a < 2; ++a)
#pragma unroll
            for (int b = 0; b < 2; ++b)
#pragma unroll
                for (int m = 0; m < 4; ++m)
#pragma unroll
                    for (int n = 0; n < 2; ++n) acc[a][b][m][n] = (f32x4){0.f, 0.f, 0.f, 0.f};
        cur = nxt; cA = nA; cB = nB; ++ui;
        if (GATHER) { vA[0][0] = vAn[0][0]; vA[0][1] = vAn[0][1]; vA[1][0] = vAn[1][0]; vA[1][1] = vAn[1][1]; }
        if constexpr (ALIGN_EPI) { if (wr == 1) GP_BAR; }
    }
    GP_WAIT_V(0);
    if constexpr (!ALIGN_EPI) { if (wr == 0) GP_BAR; }
    GP_BAR;
#undef GP_SA
#undef GP_SB
#undef GP_STAGE
#undef GP_LDA
#undef GP_LDB
#undef GP_MMA
#undef GP_WAIT_V
#undef GP_WAIT_L
#undef GP_BAR
#undef GP_SCHED
#undef GP_VOFF
}

struct DenseSched {
    const bf16_t* A; const bf16_t* Bt; int K, nM, nN, nwg, G, c;
    __device__ __forceinline__ void init(const bf16_t* A_, const bf16_t* Bt_, int M, int N, int K_, int G_, int c_) { A = A_; Bt = Bt_; K = K_; nM = M / BM; nN = N / BM; nwg = nM * nN; G = G_; c = c_; }
    __device__ __forceinline__ bool next(int i, Unit& u) const {
        const long L = (long)i * G + c; if (L >= nwg) return false;
        int wgid = (int)L; { const int q = nwg / 8, r = nwg % 8, xcd = wgid % 8, off = wgid / 8; wgid = (xcd < r ? xcd * (q + 1) : r * (q + 1) + (xcd - r) * q) + off; }
        const int nig = 8 * nN, gid = wgid / nig, fm = gid * 8, gsz = (nM - fm) < 8 ? (nM - fm) : 8;
        u.pm = fm + ((wgid % nig) % gsz); u.pn = (wgid % nig) / gsz; u.e = 0; return true;
    }
    __device__ __forceinline__ const char* a_base(const Unit& u) const { return (const char*)A + (size_t)u.pm * BM * K * 2; }
    __device__ __forceinline__ const char* b_base(const Unit& u) const { return (const char*)Bt + (size_t)u.pn * BM * K * 2; }
    __device__ __forceinline__ int a_row(const Unit&, int r) const { return r; }
};
}

struct CvDesc { const float* src; bf16_t* dst; int N, K; };
#define CV_I_IN  (32 * 100)
#define CV_I_OUT (32 * 32)
#define CV_I_GU  (32 * 8)
#define CV_I_D   (8 * 32)
#define CV_PER_L (CV_I_IN + CV_I_OUT + 65 * 2 * CV_I_GU + 65 * CV_I_D)
#define CV_TOTAL (2 * CV_PER_L)
#define CV_PRO   (CV_I_IN + CV_I_OUT)
__device__ __forceinline__ void cv_decode(const Params& p, int it0, int lane, CvDesc& d, int& rowmul) {
    const int l = it0 / CV_PER_L; int r = it0 - l * CV_PER_L;
    const float* W; bf16_t* Wt; int N, K, gu = 0; rowmul = 1;
    if (r < CV_I_IN) { W = p.w_in + (size_t)l * D_ * NIN; N = NIN; K = D_; Wt = p.WinT + (size_t)l * NINX * D_; }
    else if ((r -= CV_I_IN) < CV_I_OUT) { W = p.w_out + (size_t)l * D_ * D_; N = D_; K = D_; Wt = p.WoutT + (size_t)l * D_ * D_; }
    else if ((r -= CV_I_OUT) < 65 * 2 * CV_I_GU) { const int e = r / (2 * CV_I_GU), rr = r - e * 2 * CV_I_GU, which = rr / CV_I_GU; r = rr - which * CV_I_GU;
        W = (e < NE) ? ((which ? p.w_eu : p.w_eg) + (size_t)(l * NE + e) * D_ * 512) : ((which ? p.w_su : p.w_sg) + (size_t)l * D_ * 512);
        N = 512; K = D_; Wt = p.WguT + (size_t)(l * 65 + e) * 1024 * D_; gu = 1 + which; }
    else { r -= 65 * 2 * CV_I_GU; const int e = r / CV_I_D; r -= e * CV_I_D;
        W = (e < NE) ? (p.w_ed + (size_t)(l * NE + e) * 512 * D_) : (p.w_sd + (size_t)l * 512 * D_); N = D_; K = 512; Wt = p.WdT + (size_t)(l * 65 + e) * D_ * 512; }
    const int nkt = K >> 6, ntile = r / nkt, kt = r - ntile * nkt, k0 = kt * 64, n0 = ntile * 64;
    const int drow = gu ? ((n0 >> 7) * 256 + (gu - 1) * 128 + (n0 & 127)) : n0;
    d.src = W + (size_t)k0 * N + n0; d.dst = Wt + (size_t)drow * K + k0; d.N = N; d.K = K;
}
__device__ __forceinline__ void cv_load(const CvDesc& d, float (&v)[64], int lane) {
#pragma unroll
    for (int k = 0; k < 64; ++k) v[k] = d.src[(size_t)(k * d.N) + lane];
}
__device__ __forceinline__ void cv_store(const CvDesc& d, int rowmul, const float (&v)[64], unsigned char* scr, int lane) {
#pragma unroll
    for (int g = 0; g < 8; ++g) { u32x4 w; w.x = cvt_pk_bf16(v[g * 8 + 0], v[g * 8 + 1]); w.y = cvt_pk_bf16(v[g * 8 + 2], v[g * 8 + 3]); w.z = cvt_pk_bf16(v[g * 8 + 4], v[g * 8 + 5]); w.w = cvt_pk_bf16(v[g * 8 + 6], v[g * 8 + 7]);
        *(u32x4*)(scr + lane * 144 + g * 16) = w; }
    asm volatile("s_waitcnt lgkmcnt(0)" ::: "memory"); __builtin_amdgcn_wave_barrier();
#pragma unroll
    for (int j = 0; j < 8; ++j) { const int n = (lane >> 3) + 8 * j, kc = lane & 7; const u32x4 w = *(const u32x4*)(scr + n * 144 + kc * 16);
        *(u32x4*)(d.dst + (size_t)(n * rowmul) * d.K + kc * 8) = w; }
    __builtin_amdgcn_wave_barrier();
}
__device__ __forceinline__ void convert_one(const Params& p, int it0, unsigned char* scr, int lane) {
    CvDesc d; int rm; cv_decode(p, it0, lane, d, rm);
    float v[64]; cv_load(d, v, lane); cv_store(d, rm, v, scr, lane);
}
__device__ __forceinline__ unsigned cv_ld_stop(volatile unsigned* q) { return *q; }
__device__ __forceinline__ int convert_stream(const Params& p, int first, int stride, int hi, volatile unsigned* stop, unsigned char* scr, int lane) {
    int n = 0, it = first;
    if (it >= hi || (stop && cv_ld_stop(stop) != 0u)) return 0;
    CvDesc da, db; int rma, rmb; float va[64], vb[64];
    cv_decode(p, it, lane, da, rma); cv_load(da, va, lane);
    for (;;) {
        int itn = it + stride; bool more = itn < hi && !(stop && cv_ld_stop(stop) != 0u);
        { const int iq = more ? itn : it; cv_decode(p, iq, lane, db, rmb); cv_load(db, vb, lane); }
        cv_store(da, rma, va, scr, lane); ++n;
        if (!more) break;
        it = itn; itn = it + stride; more = itn < hi && !(stop && cv_ld_stop(stop) != 0u);
        { const int iq = more ? itn : it; cv_decode(p, iq, lane, da, rma); cv_load(da, va, lane); }
        cv_store(db, rmb, vb, scr, lane); ++n;
        if (!more) break;
        it = itn;
    }
    return n;
}
__device__ __forceinline__ int cv_lo(int l) { return l ? CV_PER_L + CV_PRO : CV_PRO; }
#define CV_NPRE(l) ((l) ? 9216 : 10240)
__device__ __forceinline__ int cv_hi(int l) { return (l ? CV_TOTAL : CV_PER_L + CV_PRO) - CV_NPRE(l); }
__device__ __forceinline__ void convert_leftovers(const Params& p, int l, unsigned char* lds) {
    const int tid = tid_(), lane = tid & 63, w = tid >> 6, gw = bid_() * NW_ + w, ncv = nblk_() * 2;
    unsigned char* scr = lds + w * 9216;
    const int g = gw % ncv, sub = gw / ncv;
    const int k0 = (int)p.cvprog[l * 1024 + g];
    (void)convert_stream(p, cv_lo(l) + g + ncv * (k0 + sub), ncv * (NW_ / 2), cv_hi(l), nullptr, scr, lane);
}
__device__ __forceinline__ void phase_convert(const Params& p, unsigned char* lds) {
    const int tid = tid_();
    { const int lane = tid & 63, w = tid >> 6; unsigned char* scr = lds + w * 9216;
      const int G = nblk_(), c = bid_();
      if (G > 192) { if (c >= 192) (void)convert_stream(p, (c - 192) * NW_ + w, (G - 192) * NW_, CV_PRO, nullptr, scr, lane); }
      else (void)convert_stream(p, c * NW_ + w, G * NW_, CV_PRO, nullptr, scr, lane); }
}
__device__ __forceinline__ void phase_cv_lrt(const Params& p) {
    const int tid = tid_();
    for (int idx = bid_() * NTHR + tid; idx < 2 * 1024 * 288; idx += nblk_() * NTHR) {
        const int l = idx / (1024 * 288), r = idx - l * (1024 * 288), col = r / 288, k = r - col * 288;
        float v;
        if (k < 64) v = p.w2[((size_t)l * 64 + k) * RW + col]; else if (k < 128) v = p.a2[((size_t)l * 64 + (k - 64)) * RW + col]; else if (k < 256) v = p.g2[((size_t)l * 128 + (k - 128)) * RW + col];
        else v = (l > 0) ? p.v2[(size_t)(k - 256) * RW + col] : 0.f;
        p.LRT[idx] = (bf16_t)(cvt_pk_bf16(v, v) & 0xffffu);
    }
}
__device__ __forceinline__ void phase_cv_u(const Params& p, unsigned char* lds) {
    const int tid = tid_(), lane = tid & 63;
    {
        float* xs = (float*)lds;
        const float* muv = p.mu + 3328 + 2048;
        for (int kb = bid_(); kb < D_ / 8; kb += nblk_()) {
            const int kk = rfl(tid >> 6), k = kb * 8 + kk;
            const float* wv = p.w_in + (size_t)D_ * NIN + (size_t)k * NIN + 5120;
            float wreg[16];
#pragma unroll
            for (int i = 0; i < 16; ++i) wreg[i] = wv[i * 64 + lane];
            float a = 0.f;
#pragma unroll
            for (int half = 0; half < 2; ++half) {
                __syncthreads();
                f32x4 vq[8]; float mq[8];
#pragma unroll
                for (int j = 0; j < 8; ++j) { const int task = tid + NTHR * j, c = half * 512 + (task >> 3), q4 = (task & 7) * 4; mq[j] = muv[c]; vq[j] = *(const f32x4*)(p.v1 + c * 32 + q4); }
#pragma unroll
                for (int j = 0; j < 8; ++j) { const int task = tid + NTHR * j, cl = task >> 3, q4 = (task & 7) * 4; const float m = mq[j];
                    *(f32x4*)(xs + cl * 64 + q4) = vq[j] * (1.0f - m); *(f32x4*)(xs + cl * 64 + 32 + q4) = vq[j] * m; }
                __syncthreads();
#pragma unroll 1
                for (int i = 0; i < 8; ++i) { const float wr = wreg[0];
#pragma unroll
                    for (int q = 0; q < 15; ++q) wreg[q] = wreg[q + 1];
                    const float* xr = xs + (size_t)i * 4096 + lane;
#pragma unroll
                    for (int j = 0; j < 64; ++j) a += RL(wr, j) * xr[j * 64]; }
            }
            p.WinT[(size_t)NINX * D_ + (size_t)(NIN + lane) * D_ + k] = (bf16_t)(cvt_pk_bf16(a, a) & 0xffffu);
        }
        __syncthreads();
    }
}
__device__ __forceinline__ void phase_cv_wrt(const Params& p) {
    const int tid = tid_();
    for (int idx = bid_() * NTHR + tid; idx < 2 * NE * D_; idx += nblk_() * NTHR) {
        const int l = idx / (NE * D_), r = idx - l * (NE * D_), e = r / D_, k = r - e * D_;
        const float v = p.w_router[((size_t)l * D_ + k) * NE + e];
        const unsigned hi = cvt_pk_bf16(v, v) & 0xffffu; const float rem = v - bflo(hi);
        p.WrT[(size_t)(l * 2) * NE * D_ + r] = (bf16_t)hi; p.WrT[(size_t)(l * 2 + 1) * NE * D_ + r] = (bf16_t)(cvt_pk_bf16(rem, rem) & 0xffffu);
    }
}

struct EpiIn {
    bf16_t* P; bf16_t* Vt; float* VV;
    __device__ __forceinline__ void operator()(const gp::Acc& acc, const gp::Unit& u, int wr, int wc, int fr, int fq) const {
        const int row0 = u.pm * 256 + wr * 64 + fr, col0 = u.pn * 256 + wc * 32 + 8 * fq;
        if (u.pn == 25) {
            if (wc < 2) {
#pragma unroll
                for (int ai = 0; ai < 2; ++ai)
#pragma unroll
                    for (int m = 0; m < 4; ++m) { float* vp = VV + (size_t)(row0 + ai * 128 + m * 16) * 64 + wc * 32 + 8 * fq;
                        *(f32x4*)vp = acc[ai][0][m][0]; *(f32x4*)(vp + 4) = acc[ai][0][m][1]; } }
            return;
        }
#pragma unroll
        for (int ai = 0; ai < 2; ++ai)
#pragma unroll
            for (int m = 0; m < 4; ++m) { bf16_t* rowp = P + (size_t)(row0 + ai * 128 + m * 16) * NIN + col0;
#pragma unroll
                for (int bj = 0; bj < 2; ++bj) { const f32x4 v0 = acc[ai][bj][m][0], v1 = acc[ai][bj][m][1];
                    u32x4 w; w.x = cvt_pk_bf16(v0[0], v0[1]); w.y = cvt_pk_bf16(v0[2], v0[3]); w.z = cvt_pk_bf16(v1[0], v1[1]); w.w = cvt_pk_bf16(v1[2], v1[3]);
                    *(u32x4*)(rowp + bj * 128) = w; } }
    }
};
struct EpiBf16Rows {
    bf16_t* C; int ldc;
    __device__ __forceinline__ void operator()(const gp::Acc& acc, const gp::Unit& u, int wr, int wc, int fr, int fq) const {
        const int row0 = u.pm * 256 + wr * 64 + fr, col0 = u.pn * 256 + wc * 32 + 8 * fq;
#pragma unroll
        for (int ai = 0; ai < 2; ++ai)
#pragma unroll
            for (int m = 0; m < 4; ++m) { bf16_t* rowp = C + (size_t)(row0 + ai * 128 + m * 16) * ldc + col0;
#pragma unroll
                for (int bj = 0; bj < 2; ++bj) { const f32x4 v0 = acc[ai][bj][m][0], v1 = acc[ai][bj][m][1];
                    u32x4 w; w.x = cvt_pk_bf16(v0[0], v0[1]); w.y = cvt_pk_bf16(v0[2], v0[3]); w.z = cvt_pk_bf16(v1[0], v1[1]); w.w = cvt_pk_bf16(v1[2], v1[3]);
                    *(u32x4*)(rowp + bj * 128) = w; } }
    }
};
struct EpiF32 {
    float* C; int ldc;
    __device__ __forceinline__ void operator()(const gp::Acc& acc, const gp::Unit& u, int wr, int wc, int fr, int fq) const {
        const int row0 = u.pm * 256 + wr * 64 + fr, col0 = u.pn * 256 + wc * 32 + 4 * fq;
#pragma unroll
        for (int ai = 0; ai < 2; ++ai)
#pragma unroll
            for (int m = 0; m < 4; ++m) { float* rowp = C + (size_t)(row0 + ai * 128 + m * 16) * ldc + col0;
#pragma unroll
                for (int bj = 0; bj < 2; ++bj)
#pragma unroll
                    for (int n = 0; n < 2; ++n) *(f32x4*)(rowp + bj * 128 + n * 16) = acc[ai][bj][m][n]; }
    }
};
__device__ __forceinline__ void phase_gemm_in8(const Params& p, int l, unsigned char* lds) {
    gp::DenseSched S; S.init(p.Hn, p.WinT + (size_t)l * NINX * D_, T_, l ? NINX : NIN, D_, nblk_(), bid_());
    EpiIn E{p.P, p.Vt, p.VV};
    gp::gemm_phase<false, 1, GP_SP2, GP_ALIGN>((LAS unsigned char*)lds, D_, S, E);
    {
        const int G = nblk_(), c = bid_(), nwg = (T_ / 256) * ((l ? NINX : NIN) / 256), nlong = nwg % G;
        if (nlong != 0 && c >= nlong) {
            const int tid = tid_(), lane = tid & 63, w = tid >> 6, sw = (c - nlong) * NW_ + w, nsw = (G - nlong) * NW_;
            unsigned char* scr = lds + w * 9216;
            (void)convert_stream(p, cv_hi(l) + sw, nsw, cv_hi(l) + CV_NPRE(l), nullptr, scr, lane);
        }
    }
}
__device__ __forceinline__ void phase_gemm_out8(const Params& p, int l, unsigned char* lds) {
    gp::DenseSched S; S.init(p.ocat, p.WoutT + (size_t)l * D_ * D_, T_, D_, D_, nblk_(), bid_());
    EpiBf16Rows E{(bf16_t*)p.mixed, D_};
    gp::gemm_phase<false, 1, GP_SP2, GP_ALIGN>((LAS unsigned char*)lds, D_, S, E);
}

__device__ __forceinline__ void build_tables(const Params& p, int l, int* tab, int tshift) {
    if (threadIdx.x == 0) {
        int pb = 0, tb = 0;
        for (int e = 0; e <= NE; ++e) { const int c = (e < NE) ? (int)__hip_atomic_load(p.counts + (l * NE + e) * 32, __ATOMIC_RELAXED, __HIP_MEMORY_SCOPE_AGENT) : T_;
            tab[e] = c; tab[80 + e] = pb; tab[160 + e] = tb; pb += (c + 255) & ~255; tb += (c + (1 << tshift) - 1) >> tshift; }
        tab[80 + NE + 1] = pb; tab[160 + NE + 1] = tb;
    }
    __syncthreads();
    {
        unsigned char* emap = (unsigned char*)(tab + 256);
        const int nt = tab[160 + NE + 1];
        for (int rt = tid_(); rt < nt && rt < 1024; rt += NTHR) { int e = 0; while (e < NE && rt >= tab[160 + e + 1]) ++e; emap[rt] = (unsigned char)e; }
    }
    __syncthreads();
}
__device__ __forceinline__ int find_expert(const int* tab, int rt) { return (int)((const unsigned char*)(tab + 256))[rt]; }

struct MoeSched {
    const int* tab; const char* A; const char* Bt; size_t bt_stride; const int* rowtok; int K, nN, nunits, G, c; bool gather;
    __device__ __forceinline__ bool next(int i, gp::Unit& u) const {
        const int L = i * G + c; if (L >= nunits) return false;
        const int rtg = L / nN; u.pn = L - rtg * nN; const int e = find_expert(tab, rtg); u.e = e; u.pm = rtg - tab[160 + e]; return true;
    }
    __device__ __forceinline__ const char* a_base(const gp::Unit& u) const { return gather ? A : A + (size_t)(tab[80 + u.e] + u.pm * 256) * K * 2; }
    __device__ __forceinline__ const char* b_base(const gp::Unit& u) const { return Bt + (size_t)u.e * bt_stride + (size_t)u.pn * 256 * K * 2; }
    __device__ __forceinline__ int a_row(const gp::Unit& u, int r) const { const int slot = u.pm * 256 + r; return (slot < tab[u.e]) ? ((u.e < NE) ? rowtok[u.e * CAP + slot] : slot) : 0; }
};
struct EpiSwiglu {
    bf16_t* H1; const int* tab;
    __device__ __forceinline__ void operator()(const gp::Acc& acc, const gp::Unit& u, int wr, int wc, int fr, int fq) const {
        const int row0 = tab[80 + u.e] + u.pm * 256 + wr * 64 + fr, hid0 = u.pn * 128 + wc * 32 + 8 * fq;
#pragma unroll
        for (int ai = 0; ai < 2; ++ai)
#pragma unroll
            for (int m = 0; m < 4; ++m) { bf16_t* rowp = H1 + (size_t)(row0 + ai * 128 + m * 16) * 512 + hid0;
                float h[8];
#pragma unroll
                for (int n = 0; n < 2; ++n)
#pragma unroll
                    for (int jj = 0; jj < 4; ++jj) { const float g = acc[ai][0][m][n][jj], uu = acc[ai][1][m][n][jj]; h[n * 4 + jj] = g * frcp_(1.0f + __expf(-g)) * uu; }
                u32x4 o; o.x = cvt_pk_bf16(h[0], h[1]); o.y = cvt_pk_bf16(h[2], h[3]); o.z = cvt_pk_bf16(h[4], h[5]); o.w = cvt_pk_bf16(h[6], h[7]);
                *(u32x4*)rowp = o; }
    }
};
#define Y2_SCALE 8.0f
struct EpiDown {
    unsigned char* Y2; const int* tab;
    __device__ __forceinline__ void operator()(const gp::Acc& acc, const gp::Unit& u, int wr, int wc, int fr, int fq) const {
        const int slot0 = u.pm * 256 + wr * 64 + fr, cnt = tab[u.e], row0 = tab[80 + u.e] + slot0, col0 = u.pn * 256 + wc * 64 + 16 * fq;
#pragma unroll
        for (int ai = 0; ai < 2; ++ai)
#pragma unroll
            for (int m = 0; m < 4; ++m) {
                if (slot0 + ai * 128 + m * 16 < cnt) {
                    u32x4 o;
#pragma unroll
                    for (int bj = 0; bj < 2; ++bj) { f32x4 v0 = acc[ai][bj][m][0] * Y2_SCALE, v1 = acc[ai][bj][m][1] * Y2_SCALE;
#pragma unroll
                        for (int jj = 0; jj < 4; ++jj) { v0[jj] = __builtin_amdgcn_fmed3f(v0[jj], -440.0f, 440.0f); v1[jj] = __builtin_amdgcn_fmed3f(v1[jj], -440.0f, 440.0f); }
                        int w0 = __builtin_amdgcn_cvt_pk_fp8_f32(v0[0], v0[1], 0, false); w0 = __builtin_amdgcn_cvt_pk_fp8_f32(v0[2], v0[3], w0, true);
                        int w1 = __builtin_amdgcn_cvt_pk_fp8_f32(v1[0], v1[1], 0, false); w1 = __builtin_amdgcn_cvt_pk_fp8_f32(v1[2], v1[3], w1, true);
                        if (bj == 0) { o.x = (unsigned)w0; o.y = (unsigned)w1; } else { o.z = (unsigned)w0; o.w = (unsigned)w1; } }
                    *(u32x4*)(Y2 + (size_t)(row0 + ai * 128 + m * 16) * D_ + col0) = o; } }
    }
};
__device__ __forceinline__ int xcd_order(int c, int G) { return (G % 8 == 0) ? (c % 8) * (G / 8) + c / 8 : c; }
__device__ __forceinline__ void phase_moe_gu8(const Params& p, int l, unsigned char* lds) {
    int* tab = (int*)(lds + TAB_OFF);
    build_tables(p, l, tab, 8);
    MoeSched S{tab, (const char*)p.Hn, (const char*)(p.WguT + (size_t)l * 65 * 1024 * D_), (size_t)1024 * D_ * 2, p.rowtok, D_, 4, tab[160 + NE + 1] * 4, nblk_(), xcd_order(bid_(), nblk_()), true};
    EpiSwiglu E{p.H1, tab};
    gp::gemm_phase<true, 1, GP_SP2, GP_ALIGN>((LAS unsigned char*)lds, D_, S, E);
}
__device__ __forceinline__ void phase_moe_down8(const Params& p, int l, unsigned char* lds) {
    int* tab = (int*)(lds + TAB_OFF);
    build_tables(p, l, tab, 8);
    MoeSched S{tab, (const char*)p.H1, (const char*)(p.WdT + (size_t)l * 65 * D_ * 512), (size_t)D_ * 512 * 2, p.rowtok, 512, 8, tab[160 + NE + 1] * 8, nblk_(), xcd_order(bid_(), nblk_()), false};
    EpiDown E{(unsigned char*)p.Y2, tab};
    gp::gemm_phase<false, 2, GP_SP2, GP_ALIGN>((LAS unsigned char*)lds, 512, S, E);
}

__device__ __forceinline__ void phase_adaln(const Params& p, unsigned char* lds) {
    typedef float f32x2a __attribute__((ext_vector_type(2)));
    float* cond = (float*)lds;
    float* red = cond + 4 * D_;
    const int tid = tid_(), lane = tid & 63, w = tid >> 6;
    for (int i = tid; i < 4 * D_; i += NTHR) { const float v = p.c[i]; cond[(i & (D_ - 1)) * 4 + (i >> 11)] = v / (1.0f + __expf(-v)); }
    __syncthreads();
    for (int unit = bid_(); unit < 192; unit += nblk_()) {
        const int l = unit / 96, n0 = (unit % 96) * 128, k0 = rfl(w) * 256;
        const float* W = p.w_ada + (size_t)l * D_ * 12288 + (size_t)k0 * 12288 + n0;
        f32x2a acc[4];
#pragma unroll
        for (int b = 0; b < 4; ++b) acc[b] = (f32x2a){0.f, 0.f};
#pragma unroll 1
        for (int kb = 0; kb < 256; kb += 16) {
            f32x2a wv[16];
#pragma unroll
            for (int k = 0; k < 16; ++k) wv[k] = *(const f32x2a*)(W + (size_t)((kb + k) * 12288) + lane * 2);
#pragma unroll
            for (int k = 0; k < 16; ++k) { const f32x4 cv = *(const f32x4*)(cond + (k0 + kb + k) * 4);
#pragma unroll
                for (int b = 0; b < 4; ++b) acc[b] += wv[k] * cv[b]; }
        }
#pragma unroll
        for (int b = 0; b < 4; ++b) *(f32x2a*)(red + (w * 4 + b) * 128 + lane * 2) = acc[b];
        __syncthreads();
        { const int b = tid >> 7, col = tid & 127; float sm = 0.f;
#pragma unroll
            for (int ww = 0; ww < NW_; ++ww) sm += red[(ww * 4 + b) * 128 + col];
            p.mod[((size_t)l * 4 + b) * 12288 + n0 + col] = sm + p.b_ada[(size_t)l * 12288 + n0 + col]; }
        __syncthreads();
    }
}

__device__ __forceinline__ void emit_hn(const f32x4 (&xv)[8], float rstd, const float* g, const float* sc, const float* sh, bf16_t* dst, int lane, float* hf) {
#pragma unroll
    for (int i = 0; i < 8; ++i) {
        const int e = i * 256 + lane * 4;
        const f32x4 gv = *(const f32x4*)(g + e), scv = *(const f32x4*)(sc + e), shv = *(const f32x4*)(sh + e);
        f32x4 h;
#pragma unroll
        for (int j = 0; j < 4; ++j) h[j] = xv[i][j] * rstd * gv[j] * (1.0f + scv[j]) + shv[j];
        u32x2 o; o.x = cvt_pk_bf16(h[0], h[1]); o.y = cvt_pk_bf16(h[2], h[3]);
        *(u32x2*)(dst + e) = o;
        if (hf) *(f32x4*)(hf + e) = h;
    }
}

__device__ __forceinline__ void phase_prenorm0(const Params& p) {
    const int lane = tid_() & 63, gw = bid_() * (NTHR / 64) + (tid_() >> 6), nw = nblk_() * (NTHR / 64);
    f32x4 xn[8];
    if (gw < T_) {
#pragma unroll
        for (int i = 0; i < 8; ++i) xn[i] = *(const f32x4*)(p.x + (size_t)gw * D_ + i * 256 + lane * 4);
    }
    for (int t = gw; t < T_; t += nw) {
        const int b = t / S_;
        f32x4 xv[8]; float ss = 0.f;
#pragma unroll
        for (int i = 0; i < 8; ++i) { xv[i] = xn[i]; ss += xv[i][0] * xv[i][0] + xv[i][1] * xv[i][1] + xv[i][2] * xv[i][2] + xv[i][3] * xv[i][3]; }
        if (t + nw < T_) {
#pragma unroll
            for (int i = 0; i < 8; ++i) xn[i] = *(const f32x4*)(p.x + (size_t)(t + nw) * D_ + i * 256 + lane * 4);
        }
        ss = wave_sum(ss);
        const float rstd = rsqrtf(ss * (1.0f / D_) + 1e-6f);
        const float* md = p.mod + (size_t)b * 12288;
        emit_hn(xv, rstd, p.g_pre_mix, md + 2048, md, p.Hn + (size_t)t * D_, lane, nullptr);
    }
}

__device__ __forceinline__ void phase_gemm_in(const Params& p, int l, unsigned char* lds) {
    const float* B = p.w_in + (size_t)l * D_ * NIN;
    for (int unit = bid_(); unit < 64 * 50; unit += nblk_()) {
        const int mt = unit / 50, nt = unit % 50;
        bf16_t* Pp = p.P;
        gemm_tile(lds, p.Hn, D_, [=](int r) { return mt * 128 + r; }, B + nt * 128 + (tid_() & 127), NIN, D_,
                  [=](int m, int n, f32x4 v) { u32x2 o; o.x = cvt_pk_bf16(v[0], v[1]); o.y = cvt_pk_bf16(v[2], v[3]); *(u32x2*)(Pp + (size_t)(mt * 128 + m) * NIN + nt * 128 + n) = o; });
    }
}

__device__ __forceinline__ void phase_attn_naive(const Params& p) {
    const int lane = tid_() & 63, gw = bid_() * (NTHR / 64) + (tid_() >> 6), nw = nblk_() * (NTHR / 64);
    float* tmp = p.mixed;
    for (int it = gw; it < 2048; it += nw) {
        const int item = rfl(it);
        const int qb = 31 - (item >> 6), rest = item & 63, c = rest & 1, h = (rest >> 1) & 7, b = rest >> 4;
        const int q = qb * 64 + lane;
        const bf16_t* Pb = p.P + (size_t)b * S_ * NIN;
        float qv[64];
        {
            const bf16_t* qp = Pb + (size_t)q * NIN + h * 128 + c * 64;
#pragma unroll
            for (int i = 0; i < 8; ++i) { const u32x4 u = *(const u32x4*)(qp + i * 8);
#pragma unroll
                for (int j = 0; j < 4; ++j) { qv[i * 8 + j * 2] = __uint_as_float(u[j] << 16); qv[i * 8 + j * 2 + 1] = __uint_as_float(u[j] & 0xffff0000u); } }
        }
        const float scale2 = 0.125f * 1.44269504f, slope2 = exp2f(-(float)(h + 1)) * 1.44269504f;
        const int jmax = qb * 64 + 63;
        const bf16_t* kbase = Pb + 1024 + h * 128 + c * 64;
        const bf16_t* vbase = Pb + 2048 + h * 128;
        float m = -1e30f;
        for (int j = 0; j <= jmax; ++j) {
            const u32x4* kp = (const u32x4*)(kbase + (size_t)j * NIN);
            float s = 0.f;
#pragma unroll
            for (int i = 0; i < 8; ++i) { const u32x4 u = kp[i];
#pragma unroll
                for (int jj = 0; jj < 4; ++jj) { s += qv[i * 8 + jj * 2] * __uint_as_float(u[jj] << 16); s += qv[i * 8 + jj * 2 + 1] * __uint_as_float(u[jj] & 0xffff0000u); } }
            s = s * scale2 - slope2 * (float)(q - j);
            if (j <= q) m = fmaxf(m, s);
        }
        const float minv = 1.0f;
#pragma unroll 1
        for (int dh = 0; dh < 2; ++dh) {
            float lsum = 0.f; float acc[64];
#pragma unroll
            for (int d = 0; d < 64; ++d) acc[d] = 0.f;
            for (int j = 0; j <= jmax; ++j) {
                const u32x4* kp = (const u32x4*)(kbase + (size_t)j * NIN);
                float s = 0.f;
#pragma unroll
                for (int i = 0; i < 8; ++i) { const u32x4 u = kp[i];
#pragma unroll
                    for (int jj = 0; jj < 4; ++jj) { s += qv[i * 8 + jj * 2] * __uint_as_float(u[jj] << 16); s += qv[i * 8 + jj * 2 + 1] * __uint_as_float(u[jj] & 0xffff0000u); } }
                s = s * scale2 - slope2 * (float)(q - j);
                const float pj = (j <= q) ? exp2f(s - m) : 0.f;
                lsum += pj;
                const u32x4* vp = (const u32x4*)(vbase + (size_t)j * NIN + dh * 64);
#pragma unroll
                for (int i = 0; i < 8; ++i) { const u32x4 u = vp[i];
#pragma unroll
                    for (int jj = 0; jj < 4; ++jj) { acc[i * 8 + jj * 2] += pj * __uint_as_float(u[jj] << 16); acc[i * 8 + jj * 2 + 1] += pj * __uint_as_float(u[jj] & 0xffff0000u); } }
            }
            const float inv = minv / lsum;
            float* op = tmp + (size_t)(b * S_ + q + launder0()) * D_ + h * 256 + c * 128;
#pragma unroll
            for (int d = 0; d < 64; d += 4) *(f32x4*)(op + dh * 64 + d) = (f32x4){acc[d] * inv, acc[d + 1] * inv, acc[d + 2] * inv, acc[d + 3] * inv};
        }
    }
}

typedef float f32x16 __attribute__((ext_vector_type(16)));
#define AT_ROWB 144
#define AT_VOFF (128 * AT_ROWB)
#define AT_BUFB (128 * AT_ROWB + 64 * 256)
__device__ __forceinline__ int at_voff(int row, int ch) { return 256 * row + 16 * (ch ^ (((row & 3) << 2) | ((row >> 2) & 3))); }
typedef short s16x4 __attribute__((ext_vector_type(4)));
__device__ __forceinline__ void phase_attn8(const Params& p, int l, unsigned char* lds) {
    const int tid = tid_(), lane = tid & 63, w = tid >> 6, r32 = lane & 31, hh = lane >> 5, c = w >> 2, wq = w & 3;
    const int srow = tid >> 3, sch = tid & 7;
    const float lam_init = (l == 0) ? 0.2f : 0.35550907f;
    for (int u0 = bid_(); u0 < 256; u0 += nblk_()) {
        const int unit = (nblk_() == 256) ? xcd_order(u0, 256) : u0;
        const int jp = unit & 7, h = (unit >> 3) & 7, b = unit >> 6;
        const bf16_t* Pb = p.P + (size_t)b * S_ * NIN;
        const bf16_t* Kg = Pb + 1024 + h * 128;
        const bf16_t* Vg = Pb + 2048 + h * 128;
        const unsigned koff = (unsigned)(srow * NIN + sch * 8), voff = (unsigned)((tid >> 4) * NIN + (tid & 15) * 8);
        const float scale2 = 0.125f * 1.44269504f, slopeS = exp2f((float)(2 - h));
        bf16x8 qx, kx0, kx1;
        { u32x4 z = (u32x4){0u, 0u, 0u, 0u}, a0 = z, a1 = z, qq = z;
          if (hh == 0) { a0.x = cvt_pk_bf16((float)r32, 0.f); a1.x = cvt_pk_bf16((float)(32 + r32), 0.f); qq.x = cvt_pk_bf16(slopeS, 0.f); }
          kx0 = __builtin_bit_cast(bf16x8, a0); kx1 = __builtin_bit_cast(bf16x8, a1); qx = __builtin_bit_cast(bf16x8, qq); }
#pragma unroll 1
        for (int half = 0; half < 2; ++half) {
            const int qb = half ? jp : 15 - jp;
            const int q0 = qb * 128 + wq * 32, q = q0 + r32;
            bf16x8 qf[4];
            { const bf16_t* qp = Pb + (size_t)q * NIN + h * 128 + c * 64 + 8 * hh;
#pragma unroll
              for (int ks = 0; ks < 4; ++ks) qf[ks] = *(const bf16x8*)(qp + 16 * ks); }
            f32x16 O[4];
#pragma unroll
            for (int d = 0; d < 4; ++d)
#pragma unroll
                for (int r = 0; r < 16; ++r) O[d][r] = 0.f;
            float m = -1e30f, lsum = 0.f;
            const int ntiles = 2 * qb + 2;
            u32x4 rk0, rk1, rv0, rv1, nk0, nk1, nv0, nv1;
            rk0 = *(const u32x4*)(Kg + koff); rk1 = *(const u32x4*)(Kg + 64 + koff); rv0 = *(const u32x4*)(Vg + voff); rv1 = *(const u32x4*)(Vg + (size_t)32 * NIN + voff);
            *(u32x4*)(lds + srow * AT_ROWB + sch * 16) = rk0; *(u32x4*)(lds + (64 + srow) * AT_ROWB + sch * 16) = rk1;
            *(u32x4*)(lds + AT_VOFF + at_voff(tid >> 4, tid & 15)) = rv0; *(u32x4*)(lds + AT_VOFF + at_voff(32 + (tid >> 4), tid & 15)) = rv1;
            { const bf16_t* kq = Kg + (size_t)64 * NIN; const bf16_t* vq = Vg + (size_t)64 * NIN;
              rk0 = *(const u32x4*)(kq + koff); rk1 = *(const u32x4*)(kq + 64 + koff); rv0 = *(const u32x4*)(vq + voff); rv1 = *(const u32x4*)(vq + (size_t)32 * NIN + voff); }
            __syncthreads();
            auto tile = [&](const int kt, u32x4& hk0, u32x4& hk1, u32x4& hv0, u32x4& hv1, u32x4& gk0, u32x4& gk1, u32x4& gv0, u32x4& gv1) __attribute__((always_inline)) {
                unsigned char* bufp = lds + (kt & 1) * AT_BUFB;
                { const int kn = (kt + 2 < ntiles) ? kt + 2 : ntiles - 1;
                    const bf16_t* kq = Kg + (size_t)kn * 64 * NIN; const bf16_t* vq = Vg + (size_t)kn * 64 * NIN;
                    gk0 = *(const u32x4*)(kq + koff); gk1 = *(const u32x4*)(kq + 64 + koff); gv0 = *(const u32x4*)(vq + voff); gv1 = *(const u32x4*)(vq + (size_t)32 * NIN + voff); }
                if (kt * 64 <= q0 + 31) {
                    f32x16 st[2];
                    {
                        bf16x8 kfr[2][4];
#pragma unroll
                        for (int kb = 0; kb < 2; ++kb)
#pragma unroll
                            for (int ks = 0; ks < 4; ++ks) kfr[kb][ks] = *(const bf16x8*)(bufp + (c * 64 + 32 * kb + r32) * AT_ROWB + (16 * ks + 8 * hh) * 2);
                        __builtin_amdgcn_sched_barrier(0);
#pragma unroll
                        for (int kb = 0; kb < 2; ++kb) {
                            f32x16 a;
#pragma unroll
                            for (int r = 0; r < 16; ++r) a[r] = 0.f;
                            a = __builtin_amdgcn_mfma_f32_32x32x16_bf16(kb ? kx1 : kx0, qx, a, 0, 0, 0);
#pragma unroll
                            for (int ks = 0; ks < 4; ++ks) a = __builtin_amdgcn_mfma_f32_32x32x16_bf16(kfr[kb][ks], qf[ks], a, 0, 0, 0);
                            st[kb] = a;
                        }
                    }
                    const int g_ = lane >> 4, q_ = (lane >> 2) & 3, p_ = lane & 3, clx = (2 * (g_ & 1) + (p_ >> 1)) ^ (g_ >> 1);
                    const LAS unsigned char* vb0 = (const LAS unsigned char*)(bufp + AT_VOFF) + 8 * (p_ & 1) + 256 * (4 * (g_ >> 1) + q_) + 16 * clx;
                    const LAS unsigned char* vb1 = (const LAS unsigned char*)(bufp + AT_VOFF) + 8 * (p_ & 1) + 256 * (4 * (g_ >> 1) + q_) + 16 * (clx ^ 2);
                    s16x4 vt[2][8];
#define AT_VLOAD(buf, d) do { const int dq_ = 64 * ((d) ^ q_); _Pragma("unroll") for (int kb_ = 0; kb_ < 2; ++kb_) _Pragma("unroll") for (int s2_ = 0; s2_ < 2; ++s2_) { \
                            vt[buf][(kb_ * 2 + s2_) * 2] = __builtin_amdgcn_ds_read_tr16_b64_v4i16((LAS s16x4*)(vb0 + dq_ + 256 * (32 * kb_ + 16 * s2_))); \
                            vt[buf][(kb_ * 2 + s2_) * 2 + 1] = __builtin_amdgcn_ds_read_tr16_b64_v4i16((LAS s16x4*)(vb1 + dq_ + 256 * (32 * kb_ + 16 * s2_ + 8))); } } while (0)
                    AT_VLOAD(0, 0);
                    __builtin_amdgcn_sched_barrier(0);
                    const float tb = slopeS * (float)(kt * 64);
                    float mx = -1e30f;
                    if (kt * 64 + 63 > q0) {
                        const int kmq = kt * 64 + 4 * hh - q;
#pragma unroll
                        for (int kb = 0; kb < 2; ++kb)
#pragma unroll
                            for (int r = 0; r < 16; ++r) { const int off = 32 * kb + (r & 3) + 8 * (r >> 2);
                                const float sv = (kmq + off > 0) ? -1e30f : st[kb][r]; st[kb][r] = sv; mx = fmaxf(mx, sv); }
                    } else {
#pragma unroll
                        for (int kb = 0; kb < 2; ++kb)
#pragma unroll
                            for (int r = 0; r < 16; ++r) mx = fmaxf(mx, st[kb][r]);
                    }
                    mx = fmaxf(mx, __shfl_xor(mx, 32));
                    const float mn = fmaxf(m, mx + tb), alpha = __builtin_amdgcn_exp2f((m - mn) * scale2);
                    const bool resc = __any(mn > m);
                    m = mn;
                    const float cexp = (tb - mn) * scale2;
                    float rs = 0.f;
#pragma unroll
                    for (int kb = 0; kb < 2; ++kb)
#pragma unroll
                        for (int r = 0; r < 16; ++r) { const float pe = __builtin_amdgcn_exp2f(st[kb][r] * scale2 + cexp); st[kb][r] = pe; rs += pe; }
                    rs += __shfl_xor(rs, 32);
                    lsum = lsum * alpha + rs;
                    if (resc) {
#pragma unroll
                        for (int d = 0; d < 4; ++d)
#pragma unroll
                            for (int r = 0; r < 16; ++r) O[d][r] *= alpha;
                    }
                    bf16x8 pf[2][2];
#pragma unroll
                    for (int kb = 0; kb < 2; ++kb)
#pragma unroll
                        for (int s2 = 0; s2 < 2; ++s2) { u32x4 u; u.x = cvt_pk_bf16(st[kb][8 * s2 + 0], st[kb][8 * s2 + 1]); u.y = cvt_pk_bf16(st[kb][8 * s2 + 2], st[kb][8 * s2 + 3]);
                            u.z = cvt_pk_bf16(st[kb][8 * s2 + 4], st[kb][8 * s2 + 5]); u.w = cvt_pk_bf16(st[kb][8 * s2 + 6], st[kb][8 * s2 + 7]); pf[kb][s2] = __builtin_bit_cast(bf16x8, u); }
                    {
#pragma unroll
                        for (int d = 0; d < 4; ++d) {
                            if (d + 1 < 4) AT_VLOAD((d + 1) & 1, d + 1);
                            __builtin_amdgcn_sched_barrier(0);
#pragma unroll
                            for (int kb = 0; kb < 2; ++kb)
#pragma unroll
                                for (int s2 = 0; s2 < 2; ++s2) {
                                    const bf16x8 vf = __builtin_shufflevector(vt[d & 1][(kb * 2 + s2) * 2], vt[d & 1][(kb * 2 + s2) * 2 + 1], 0, 1, 2, 3, 4, 5, 6, 7);
                                    O[d] = __builtin_amdgcn_mfma_f32_32x32x16_bf16(vf, pf[kb][s2], O[d], 0, 0, 0); }
                            __builtin_amdgcn_sched_barrier(0);
                        }
#undef AT_VLOAD
                    }
                }
                if (kt + 1 < ntiles) { unsigned char* nb = lds + ((kt + 1) & 1) * AT_BUFB;
                    *(u32x4*)(nb + srow * AT_ROWB + sch * 16) = hk0; *(u32x4*)(nb + (64 + srow) * AT_ROWB + sch * 16) = hk1;
                    *(u32x4*)(nb + AT_VOFF + at_voff(tid >> 4, tid & 15)) = hv0; *(u32x4*)(nb + AT_VOFF + at_voff(32 + (tid >> 4), tid & 15)) = hv1; }
                __syncthreads();
            };
#pragma unroll 1
            for (int kt = 0; kt < ntiles; kt += 2) { tile(kt, rk0, rk1, rv0, rv1, nk0, nk1, nv0, nv1); tile(kt + 1, nk0, nk1, nv0, nv1, rk0, rk1, rv0, rv1); }
            const float inv = 1.0f / lsum;
            float* xo = (float*)lds + (size_t)wq * 64 * 64 + lane;
            if (c == 1) {
#pragma unroll
                for (int d = 0; d < 4; ++d)
#pragma unroll
                    for (int r = 0; r < 16; ++r) xo[(d * 16 + r) * 64] = O[d][r] * inv;
            }
            __syncthreads();
            if (c == 0) {
                float lam;
                { const float s1 = wave_sum(p.lam_q1[l * 64 + lane] * p.lam_k1[l * 64 + lane]), s2 = wave_sum(p.lam_q2[l * 64 + lane] * p.lam_k2[l * 64 + lane]); lam = __expf(s1) - __expf(s2) + lam_init; }
                float ss = 0.f;
#pragma unroll
                for (int d = 0; d < 4; ++d)
#pragma unroll
                    for (int r = 0; r < 16; ++r) { const float o = O[d][r] * inv - lam * xo[(d * 16 + r) * 64]; O[d][r] = o; ss += o * o; }
                ss += __shfl_xor(ss, 32);
                const float rstd = rsqrtf(ss * (1.0f / 128.0f) + 1e-5f) * (1.0f - lam_init);
                bf16_t* op = p.ocat + (size_t)(b * S_ + q) * D_ + h * 128 + 4 * hh;
                const float* sg = p.subln_g + l * 128 + 4 * hh;
#pragma unroll
                for (int d = 0; d < 4; ++d)
#pragma unroll
                    for (int g = 0; g < 4; ++g) { const f32x4 gv = *(const f32x4*)(sg + 32 * d + 8 * g);
                        u32x2 o; o.x = cvt_pk_bf16(O[d][4 * g] * rstd * gv[0], O[d][4 * g + 1] * rstd * gv[1]); o.y = cvt_pk_bf16(O[d][4 * g + 2] * rstd * gv[2], O[d][4 * g + 3] * rstd * gv[3]);
                        *(u32x2*)(op + 32 * d + 8 * g) = o; }
            }
            __syncthreads();
        }
    }
}

__device__ __forceinline__ float shifted(const bf16_t* P, int t, int col, float mu) {
    const float cur = bf2f(P[(size_t)t * NIN + 3072 + col]);
    const float prev = (t % S_) ? bf2f(P[(size_t)(t - 1) * NIN + 3072 + col]) : 0.f;
    return cur + (prev - cur) * mu;
}
#define PREP_RB 2
__device__ __forceinline__ void phase_rwkv_prep(const Params& p, int l, unsigned char* lds) {
    float* lowr = (float*)lds;
    float* vrow = lowr + PREP_RB * 256;
    float* red = vrow + PREP_RB * 1024;
    float* vv = red + PREP_RB * 512;
    const int tid = tid_(), lane = tid & 63;
    const float* mu = p.mu + (size_t)l * 3328;
    const float *w0 = p.w0 + l * RW, *w2 = p.w2 + (size_t)l * 64 * RW, *a0 = p.a0 + l * RW, *a2 = p.a2 + (size_t)l * 64 * RW, *g2 = p.g2 + (size_t)l * 128 * RW;
    const float *k_k = p.k_k + l * RW, *k_a = p.k_a + l * RW, *r_k = p.r_k + l * RW;
    for (int unit = bid_(); unit < T_ / PREP_RB; unit += nblk_()) {
        const int t0 = unit * PREP_RB;
        for (int idx = tid; idx < PREP_RB * 256; idx += NTHR) {
            const int r = idx >> 8, m = idx & 255;
            const float f = shifted(p.P, t0 + r, 3072 + m, mu[3072 + m]);
            lowr[idx] = (m < 64) ? tanhf(f) : (m < 128) ? f : sigmoidf_(f);
        }
        if (l > 0) {
            for (int idx = tid; idx < PREP_RB * 1024; idx += NTHR) { const int r = idx >> 10, cc = idx & 1023; vrow[idx] = shifted(p.P, t0 + r, 2048 + cc, mu[2048 + cc]); }
        }
        __syncthreads();
        if (l > 0) {
            const int j = tid & 31, part = tid >> 5;
            const float* v1 = p.v1;
#pragma unroll
            for (int r = 0; r < PREP_RB; ++r) {
                float s = 0.f;
#pragma unroll 4
                for (int cc = part * 64; cc < part * 64 + 64; ++cc) s += vrow[r * 1024 + cc] * v1[cc * 32 + j];
                red[(r * 16 + part) * 32 + j] = s;
            }
            __syncthreads();
            if (tid < PREP_RB * 32) { const int r = tid >> 5, jj = tid & 31; float s = 0.f;
#pragma unroll
                for (int pp = 0; pp < 16; ++pp) s += red[(r * 16 + pp) * 32 + jj];
                vv[r * 32 + jj] = s; }
            __syncthreads();
        }
#pragma unroll 1
        for (int i = 0; i < 1024 / NTHR; ++i) {
            const int cc = tid + i * NTHR, h = cc >> 6;
            float wa[PREP_RB], aa[PREP_RB], ga[PREP_RB];
#pragma unroll
            for (int r = 0; r < PREP_RB; ++r) { wa[r] = 0.f; aa[r] = 0.f; ga[r] = 0.f; }
#pragma unroll 2
            for (int m = 0; m < 64; ++m) {
                const float w2v = w2[m * RW + cc], a2v = a2[m * RW + cc], g2a = g2[m * RW + cc], g2b = g2[(64 + m) * RW + cc];
#pragma unroll
                for (int r = 0; r < PREP_RB; ++r) { wa[r] += lowr[r * 256 + m] * w2v; aa[r] += lowr[r * 256 + 64 + m] * a2v; ga[r] += lowr[r * 256 + 128 + m] * g2a + lowr[r * 256 + 192 + m] * g2b; }
            }
#pragma unroll
            for (int r = 0; r < PREP_RB; ++r) {
                const int t = t0 + r;
                const float rr = shifted(p.P, t, cc, mu[cc]), kx = shifted(p.P, t, 1024 + cc, mu[1024 + cc]);
                float vx = shifted(p.P, t, 2048 + cc, mu[2048 + cc]);
                const float wv = w0[cc] + wa[r];
                const float decay = __expf(-sigmoidf_(wv) * 0.60653066f);
                const float a = sigmoidf_(a0[cc] + aa[r]);
                const size_t o = (size_t)t * RW + cc;
                if (l == 0) p.vfirst[o] = vx;
                else {
                    float s = p.v0[cc];
#pragma unroll
                    for (int jj = 0; jj < 32; ++jj) s += vv[r * 32 + jj] * p.v2[jj * RW + cc];
                    vx = vx + (p.vfirst[o] - vx) * sigmoidf_(s);
                }
                const float kk = kx * k_k[cc];
                const float ss = wave_sum(kk * kk);
                const float kkn = kk / fmaxf(sqrtf(ss), 1e-12f);
                const float kh = kx * (1.0f + (a - 1.0f) * k_a[cc]);
                const float bc = wave_sum(rr * kh * r_k[cc]);
                if (lane == 0) p.bcoef[(size_t)t * 16 + h] = bc;
                p.sr[o] = rr; p.sw[o] = decay; p.sk[o] = kh; p.sv[o] = vx; p.sa[o] = -kkn; p.sb[o] = kkn * a; p.sg[o] = ga[r];
            }
        }
        __syncthreads();
    }
}

__device__ __forceinline__ void phase_scan_naive(const Params& p) {
    const int lane = tid_() & 63, gw = (tid_() >> 6) * nblk_() + bid_(), nw = nblk_() * (NTHR / 64);
    for (int it = gw; it < 64; it += nw) {
        const int item = rfl(it), b = item >> 4, h = item & 15;
        float st[64];
#pragma unroll
        for (int j = 0; j < 64; ++j) st[j] = 0.f;
        size_t base = (size_t)b * S_ * RW + h * 64 + lane;
        for (int t = 0; t < S_; ++t, base += RW) {
            const float wv = p.sw[base], av = p.sa[base], bv = p.sb[base], kv = p.sk[base], rv = p.sr[base], vi = p.sv[base];
            float sa = 0.f;
#pragma unroll
            for (int j = 0; j < 64; ++j) sa += st[j] * RL(av, j);
            float y = 0.f;
#pragma unroll
            for (int j = 0; j < 64; ++j) { st[j] = st[j] * RL(wv, j) + sa * RL(bv, j) + vi * RL(kv, j); y += st[j] * RL(rv, j); }
            p.sy[base] = y;
        }
    }
}

#define SC_CH 32
#define SC_BUFB (5 * SC_CH * 256 + SC_CH * 64)
__device__ __forceinline__ float dpp_add16(float x) {
    x += __int_as_float(__builtin_amdgcn_update_dpp(0, __float_as_int(x), 0xB1, 0xF, 0xF, true));
    x += __int_as_float(__builtin_amdgcn_update_dpp(0, __float_as_int(x), 0x4E, 0xF, 0xF, true));
    x += __int_as_float(__builtin_amdgcn_update_dpp(0, __float_as_int(x), 0x141, 0xF, 0xF, true));
    x += __int_as_float(__builtin_amdgcn_update_dpp(0, __float_as_int(x), 0x140, 0xF, 0xF, true));
    return x;
}
#define SC_FLAGS (2 * SC_BUFB)
#define SC_CVSCR (2 * SC_BUFB + 512)
__device__ __forceinline__ unsigned lds_ld(volatile unsigned* q) { return *q; }
__device__ __forceinline__ void phase_scan8(const Params& p, int l, unsigned char* lds) {
    const int tid = tid_(), lane = tid & 63, w = tid >> 6, l16 = lane & 15, rs = lane >> 4;
    volatile unsigned* flg = (volatile unsigned*)(lds + SC_FLAGS);
    for (int u0 = bid_(); u0 < 256; u0 += nblk_()) {
        const int unit = (nblk_() == 256) ? xcd_order(u0, 256) : u0;
        const int bh = unit >> 2, rg = unit & 3, b = bh >> 4, h = bh & 15;
        const size_t gbase = (size_t)b * S_ * RW + h * 64;
        if (tid < 8) flg[tid] = 0u;
        __syncthreads();
        if (w < 4) {
            typedef float f32x2v __attribute__((ext_vector_type(2)));
            f32x2v sA = (f32x2v){0.f, 0.f}, sB = (f32x2v){0.f, 0.f};
            const int irow = rg * 16 + w * 4 + rs;
#pragma unroll 1
            for (int c = 0; c < S_ / SC_CH; ++c) {
                { unsigned sp = 0; while (lds_ld(flg) < (unsigned)(c + 1) || lds_ld(flg + 1) < (unsigned)(c + 1)) { __builtin_amdgcn_s_sleep(1); if (++sp > (1u << 22)) break; } }
                const unsigned char* buf = lds + (c & 1) * SC_BUFB;
                float* yp = p.sy + gbase + (size_t)(c * SC_CH + l16) * RW + irow;
                const unsigned char* bl = buf + l16 * 16; const unsigned char* bv = buf + 5 * SC_CH * 256 + (w * 4 + rs) * 4;
#define SC_LOAD(W_, A_, B_, K_, R_, V_, s) do { W_ = *(const f32x4*)(bl + (s) * 256); A_ = *(const f32x4*)(bl + SC_CH * 256 + (s) * 256); B_ = *(const f32x4*)(bl + 2 * SC_CH * 256 + (s) * 256); \
        K_ = *(const f32x4*)(bl + 3 * SC_CH * 256 + (s) * 256); R_ = *(const f32x4*)(bl + 4 * SC_CH * 256 + (s) * 256); V_ = *(const float*)(bv + (s) * 64); } while (0)
#define SC_LO(x) ((f32x2v){x[0], x[1]})
#define SC_HI(x) ((f32x2v){x[2], x[3]})
#define SC_STEP(W_, A_, B_, K_, R_, V_, yout) do { f32x2v t_ = sA * SC_LO(A_); t_ = sB * SC_HI(A_) + t_; float sa = t_.x + t_.y; sa = dpp_add16(sa); \
        const f32x2v sa2 = (f32x2v){sa, sa}, v2 = (f32x2v){V_, V_}; \
        sA = sA * SC_LO(W_) + (sa2 * SC_LO(B_) + v2 * SC_LO(K_)); sB = sB * SC_HI(W_) + (sa2 * SC_HI(B_) + v2 * SC_HI(K_)); \
        f32x2v y_ = sA * SC_LO(R_); y_ = sB * SC_HI(R_) + y_; yout = y_.x + y_.y; } while (0)
#define SC_DPPADD(x, ctrl) ((x) + __int_as_float(__builtin_amdgcn_update_dpp(0, __float_as_int(x), ctrl, 0xF, 0xF, true)))
                f32x4 wA, aA, bA, kA, rA, wB, aB, bB, kB, rB; float vA, vB, ykeep = 0.f;
                const bool od1 = (l16 & 1) != 0, od2 = (l16 & 2) != 0; const int g4 = l16 >> 2;
                SC_LOAD(wA, aA, bA, kA, rA, vA, 0);
#pragma unroll 2
                for (int s = 0; s < SC_CH; s += 4) {
                    float y0, y1, y2, y3;
                    SC_LOAD(wB, aB, bB, kB, rB, vB, s + 1);
                    SC_STEP(wA, aA, bA, kA, rA, vA, y0);
                    SC_LOAD(wA, aA, bA, kA, rA, vA, s + 2);
                    SC_STEP(wB, aB, bB, kB, rB, vB, y1);
                    SC_LOAD(wB, aB, bB, kB, rB, vB, s + 3);
                    SC_STEP(wA, aA, bA, kA, rA, vA, y2);
                    if (s + 4 < SC_CH) SC_LOAD(wA, aA, bA, kA, rA, vA, s + 4);
                    SC_STEP(wB, aB, bB, kB, rB, vB, y3);
                    const float t01 = od1 ? y1 : y0, u01 = od1 ? y0 : y1, t23 = od1 ? y3 : y2, u23 = od1 ? y2 : y3;
                    const float r01 = t01 + __int_as_float(__builtin_amdgcn_update_dpp(0, __float_as_int(u01), 0xB1, 0xF, 0xF, true));
                    const float r23 = t23 + __int_as_float(__builtin_amdgcn_update_dpp(0, __float_as_int(u23), 0xB1, 0xF, 0xF, true));
                    const float tq = od2 ? r23 : r01, uq = od2 ? r01 : r23;
                    float rq = tq + __int_as_float(__builtin_amdgcn_update_dpp(0, __float_as_int(uq), 0x4E, 0xF, 0xF, true));
                    rq = SC_DPPADD(rq, 0x124);
                    rq = SC_DPPADD(rq, 0x128);
                    ykeep = (g4 == ((s >> 2) & 3)) ? rq : ykeep;
                    if ((s & 15) == 12) yp[(size_t)(s & 16) * RW] = ykeep;
                }
#undef SC_LOAD
#undef SC_STEP
#undef SC_LO
#undef SC_HI
#undef SC_DPPADD
                asm volatile("s_waitcnt lgkmcnt(0)" ::: "memory");
                if (lane == 0) flg[4 + w] = (unsigned)(c + 1);
            }
            if (threadIdx.x == 0) flg[2] = 1u;
        } else if (w < 6) {
            const bf16_t *q_a = p.ha, *q_b = p.hb, *q_k = p.hk, *q_r = p.hr;
            const int lt = tid - 256;
#pragma unroll 1
            for (int c = 0; c < S_ / SC_CH; ++c) {
                f32x4 rw[4]; u32x4 rh[8]; u32x2 rv;
#pragma unroll
                for (int i = 0; i < 4; ++i) { const int idx = lt + 128 * i, st = idx >> 4, q4 = idx & 15; rw[i] = *(const f32x4*)(p.sw + gbase + (size_t)(c * SC_CH + st) * RW + q4 * 4); }
#pragma unroll
                for (int i = 0; i < 8; ++i) { const int a = i >> 1, idx = lt + 128 * (i & 1), st = idx >> 3, q8 = idx & 7;
                    const bf16_t* src = (a == 0) ? q_a : (a == 1) ? q_b : (a == 2) ? q_k : q_r;
                    rh[i] = *(const u32x4*)(src + gbase + (size_t)(c * SC_CH + st) * RW + q8 * 8); }
                rv = *(const u32x2*)(p.hv + gbase + (size_t)(c * SC_CH + (lt >> 2)) * RW + rg * 16 + (lt & 3) * 4);
                if (c >= 2) { unsigned sp = 0; const unsigned need = (unsigned)(c - 1);
                    while (lds_ld(flg + 4) < need || lds_ld(flg + 5) < need || lds_ld(flg + 6) < need || lds_ld(flg + 7) < need) { __builtin_amdgcn_s_sleep(1); if (++sp > (1u << 22)) break; } }
                unsigned char* buf = lds + (c & 1) * SC_BUFB;
#pragma unroll
                for (int i = 0; i < 4; ++i) { const int idx = lt + 128 * i, st = idx >> 4, q4 = idx & 15; *(f32x4*)(buf + st * 256 + q4 * 16) = rw[i]; }
#pragma unroll
                for (int i = 0; i < 8; ++i) { const int a = i >> 1, idx = lt + 128 * (i & 1), st = idx >> 3, q8 = idx & 7;
                    unsigned char* dp = buf + (a + 1) * (SC_CH * 256) + st * 256 + q8 * 32;
                    *(f32x4*)dp = (f32x4){bflo(rh[i].x), bfhi(rh[i].x), bflo(rh[i].y), bfhi(rh[i].y)}; *(f32x4*)(dp + 16) = (f32x4){bflo(rh[i].z), bfhi(rh[i].z), bflo(rh[i].w), bfhi(rh[i].w)}; }
                *(f32x4*)(buf + 5 * SC_CH * 256 + (lt >> 2) * 64 + (lt & 3) * 16) = (f32x4){bflo(rv.x), bfhi(rv.x), bflo(rv.y), bfhi(rv.y)};
                asm volatile("s_waitcnt lgkmcnt(0)" ::: "memory");
                if (lane == 0) flg[w - 4] = (unsigned)(c + 1);
            }
        } else {
            unsigned char* scr = lds + SC_CVSCR + (w - 6) * 9216;
            const int g = bid_() * 2 + (w - 6), ncv = nblk_() * 2;
            const int k = convert_stream(p, cv_lo(l) + g, ncv, cv_hi(l), flg + 2, scr, lane);
            if (lane == 0) p.cvprog[l * 1024 + g] = (unsigned)k;
        }
        __syncthreads();
    }
}

#define LR_K 288
#define LR_ROWB 592
__device__ __forceinline__ void phase_prep8(const Params& p, int l, unsigned char* lds) {
    const int tid = tid_(), lane = tid & 63, w = tid >> 6, fr = lane & 15, fq = lane >> 4;
    const float* mu = p.mu + (size_t)l * 3328;
    const bf16_t* LRT = p.LRT + (size_t)l * 1024 * LR_K;
    for (int unit = bid_(); unit < T_ / 32; unit += nblk_()) {
        const int t0 = unit * 32;
        {
            const int tok = tid >> 4, cg = tid & 15, t = t0 + tok; const bool first = (t % S_) == 0;
            const bf16_t* pc = p.P + (size_t)t * NIN + 6144 + cg * 16;
            const u32x4 c0 = *(const u32x4*)pc, c1 = *(const u32x4*)(pc + 8);
            u32x4 p0 = (u32x4){0u, 0u, 0u, 0u}, p1 = p0;
            if (!first) { p0 = *(const u32x4*)(pc - NIN); p1 = *(const u32x4*)(pc - NIN + 8); }
            const float* mm = mu + 3072 + cg * 16;
            float f[16];
#pragma unroll
            for (int e = 0; e < 4; ++e) { f[2 * e] = bflo(c0[e]) + (bflo(p0[e]) - bflo(c0[e])) * mm[2 * e]; f[2 * e + 1] = bfhi(c0[e]) + (bfhi(p0[e]) - bfhi(c0[e])) * mm[2 * e + 1];
                f[8 + 2 * e] = bflo(c1[e]) + (bflo(p1[e]) - bflo(c1[e])) * mm[8 + 2 * e]; f[8 + 2 * e + 1] = bfhi(c1[e]) + (bfhi(p1[e]) - bfhi(c1[e])) * mm[8 + 2 * e + 1]; }
            if (cg < 4) {
#pragma unroll
                for (int e = 0; e < 16; ++e) f[e] = tanhf_(f[e]);
            } else if (cg >= 8) {
#pragma unroll
                for (int e = 0; e < 16; ++e) f[e] = sigmoidf_(f[e]);
            }
            u32x4 o0, o1; o0.x = cvt_pk_bf16(f[0], f[1]); o0.y = cvt_pk_bf16(f[2], f[3]); o0.z = cvt_pk_bf16(f[4], f[5]); o0.w = cvt_pk_bf16(f[6], f[7]);
            o1.x = cvt_pk_bf16(f[8], f[9]); o1.y = cvt_pk_bf16(f[10], f[11]); o1.z = cvt_pk_bf16(f[12], f[13]); o1.w = cvt_pk_bf16(f[14], f[15]);
            *(u32x4*)(lds + tok * LR_ROWB + cg * 32) = o0; *(u32x4*)(lds + tok * LR_ROWB + cg * 32 + 16) = o1;
            if (l > 0) {
                const float* vr = p.VV + (size_t)t * 64;
                const float a0_ = vr[cg] + (first ? 0.f : vr[-64 + 32 + cg]), a1_ = vr[16 + cg] + (first ? 0.f : vr[-64 + 48 + cg]);
                bf16_t* vvp = (bf16_t*)(lds + tok * LR_ROWB + 512);
                vvp[cg] = (bf16_t)(cvt_pk_bf16(a0_, a0_) & 0xffffu); vvp[16 + cg] = (bf16_t)(cvt_pk_bf16(a1_, a1_) & 0xffffu);
            }
        }
        __syncthreads();
#pragma unroll 1
        for (int it = 0; it < 4; ++it) {
            const int hd = it >> 1, mt = it & 1, head = 2 * w + hd;
            const int t = t0 + 16 * mt + fr; const bool first = (t % S_) == 0;
            const bf16_t* prow = p.P + (size_t)t * NIN + 3072;
            u32x4 raw[2][6];
#pragma unroll
            for (int pr = 0; pr < 2; ++pr) { const int c8 = head * 64 + pr * 32 + 8 * fq;
                raw[pr][0] = *(const u32x4*)(prow + c8); raw[pr][1] = *(const u32x4*)(prow + 1024 + c8); raw[pr][2] = *(const u32x4*)(prow + 2048 + c8);
                raw[pr][3] = (u32x4){0u, 0u, 0u, 0u}; raw[pr][4] = raw[pr][3]; raw[pr][5] = raw[pr][3];
                if (!first) { raw[pr][3] = *(const u32x4*)(prow - NIN + c8); raw[pr][4] = *(const u32x4*)(prow - NIN + 1024 + c8); raw[pr][5] = *(const u32x4*)(prow - NIN + 2048 + c8); } }
            f32x4 aw[4], aa[4], ag[4], av[4];
#pragma unroll
            for (int nt = 0; nt < 4; ++nt) { aw[nt] = (f32x4){0.f, 0.f, 0.f, 0.f}; aa[nt] = aw[nt]; ag[nt] = aw[nt]; av[nt] = aw[nt]; }
            bf16x8 af[9];
#pragma unroll
            for (int ks = 0; ks < 9; ++ks) af[ks] = *(const bf16x8*)(lds + (mt * 16 + fr) * LR_ROWB + ks * 64 + fq * 16);
#pragma unroll
            for (int nt = 0; nt < 4; ++nt) {
                const bf16_t* bp = LRT + (size_t)(head * 64 + (nt >> 1) * 32 + 8 * (fr >> 2) + 4 * (nt & 1) + (fr & 3)) * LR_K + fq * 8;
                bf16x8 bfv[9];
#pragma unroll
                for (int ks = 0; ks < 9; ++ks) bfv[ks] = *(const bf16x8*)(bp + ks * 32);
                aw[nt] = __builtin_amdgcn_mfma_f32_16x16x32_bf16(bfv[0], af[0], aw[nt], 0, 0, 0); aw[nt] = __builtin_amdgcn_mfma_f32_16x16x32_bf16(bfv[1], af[1], aw[nt], 0, 0, 0);
                aa[nt] = __builtin_amdgcn_mfma_f32_16x16x32_bf16(bfv[2], af[2], aa[nt], 0, 0, 0); aa[nt] = __builtin_amdgcn_mfma_f32_16x16x32_bf16(bfv[3], af[3], aa[nt], 0, 0, 0);
#pragma unroll
                for (int ks = 4; ks < 8; ++ks) ag[nt] = __builtin_amdgcn_mfma_f32_16x16x32_bf16(bfv[ks], af[ks], ag[nt], 0, 0, 0);
                if (l > 0) av[nt] = __builtin_amdgcn_mfma_f32_16x16x32_bf16(bfv[8], af[8], av[nt], 0, 0, 0);
            }
            f32x4 kkv[4], aav[4]; float ss = 0.f, bc = 0.f;
#pragma unroll
            for (int pr = 0; pr < 2; ++pr) {
                const int c8 = head * 64 + pr * 32 + 8 * fq; const size_t o8 = (size_t)t * RW + c8;
                const u32x4 cr = raw[pr][0], ck = raw[pr][1], cv = raw[pr][2], qr = raw[pr][3], qk = raw[pr][4], qv = raw[pr][5];
                u32x4 or_, ok_, ov_, og_;
#pragma unroll
                for (int n = 0; n < 2; ++n) {
                    const int nt = 2 * pr + n, c = c8 + 4 * n; const size_t o = (size_t)t * RW + c;
                    const unsigned crx = n ? cr.z : cr.x, cry = n ? cr.w : cr.y, ckx = n ? ck.z : ck.x, cky = n ? ck.w : ck.y, cvx = n ? cv.z : cv.x, cvy = n ? cv.w : cv.y;
                    const unsigned qrx = n ? qr.z : qr.x, qry = n ? qr.w : qr.y, qkx = n ? qk.z : qk.x, qky = n ? qk.w : qk.y, qvx = n ? qv.z : qv.x, qvy = n ? qv.w : qv.y;
                    const f32x4 mr = *(const f32x4*)(mu + c), mk = *(const f32x4*)(mu + 1024 + c), mv = *(const f32x4*)(mu + 2048 + c);
                    f32x4 rr, kx, vx;
                    rr[0] = bflo(crx) + (bflo(qrx) - bflo(crx)) * mr[0]; rr[1] = bfhi(crx) + (bfhi(qrx) - bfhi(crx)) * mr[1]; rr[2] = bflo(cry) + (bflo(qry) - bflo(cry)) * mr[2]; rr[3] = bfhi(cry) + (bfhi(qry) - bfhi(cry)) * mr[3];
                    kx[0] = bflo(ckx) + (bflo(qkx) - bflo(ckx)) * mk[0]; kx[1] = bfhi(ckx) + (bfhi(qkx) - bfhi(ckx)) * mk[1]; kx[2] = bflo(cky) + (bflo(qky) - bflo(cky)) * mk[2]; kx[3] = bfhi(cky) + (bfhi(qky) - bfhi(cky)) * mk[3];
                    vx[0] = bflo(cvx) + (bflo(qvx) - bflo(cvx)) * mv[0]; vx[1] = bfhi(cvx) + (bfhi(qvx) - bfhi(cvx)) * mv[1]; vx[2] = bflo(cvy) + (bflo(qvy) - bflo(cvy)) * mv[2]; vx[3] = bfhi(cvy) + (bfhi(qvy) - bfhi(cvy)) * mv[3];
                    const f32x4 w0v = *(const f32x4*)(p.w0 + l * RW + c), a0v = *(const f32x4*)(p.a0 + l * RW + c), kkw = *(const f32x4*)(p.k_k + l * RW + c), kaw = *(const f32x4*)(p.k_a + l * RW + c), rkw = *(const f32x4*)(p.r_k + l * RW + c);
                    f32x4 dec, av_, kh;
#pragma unroll
                    for (int j = 0; j < 4; ++j) { dec[j] = __expf(-sigmoidf_(w0v[j] + aw[nt][j]) * 0.60653066f); av_[j] = sigmoidf_(a0v[j] + aa[nt][j]); }
                    if (l == 0) *(f32x4*)(p.vfirst + o) = vx;
                    else { const f32x4 vf = *(const f32x4*)(p.vfirst + o), v0v = *(const f32x4*)(p.v0 + c);
#pragma unroll
                        for (int j = 0; j < 4; ++j) vx[j] = vx[j] + (vf[j] - vx[j]) * sigmoidf_(v0v[j] + av[nt][j]); }
#pragma unroll
                    for (int j = 0; j < 4; ++j) { const float kk = kx[j] * kkw[j]; kkv[nt][j] = kk; ss += kk * kk; kh[j] = kx[j] * (1.0f + (av_[j] - 1.0f) * kaw[j]); bc += rr[j] * kh[j] * rkw[j]; }
                    aav[nt] = av_;
                    *(f32x4*)(p.sw + o) = dec;
                    const unsigned r0 = cvt_pk_bf16(rr[0], rr[1]), r1 = cvt_pk_bf16(rr[2], rr[3]), k0_ = cvt_pk_bf16(kh[0], kh[1]), k1_ = cvt_pk_bf16(kh[2], kh[3]);
                    const unsigned v0_ = cvt_pk_bf16(vx[0], vx[1]), v1_ = cvt_pk_bf16(vx[2], vx[3]), g0_ = cvt_pk_bf16(ag[nt][0], ag[nt][1]), g1_ = cvt_pk_bf16(ag[nt][2], ag[nt][3]);
                    if (n == 0) { or_.x = r0; or_.y = r1; ok_.x = k0_; ok_.y = k1_; ov_.x = v0_; ov_.y = v1_; og_.x = g0_; og_.y = g1_; }
                    else { or_.z = r0; or_.w = r1; ok_.z = k0_; ok_.w = k1_; ov_.z = v0_; ov_.w = v1_; og_.z = g0_; og_.w = g1_; }
                }
                *(u32x4*)(p.hr + o8) = or_; *(u32x4*)(p.hk + o8) = ok_; *(u32x4*)(p.hv + o8) = ov_; *(u32x4*)(p.hg + o8) = og_;
            }
            ss += __shfl_xor(ss, 16); ss += __shfl_xor(ss, 32); bc += __shfl_xor(bc, 16); bc += __shfl_xor(bc, 32);
            const float rn = fminf(__builtin_amdgcn_rsqf(ss), 1e12f);
            if (fq == 0) p.bcoef[(size_t)t * 16 + head] = bc;
#pragma unroll
            for (int pr = 0; pr < 2; ++pr) { const size_t o8 = (size_t)t * RW + head * 64 + pr * 32 + 8 * fq;
                u32x4 oa, ob;
#pragma unroll
                for (int n = 0; n < 2; ++n) { const int nt = 2 * pr + n; f32x4 sa_, sb_;
#pragma unroll
                    for (int j = 0; j < 4; ++j) { const float kn = kkv[nt][j] * rn; sa_[j] = -kn; sb_[j] = kn * aav[nt][j]; }
                    const unsigned a0_ = cvt_pk_bf16(sa_[0], sa_[1]), a1_ = cvt_pk_bf16(sa_[2], sa_[3]), b0_ = cvt_pk_bf16(sb_[0], sb_[1]), b1_ = cvt_pk_bf16(sb_[2], sb_[3]);
                    if (n == 0) { oa.x = a0_; oa.y = a1_; ob.x = b0_; ob.y = b1_; } else { oa.z = a0_; oa.w = a1_; ob.z = b0_; ob.w = b1_; } }
                *(u32x4*)(p.ha + o8) = oa; *(u32x4*)(p.hb + o8) = ob; }
        }
        __syncthreads();
    }
}

__device__ __forceinline__ void phase_post(const Params& p, int l) {
    const int tid = tid_(), lane = tid & 63, w = tid >> 6;
    const float lam_init = (l == 0) ? 0.2f : 0.35550907f;
    float lam;
    { const float s1 = wave_sum(p.lam_q1[l * 64 + lane] * p.lam_k1[l * 64 + lane]), s2 = wave_sum(p.lam_q2[l * 64 + lane] * p.lam_k2[l * 64 + lane]); lam = __expf(s1) - __expf(s2) + lam_init; }
    const float* tmp = p.mixed;
    for (int t = bid_(); t < T_; t += nblk_()) {
        if (!USE_ATTN8) for (int h = w; h < 8; h += NTHR / 64) {
            const float* o0 = tmp + (size_t)t * D_ + h * 256 + lane * 2;
            const float x0 = o0[0] - lam * o0[128], x1 = o0[1] - lam * o0[129];
            const float ss = wave_sum(x0 * x0 + x1 * x1);
            const float rstd = rsqrtf(ss * (1.0f / 128.0f) + 1e-5f) * (1.0f - lam_init);
            const float* sg = p.subln_g + l * 128 + lane * 2;
            *(unsigned*)(p.ocat + (size_t)t * D_ + h * 128 + lane * 2) = cvt_pk_bf16(x0 * rstd * sg[0], x1 * rstd * sg[1]);
        }
        for (int h = w; h < 16; h += NTHR / 64) {
            const int cc = h * 64 + lane; const size_t o = (size_t)t * RW + cc;
            const float y = p.sy[o];
            const float mean = wave_sum(y) * (1.0f / 64.0f);
            const float d = y - mean;
            const float var = wave_sum(d * d) * (1.0f / 64.0f);
            const float yn = d * rsqrtf(var + 64e-5f) * p.lnx_w[l * RW + cc] + p.lnx_b[l * RW + cc];
            const float val = (yn + p.bcoef[(size_t)t * 16 + h] * bf2f(p.hv[o])) * bf2f(p.hg[o]);
            const float nb = __shfl_down(val, 1);
            if ((lane & 1) == 0) *(unsigned*)(p.ocat + (size_t)t * D_ + 1024 + cc) = cvt_pk_bf16(val, nb);
        }
    }
}

__device__ __forceinline__ void phase_post8(const Params& p, int l) {
    const int tid = tid_(), lane = tid & 63, l16 = lane & 15, rs = lane >> 4, gw = bid_() * NW_ + (tid >> 6), nw = nblk_() * NW_;
#pragma unroll 4
    for (int item = gw; item < T_ * 4; item += nw) {
        const int t = item >> 2, h = (item & 3) * 4 + rs, cc = h * 64 + l16 * 4; const size_t o = (size_t)t * RW + cc;
        const f32x4 y = *(const f32x4*)(p.sy + o);
        const u32x2 hv = *(const u32x2*)(p.hv + o), hg = *(const u32x2*)(p.hg + o);
        const float bc = p.bcoef[(size_t)t * 16 + h];
        const f32x4 lw = *(const f32x4*)(p.lnx_w + l * RW + cc), lb = *(const f32x4*)(p.lnx_b + l * RW + cc);
        const float mean = dpp_add16((y[0] + y[1]) + (y[2] + y[3])) * (1.0f / 64.0f);
        const f32x4 d = y - mean;
        const float var = dpp_add16((d[0] * d[0] + d[1] * d[1]) + (d[2] * d[2] + d[3] * d[3])) * (1.0f / 64.0f);
        const float rstd = rsqrtf(var + 64e-5f);
        const float v0 = ((d[0] * rstd * lw[0] + lb[0]) + bc * bflo(hv.x)) * bflo(hg.x), v1 = ((d[1] * rstd * lw[1] + lb[1]) + bc * bfhi(hv.x)) * bfhi(hg.x);
        const float v2 = ((d[2] * rstd * lw[2] + lb[2]) + bc * bflo(hv.y)) * bflo(hg.y), v3 = ((d[3] * rstd * lw[3] + lb[3]) + bc * bfhi(hv.y)) * bfhi(hg.y);
        u32x2 ov; ov.x = cvt_pk_bf16(v0, v1); ov.y = cvt_pk_bf16(v2, v3);
        *(u32x2*)(p.ocat + (size_t)t * D_ + 1024 + cc) = ov;
    }
}

__device__ __forceinline__ void phase_gemm_out(const Params& p, int l, unsigned char* lds) {
    const float* B = p.w_out + (size_t)l * D_ * D_;
    for (int unit = bid_(); unit < 64 * 16; unit += nblk_()) {
        const int mt = unit >> 4, nt = unit & 15;
        float* C = p.mixed;
        gemm_tile(lds, p.ocat, D_, [=](int r) { return mt * 128 + r; }, B + nt * 128 + (tid_() & 127), D_, D_,
                  [=](int m, int n, f32x4 v) { *(f32x4*)(C + (size_t)(mt * 128 + m) * D_ + nt * 128 + n) = v; });
    }
}

__device__ __forceinline__ void phase_res1_router(const Params& p, int l, unsigned char* lds) {
    const int tid = tid_(), lane = tid & 63, w = tid >> 6, gw = bid_() * (NTHR / 64) + w, nw = nblk_() * (NTHR / 64);
    float* hrow = (float*)lds + w * D_;
    const float* xin = (l == 0) ? p.x : p.out;
    const float* Wr = p.w_router + (size_t)l * D_ * NE;
    for (int t = gw; t < T_; t += nw) {
        const int b = t / S_;
        const float* md = p.mod + ((size_t)l * 4 + b) * 12288;
        f32x4 xv[8]; float ss = 0.f;
#pragma unroll
        for (int i = 0; i < 8; ++i) { const int e = i * 256 + lane * 4; const f32x4 mv = *(const f32x4*)(p.mixed + (size_t)t * D_ + e);
            ss += mv[0] * mv[0] + mv[1] * mv[1] + mv[2] * mv[2] + mv[3] * mv[3]; }
        ss = wave_sum(ss);
        const float rm = rsqrtf(ss * (1.0f / D_) + 1e-6f);
        float s2 = 0.f;
#pragma unroll
        for (int i = 0; i < 8; ++i) { const int e = i * 256 + lane * 4; const f32x4 gp = *(const f32x4*)(p.g_post_mix + l * D_ + e), ga = *(const f32x4*)(md + 4096 + e);
            const f32x4 mv = *(const f32x4*)(p.mixed + (size_t)t * D_ + e); xv[i] = *(const f32x4*)(xin + (size_t)t * D_ + e);
#pragma unroll
            for (int j = 0; j < 4; ++j) { xv[i][j] += ga[j] * (mv[j] * rm * gp[j]); s2 += xv[i][j] * xv[i][j]; }
            *(f32x4*)(p.out + (size_t)t * D_ + e) = xv[i]; }
        s2 = wave_sum(s2);
        const float rx = rsqrtf(s2 * (1.0f / D_) + 1e-6f);
        emit_hn(xv, rx, p.g_pre_ffn + l * D_, md + 8192, md + 6144, p.Hn + (size_t)t * D_, lane, hrow);
        __builtin_amdgcn_s_waitcnt(0);
        __builtin_amdgcn_wave_barrier();
        float lg = 0.f;
#pragma unroll 8
        for (int k = 0; k < D_; ++k) lg += hrow[k] * Wr[(size_t)k * NE + lane];
        const float score = sigmoidf_(lg), biased = score + p.router_bias[l * NE + lane];
        int rk = 0;
#pragma unroll
        for (int i = 0; i < 8; ++i) { const int src = (lane & ~7) + i; const float o = __shfl(biased, src); rk += (o > biased || (o == biased && src < lane)) ? 1 : 0; }
        float gs = (rk < 2) ? biased : 0.f;
        gs += __shfl_xor(gs, 1); gs += __shfl_xor(gs, 2); gs += __shfl_xor(gs, 4);
        int grk = 0; const int g = lane >> 3;
#pragma unroll
        for (int i = 0; i < 8; ++i) { const float o = RL(gs, i * 8); grk += (o > gs || (o == gs && i < g)) ? 1 : 0; }
        const bool gsel = grk < 4;
        const float mvv = gsel ? biased : -INFINITY;
        int erk = 0;
#pragma unroll
        for (int i = 0; i < 64; ++i) { const float o = RL(mvv, i); erk += (o > mvv || (o == mvv && i < lane)) ? 1 : 0; }
        const bool sel = gsel && erk < 8;
        const float gsum = wave_sum(sel ? score : 0.f);
        if (sel) {
            const float gate = score / gsum * 2.5f;
            const unsigned slot = atomicAdd(p.counts + (l * NE + lane) * 32, 1u);
            p.rowtok[lane * CAP + slot] = t; p.rowg[lane * CAP + slot] = gate; p.tokpos[(size_t)t * 8 + erk] = lane * CAP + (int)slot;
        }
        __builtin_amdgcn_wave_barrier();
    }
}

#define RT_ROWB 4112
__device__ __forceinline__ void phase_res1_router8(const Params& p, int l, unsigned char* lds) {
    const int tid = tid_(), lane = tid & 63, w = tid >> 6, fr = lane & 15, fq = lane >> 4;
    const float* xin = (l == 0) ? p.x : p.out;
    unsigned char* hiL = lds; unsigned char* loL = lds + 16 * RT_ROWB; float* part = (float*)lds;
    const bf16_t* Whi = p.WrT + (size_t)l * 2 * NE * D_; const bf16_t* Wlo = Whi + (size_t)NE * D_;
    int* selinfo = (int*)(lds + RSEL_OFF); int* lcount = selinfo + 4 * 128 * 3; int* lbase = lcount + NE;
    if (tid < NE) lcount[tid] = 0;
    int nsel = 0;
    __syncthreads();
    for (int unit = bid_(); unit < T_ / 16; unit += nblk_()) {
        const int b = (unit * 16) / S_;
        const float* md = p.mod + ((size_t)l * 4 + b) * 12288;
#pragma unroll 1
        for (int rr = 0; rr < 2; ++rr) {
            const int tl = w + 8 * rr, t = unit * 16 + tl;
            int e0 = lane * 4; asm volatile("" : "+v"(e0));
            f32x4 xv[8]; float ss = 0.f;
            u32x2 mq[8];
#pragma unroll
            for (int i = 0; i < 8; ++i) { const int e = i * 256 + e0; mq[i] = *(const u32x2*)((const bf16_t*)p.mixed + (size_t)t * D_ + e);
                const float m0 = bflo(mq[i].x), m1 = bfhi(mq[i].x), m2 = bflo(mq[i].y), m3 = bfhi(mq[i].y);
                ss += m0 * m0 + m1 * m1 + m2 * m2 + m3 * m3; }
            ss = wave_sum(ss);
            const float rm = rsqrtf(ss * (1.0f / D_) + 1e-6f);
            float s2 = 0.f;
#pragma unroll
            for (int i = 0; i < 8; ++i) { const int e = i * 256 + e0; const f32x4 gp = *(const f32x4*)(p.g_post_mix + l * D_ + e), ga = *(const f32x4*)(md + 4096 + e);
                const f32x4 mv = (f32x4){bflo(mq[i].x), bfhi(mq[i].x), bflo(mq[i].y), bfhi(mq[i].y)}; xv[i] = *(const f32x4*)(xin + (size_t)t * D_ + e);
#pragma unroll
                for (int j = 0; j < 4; ++j) { xv[i][j] += ga[j] * (mv[j] * rm * gp[j]); s2 += xv[i][j] * xv[i][j]; }
                *(f32x4*)(p.out + (size_t)t * D_ + e) = xv[i]; }
            s2 = wave_sum(s2);
            const float rx = rsqrtf(s2 * (1.0f / D_) + 1e-6f);
#pragma unroll
            for (int i = 0; i < 8; ++i) { const int e = i * 256 + e0;
                const f32x4 gv = *(const f32x4*)(p.g_pre_ffn + l * D_ + e), scv = *(const f32x4*)(md + 8192 + e), shv = *(const f32x4*)(md + 6144 + e);
                f32x4 h;
#pragma unroll
                for (int j = 0; j < 4; ++j) h[j] = xv[i][j] * rx * gv[j] * (1.0f + scv[j]) + shv[j];
                u32x2 hi; hi.x = cvt_pk_bf16(h[0], h[1]); hi.y = cvt_pk_bf16(h[2], h[3]);
                u32x2 lo; lo.x = cvt_pk_bf16(h[0] - bflo(hi.x), h[1] - bfhi(hi.x)); lo.y = cvt_pk_bf16(h[2] - bflo(hi.y), h[3] - bfhi(hi.y));
                *(u32x2*)(p.Hn + (size_t)t * D_ + e) = hi;
                *(u32x2*)(hiL + tl * RT_ROWB + e * 2) = hi; *(u32x2*)(loL + tl * RT_ROWB + e * 2) = lo; }
        }
        __syncthreads();
        f32x4 acc[4];
        {
#pragma unroll
            for (int nt = 0; nt < 4; ++nt) acc[nt] = (f32x4){0.f, 0.f, 0.f, 0.f};
            bf16x8 bh[2][4], bl[2][4];
            const bf16_t* wb = Whi + (size_t)fr * D_ + w * 256 + fq * 8; const bf16_t* wl = Wlo + (size_t)fr * D_ + w * 256 + fq * 8;
#pragma unroll
            for (int nt = 0; nt < 4; ++nt) { bh[0][nt] = *(const bf16x8*)(wb + (size_t)nt * 16 * D_); bl[0][nt] = *(const bf16x8*)(wl + (size_t)nt * 16 * D_); }
#pragma unroll
            for (int kk = 0; kk < 8; ++kk) {
                if (kk + 1 < 8) {
#pragma unroll
                    for (int nt = 0; nt < 4; ++nt) { bh[(kk + 1) & 1][nt] = *(const bf16x8*)(wb + (size_t)nt * 16 * D_ + (kk + 1) * 32); bl[(kk + 1) & 1][nt] = *(const bf16x8*)(wl + (size_t)nt * 16 * D_ + (kk + 1) * 32); } }
                const int ks = w * 8 + kk;
                const bf16x8 ahi = *(const bf16x8*)(hiL + fr * RT_ROWB + ks * 64 + fq * 16), alo = *(const bf16x8*)(loL + fr * RT_ROWB + ks * 64 + fq * 16);
#pragma unroll
                for (int nt = 0; nt < 4; ++nt) {
                    acc[nt] = __builtin_amdgcn_mfma_f32_16x16x32_bf16(bh[kk & 1][nt], ahi, acc[nt], 0, 0, 0);
                    acc[nt] = __builtin_amdgcn_mfma_f32_16x16x32_bf16(bh[kk & 1][nt], alo, acc[nt], 0, 0, 0);
                    acc[nt] = __builtin_amdgcn_mfma_f32_16x16x32_bf16(bl[kk & 1][nt], ahi, acc[nt], 0, 0, 0); } }
        }
        __syncthreads();
#pragma unroll
        for (int nt = 0; nt < 4; ++nt) *(f32x4*)(part + (w * 16 + fr) * 64 + nt * 16 + fq * 4) = acc[nt];
        __syncthreads();
#pragma unroll 1
        for (int rr = 0; rr < 2; ++rr) {
            const int tl = w + 8 * rr, t = unit * 16 + tl;
            float lg = 0.f;
#pragma unroll
            for (int ww = 0; ww < 8; ++ww) lg += part[(ww * 16 + tl) * 64 + lane];
            const float score = sigmoidf_(lg), biased = score + p.router_bias[l * NE + lane];
            int rk = 0;
#pragma unroll
            for (int i = 0; i < 8; ++i) { const int src = (lane & ~7) + i; const float o = __shfl(biased, src); rk += (o > biased || (o == biased && src < lane)) ? 1 : 0; }
            float gs = (rk < 2) ? biased : 0.f;
            gs += __shfl_xor(gs, 1); gs += __shfl_xor(gs, 2); gs += __shfl_xor(gs, 4);
            int grk = 0; const int g = lane >> 3;
#pragma unroll
            for (int i = 0; i < 8; ++i) { const float o = RL(gs, i * 8); grk += (o > gs || (o == gs && i < g)) ? 1 : 0; }
            const bool gsel = grk < 4;
            const float mvv = gsel ? biased : -INFINITY;
            int erk = 0;
#pragma unroll
            for (int i = 0; i < 64; ++i) { const float o = RL(mvv, i); erk += (o > mvv || (o == mvv && i < lane)) ? 1 : 0; }
            const bool sel = gsel && erk < 8;
            const float gsum = wave_sum(sel ? score : 0.f);
            if (sel) {
                const float gate = score / gsum * 2.5f;
                const int lrank = atomicAdd(lcount + lane, 1);
                int* si = selinfo + ((nsel * 16 + tl) * 8 + erk) * 3;
                si[0] = t; si[1] = (lane << 16) | lrank; si[2] = __float_as_int(gate);
            }
        }
        ++nsel;
        __syncthreads();
    }
    if (tid < NE) { const int c = lcount[tid]; lbase[tid] = c ? (int)atomicAdd(p.counts + (l * NE + tid) * 32, (unsigned)c) : 0; }
    __syncthreads();
    for (int i = tid; i < nsel * 128; i += NTHR) { const int* si = selinfo + i * 3; const int t = si[0], e = si[1] >> 16, slot = lbase[e] + (si[1] & 0xffff);
        p.rowtok[e * CAP + slot] = t; p.tokpos[(size_t)t * 8 + (i & 7)] = e * CAP + slot; p.tokgate[(size_t)t * 8 + (i & 7)] = __int_as_float(si[2]); }
    __syncthreads();
}

__device__ __forceinline__ void phase_moe_gu(const Params& p, int l, unsigned char* lds) {
    int* tab = (int*)(lds + TAB_OFF);
    build_tables(p, l, tab, 7);
    const int ntile = tab[160 + NE + 1];
    for (int unit = bid_(); unit < ntile * 8; unit += nblk_()) {
        const int rtg = unit >> 3, ct = unit & 7, e = find_expert(tab, rtg), rt = rtg - tab[160 + e], cnt = tab[e], pb = tab[80 + e];
        const float* Bg = (e < NE) ? p.w_eg + ((size_t)(l * NE + e) * D_) * 512 : p.w_sg + (size_t)l * D_ * 512;
        const float* Bu = (e < NE) ? p.w_eu + ((size_t)(l * NE + e) * D_) * 512 : p.w_su + (size_t)l * D_ * 512;
        const int n = tid_() & 127;
        const float* bp = ((n & 1) ? Bu : Bg) + ct * 64 + (n >> 1);
        const int* rtok = p.rowtok + e * CAP;
        bf16_t* H1 = p.H1;
        gemm_tile(lds, p.Hn, D_, [=](int r) { const int slot = rt * 128 + r; return (slot < cnt) ? ((e < NE) ? rtok[slot] : slot) : 0; }, bp, 512, D_,
                  [=](int m, int nn, f32x4 v) { const float h0 = v[0] / (1.0f + __expf(-v[0])) * v[1], h1 = v[2] / (1.0f + __expf(-v[2])) * v[3];
                      *(unsigned*)(H1 + (size_t)(pb + rt * 128 + m) * 512 + ct * 64 + (nn >> 1)) = cvt_pk_bf16(h0, h1); });
    }
}

__device__ __forceinline__ void phase_moe_down(const Params& p, int l, unsigned char* lds) {
    int* tab = (int*)(lds + TAB_OFF);
    build_tables(p, l, tab, 7);
    const int ntile = tab[160 + NE + 1];
    for (int unit = bid_(); unit < ntile * 16; unit += nblk_()) {
        const int rtg = unit >> 4, ct = unit & 15, e = find_expert(tab, rtg), rt = rtg - tab[160 + e], cnt = tab[e], pb = tab[80 + e];
        const float* Bd = (e < NE) ? p.w_ed + ((size_t)(l * NE + e) * 512) * D_ : p.w_sd + (size_t)l * 512 * D_;
        const float* rg = p.rowg + e * CAP;
        bf16_t* Y2 = p.Y2;
        gemm_tile(lds, p.H1, 512, [=](int r) { return pb + rt * 128 + r; }, Bd + ct * 128 + (tid_() & 127), D_, 512,
                  [=](int m, int nn, f32x4 v) { const int slot = rt * 128 + m; const float g = (slot < cnt) ? ((e < NE) ? rg[slot] : 1.0f) : 0.f;
                      u32x2 o; o.x = cvt_pk_bf16(v[0] * g, v[1] * g); o.y = cvt_pk_bf16(v[2] * g, v[3] * g);
                      *(u32x2*)(Y2 + (size_t)(pb + slot) * D_ + ct * 128 + nn) = o; });
    }
}

__device__ __forceinline__ void phase_combine(const Params& p, int l, unsigned char* lds) {
    typedef float f32x2c __attribute__((ext_vector_type(2)));
    int* tab = (int*)(lds + TAB_OFF);
    build_tables(p, l, tab, 8);
    const int lane = tid_() & 63, gw = bid_() * (NTHR / 64) + (tid_() >> 6), nw = nblk_() * (NTHR / 64);
    const unsigned char* Y2q = (const unsigned char*)p.Y2;
    for (int t = gw; t < T_; t += nw) {
        const int b = t / S_;
        const float* md = p.mod + ((size_t)l * 4 + b) * 12288;
        f32x4 yv[8];
        const unsigned char* yr[9]; float gk[9];
        { const u32x4 tp0 = *(const u32x4*)(p.tokpos + (size_t)t * 8), tp1 = *(const u32x4*)(p.tokpos + (size_t)t * 8 + 4);
          const f32x4 g0 = *(const f32x4*)(p.tokgate + (size_t)t * 8), g1 = *(const f32x4*)(p.tokgate + (size_t)t * 8 + 4);
#pragma unroll
          for (int k = 0; k < 4; ++k) { const int a = (int)tp0[k], bq = (int)tp1[k];
              yr[k] = Y2q + (size_t)(tab[80 + (a >> 13)] + (a & (CAP - 1))) * D_ + lane * 8; gk[k] = g0[k] * (1.0f / Y2_SCALE);
              yr[4 + k] = Y2q + (size_t)(tab[80 + (bq >> 13)] + (bq & (CAP - 1))) * D_ + lane * 8; gk[4 + k] = g1[k] * (1.0f / Y2_SCALE); }
          yr[8] = Y2q + (size_t)(tab[80 + NE] + t) * D_ + lane * 8; gk[8] = 1.0f / Y2_SCALE; }
        u32x2 u[9][4];
#pragma unroll
        for (int k = 0; k < 9; ++k)
#pragma unroll
            for (int i = 0; i < 4; ++i) u[k][i] = *(const u32x2*)(yr[k] + i * 512);
#pragma unroll
        for (int i = 0; i < 4; ++i) { f32x4 a0 = (f32x4){0.f, 0.f, 0.f, 0.f}, a1 = a0;
#pragma unroll
            for (int k = 0; k < 9; ++k) { const f32x2c x0 = __builtin_amdgcn_cvt_pk_f32_fp8((int)u[k][i].x, false), x1 = __builtin_amdgcn_cvt_pk_f32_fp8((int)u[k][i].x, true);
                const f32x2c x2 = __builtin_amdgcn_cvt_pk_f32_fp8((int)u[k][i].y, false), x3 = __builtin_amdgcn_cvt_pk_f32_fp8((int)u[k][i].y, true);
                a0[0] += gk[k] * x0.x; a0[1] += gk[k] * x0.y; a0[2] += gk[k] * x1.x; a0[3] += gk[k] * x1.y; a1[0] += gk[k] * x2.x; a1[1] += gk[k] * x2.y; a1[2] += gk[k] * x3.x; a1[3] += gk[k] * x3.y; }
            yv[2 * i] = a0; yv[2 * i + 1] = a1; }
        float ss = 0.f;
#pragma unroll
        for (int i = 0; i < 8; ++i) ss += yv[i][0] * yv[i][0] + yv[i][1] * yv[i][1] + yv[i][2] * yv[i][2] + yv[i][3] * yv[i][3];
        ss = wave_sum(ss);
        const float ry = rsqrtf(ss * (1.0f / D_) + 1e-6f);
        float s2 = 0.f;
#pragma unroll
        for (int i = 0; i < 8; ++i) { const int e = (i >> 1) * 512 + lane * 8 + (i & 1) * 4; const f32x4 xo = *(const f32x4*)(p.out + (size_t)t * D_ + e);
            const f32x4 gp = *(const f32x4*)(p.g_post_ffn + l * D_ + e), gf = *(const f32x4*)(md + 10240 + e);
#pragma unroll
            for (int j = 0; j < 4; ++j) { yv[i][j] = xo[j] + gf[j] * (yv[i][j] * ry * gp[j]); s2 += yv[i][j] * yv[i][j]; }
            *(f32x4*)(p.out + (size_t)t * D_ + e) = yv[i]; }
        if (l + 1 < 2) {
            s2 = wave_sum(s2);
            const float rx = rsqrtf(s2 * (1.0f / D_) + 1e-6f);
            const float* md1 = p.mod + ((size_t)(l + 1) * 4 + b) * 12288;
            const float* g = p.g_pre_mix + (l + 1) * D_;
#pragma unroll
            for (int i = 0; i < 8; ++i) { const int e = (i >> 1) * 512 + lane * 8 + (i & 1) * 4;
                const f32x4 gv = *(const f32x4*)(g + e), scv = *(const f32x4*)(md1 + 2048 + e), shv = *(const f32x4*)(md1 + e);
                f32x4 h;
#pragma unroll
                for (int j = 0; j < 4; ++j) h[j] = yv[i][j] * rx * gv[j] * (1.0f + scv[j]) + shv[j];
                u32x2 o; o.x = cvt_pk_bf16(h[0], h[1]); o.y = cvt_pk_bf16(h[2], h[3]);
                *(u32x2*)(p.Hn + (size_t)t * D_ + e) = o; }
        }
    }
}

#ifndef USE_SCAN8
#define USE_SCAN8 1
#endif
#ifndef USE_PREP8
#define USE_PREP8 1
#endif
#ifndef USE_ROUTER8
#define USE_ROUTER8 1
#endif
#ifndef USE8_IN
#define USE8_IN 1
#endif
#ifndef USE8_OUT
#define USE8_OUT 1
#endif
#ifndef USE8_GU
#define USE8_GU 1
#endif
#ifndef USE8_DOWN
#define USE8_DOWN 1
#endif
__global__ __launch_bounds__(NTHR, 2) void k_fwd(Params p) {
#define PP() (*(const Params*)((const char*)&p + launder0()))
    extern __shared__ __attribute__((aligned(16))) unsigned char lds[];
    volatile LAS unsigned* xbw = (volatile LAS unsigned*)(lds + LDS_BYTES);
    if (threadIdx.x == 0) { xbw[0] = 0u; xbw[1] = 0u; xbw[2] = 0u; xbw[3] = 0u; }
    __syncthreads();
    (void)xcd_barrier_post(p.bar, xbw);
#define GRIDBAR() do { XcdBarrier _b; _b.bar = PP().bar; _b.x = xb_xcc_id(); _b.st = (volatile LAS unsigned*)(lds + LDS_BYTES); xcd_barrier(_b); } while (0)
#ifndef TIME_PH
#define TIME_PH -1
#endif
    volatile unsigned long long* tsl = (volatile unsigned long long*)(lds + RSEL_OFF + 8192);
    int nst = 0;
#define STAMP() do { if (TIME_PH >= 0) { if (blockIdx.x == 0 && threadIdx.x == 0 && nst < 60) tsl[nst] = wall_clock64(); ++nst; } } while (0)
    STAMP();
#ifdef TIME_PRO
#define PROBAR() do { GRIDBAR(); STAMP(); } while (0)
#else
#define PROBAR() do { __syncthreads(); } while (0)
#endif
#ifndef REP_PRO
#define REP_PRO 1
#endif
#ifndef REP_GEMM
#define REP_GEMM 1
#endif
#ifndef REP_SCAN
#define REP_SCAN 1
#endif
#ifndef REP_POST
#define REP_POST 1
#endif
#ifndef REP_ATT
#define REP_ATT 1
#endif
#ifndef REP_MIX
#define REP_MIX 1
#endif
    for (int rep = 0; rep < REP_PRO; ++rep) {
    phase_adaln(PP(), lds);   PROBAR();
    phase_convert(PP(), lds); PROBAR();
    phase_cv_lrt(PP());       PROBAR();
    phase_cv_u(PP(), lds);    PROBAR();
    phase_cv_wrt(PP());
    GRIDBAR(); STAMP(); }
    phase_prenorm0(PP());
    GRIDBAR(); STAMP();
#pragma unroll 1
    for (int l = 0; l < 2; ++l) {
        for (int rep = 0; rep < REP_GEMM; ++rep) {
        if (USE8_IN) phase_gemm_in8(PP(), l, lds); else phase_gemm_in(PP(), l, lds);
        GRIDBAR(); STAMP(); }
        for (int rep = 0; rep < REP_MIX; ++rep) {
        for (int r2 = 0; r2 < REP_ATT; ++r2) { if (USE_ATTN8) phase_attn8(PP(), l, lds); else phase_attn_naive(PP()); }
        __syncthreads(); STAMP();
        if (USE_PREP8) phase_prep8(PP(), l, lds); else phase_rwkv_prep(PP(), l, lds);
        GRIDBAR(); STAMP();
        for (int r2 = 0; r2 < REP_SCAN; ++r2) { if (USE_SCAN8) phase_scan8(PP(), l, lds); else phase_scan_naive(PP());
        GRIDBAR(); STAMP(); }
        for (int r2 = 0; r2 < REP_POST; ++r2) { if (USE_ATTN8) phase_post8(PP(), l); else phase_post(PP(), l);
        GRIDBAR(); STAMP(); } }
        for (int rep = 0; rep < REP_GEMM; ++rep) {
        if (USE8_OUT) phase_gemm_out8(PP(), l, lds); else phase_gemm_out(PP(), l, lds);
        GRIDBAR(); STAMP(); }
        if (USE_ROUTER8) phase_res1_router8(PP(), l, lds); else phase_res1_router(PP(), l, lds);
        convert_leftovers(PP(), l, lds);
        GRIDBAR(); STAMP();
        for (int rep = 0; rep < REP_GEMM; ++rep) {
        if (USE8_GU) phase_moe_gu8(PP(), l, lds); else phase_moe_gu(PP(), l, lds);
        GRIDBAR(); STAMP(); }
        for (int rep = 0; rep < REP_GEMM; ++rep) {
        if (USE8_DOWN) phase_moe_down8(PP(), l, lds); else phase_moe_down(PP(), l, lds);
        GRIDBAR(); STAMP(); }
        phase_combine(PP(), l, lds);
        GRIDBAR(); STAMP();
    }
    if (TIME_PH >= 0 && blockIdx.x == 0 && threadIdx.x == 0) {
        const unsigned long long d = tsl[TIME_PH + 1] - tsl[TIME_PH], t0 = wall_clock64();
        const unsigned long long lim = (9ull * d < 5000000ull) ? 9ull * d : 5000000ull;
        while (wall_clock64() - t0 < lim) __builtin_amdgcn_s_sleep(8);
    }
}

extern "C" void kernel_launch(void* const* d_in, const int* in_sizes, int n_in, void* d_out, int out_size, void* d_ws, size_t ws_size, hipStream_t stream) {
    Params p{};
    const float* const* in = (const float* const*)d_in;
    p.x = in[0]; p.c = in[1]; p.w_ada = in[2]; p.b_ada = in[3]; p.g_pre_mix = in[4]; p.g_post_mix = in[5]; p.g_pre_ffn = in[6]; p.g_post_ffn = in[7]; p.w_in = in[8]; p.w_out = in[9];
    p.lam_q1 = in[10]; p.lam_k1 = in[11]; p.lam_q2 = in[12]; p.lam_k2 = in[13]; p.subln_g = in[14]; p.mu = in[15]; p.w0 = in[16]; p.w2 = in[17]; p.a0 = in[18]; p.a2 = in[19]; p.g2 = in[20];
    p.k_k = in[21]; p.k_a = in[22]; p.r_k = in[23]; p.lnx_w = in[24]; p.lnx_b = in[25]; p.v0 = in[26]; p.v1 = in[27]; p.v2 = in[28];
    p.w_router = in[29]; p.router_bias = in[30]; p.w_eg = in[31]; p.w_eu = in[32]; p.w_ed = in[33]; p.w_sg = in[34]; p.w_su = in[35]; p.w_sd = in[36];
    p.out = (float*)d_out;
    unsigned char* ws = (unsigned char*)d_ws; size_t off = 0;
    auto take = [&](size_t bytes) { void* r = ws + off; off += (bytes + 255) & ~(size_t)255; return r; };
    p.bar = (unsigned*)take(16384);
    p.counts = (unsigned*)take(2 * NE * 128);
    p.cvprog = (unsigned*)take(2 * 1024 * 4);
    p.mod = (float*)take((size_t)2 * 4 * 12288 * 4);
    p.Hn = (bf16_t*)take((size_t)T_ * D_ * 2);
    p.P = (bf16_t*)take((size_t)T_ * NIN * 2);
    p.sr = (float*)take((size_t)T_ * RW * 4); p.sw = (float*)take((size_t)T_ * RW * 4); p.sk = (float*)take((size_t)T_ * RW * 4); p.sv = (float*)take((size_t)T_ * RW * 4);
    p.sa = (float*)take((size_t)T_ * RW * 4); p.sb = (float*)take((size_t)T_ * RW * 4); p.sy = (float*)take((size_t)T_ * RW * 4); p.sg = (float*)take((size_t)T_ * RW * 4);
    p.vfirst = (float*)take((size_t)T_ * RW * 4);
    p.hr = (bf16_t*)p.sr; p.hk = (bf16_t*)p.sk; p.hv = (bf16_t*)p.sv; p.ha = (bf16_t*)p.sa; p.hb = (bf16_t*)p.sb; p.hg = (bf16_t*)p.sg;
    p.bcoef = (float*)take((size_t)T_ * 16 * 4);
    p.ocat = (bf16_t*)take((size_t)T_ * D_ * 2);
    p.mixed = (float*)take((size_t)T_ * D_ * 4);
    p.rowtok = (int*)take((size_t)NE * CAP * 4);
    p.rowg = (float*)take((size_t)NE * CAP * 4);
    p.tokpos = (int*)take((size_t)T_ * 8 * 4);
    p.tokgate = (float*)take((size_t)T_ * 8 * 4);
    p.H1 = (bf16_t*)take((size_t)PMAX * 512 * 2);
    p.Y2 = (bf16_t*)take((size_t)PMAX * D_ * 2);
    p.Vt = (bf16_t*)take((size_t)T_ * 1024 * 2);
    p.LRT = (bf16_t*)take((size_t)2 * 1024 * 288 * 2);
    p.WrT = (bf16_t*)take((size_t)2 * 2 * NE * D_ * 2);
    p.VV = (float*)take((size_t)T_ * 64 * 4);
    p.WinT = (bf16_t*)take((size_t)2 * NINX * D_ * 2);
    p.WoutT = (bf16_t*)take((size_t)2 * D_ * D_ * 2);
    p.WguT = (bf16_t*)take((size_t)2 * 65 * 1024 * D_ * 2);
    p.WdT = (bf16_t*)take((size_t)2 * 65 * D_ * 512 * 2);
    (void)hipMemsetAsync(p.bar, 0, (size_t)((unsigned char*)p.mod - (unsigned char*)p.bar), stream);
    static int grid = 0;
    if (!grid) {
        int dev = 0, cus = 0, per_cu = 0;
        (void)hipGetDevice(&dev);
        (void)hipDeviceGetAttribute(&cus, hipDeviceAttributeMultiprocessorCount, dev);
        (void)hipFuncSetAttribute((const void*)k_fwd, hipFuncAttributeMaxDynamicSharedMemorySize, LDS_BYTES + 16);
        (void)hipOccupancyMaxActiveBlocksPerMultiprocessor(&per_cu, k_fwd, NTHR, LDS_BYTES + 16);
        if (per_cu < 1) per_cu = 1;
        grid = cus;
    }
    k_fwd<<<grid, NTHR, LDS_BYTES + 16, stream>>>(p);
}
```

```cpp
#include <hip/hip_runtime.h>
#include <stdint.h>

typedef unsigned short bf16_t;
typedef short bf16x8 __attribute__((ext_vector_type(8)));
typedef float f32x4 __attribute__((ext_vector_type(4)));
typedef unsigned u32x4 __attribute__((ext_vector_type(4)));
typedef unsigned u32x2 __attribute__((ext_vector_type(2)));

#define T_    8192
#define D_    2048
#define S_    2048
#define NB_   4
#define NIN   6400
#define NINX  6656
#define RW    1024
#define NE    64
#define CAP   8192
#define PMAX  90112
#define USE_ATTN8 1
#define NTHR  512
#define NW_   (NTHR / 64)
#define TAB_OFF 131072
#define RSEL_OFF 133120
#define LDS_BYTES (133120 + 10240)

struct Params {
    const float *x, *c, *w_ada, *b_ada, *g_pre_mix, *g_post_mix, *g_pre_ffn, *g_post_ffn, *w_in, *w_out;
    const float *lam_q1, *lam_k1, *lam_q2, *lam_k2, *subln_g, *mu, *w0, *w2, *a0, *a2, *g2, *k_k, *k_a, *r_k, *lnx_w, *lnx_b, *v0, *v1, *v2;
    const float *w_router, *router_bias, *w_eg, *w_eu, *w_ed, *w_sg, *w_su, *w_sd;
    float* out;
    unsigned* bar;
    float* mod;
    bf16_t* Hn;
    bf16_t* P;
    float *sr, *sw, *sk, *sv, *sa, *sb, *sy, *sg, *vfirst;
    bf16_t *hr, *hk, *hv, *ha, *hb, *hg;
    float* bcoef;
    bf16_t* ocat;
    float* mixed;
    unsigned* counts;
    int* rowtok;
    float* rowg;
    int* tokpos;
    float* tokgate;
    bf16_t* H1;
    bf16_t* Y2;
    bf16_t* Vt;
    unsigned* cvprog;
    float* VV;
    bf16_t* WrT;
    bf16_t* LRT;
    bf16_t *WinT, *WoutT, *WguT, *WdT;
};

__device__ __forceinline__ float bf2f(unsigned short h) { return __uint_as_float(((unsigned)h) << 16); }
__device__ __forceinline__ unsigned cvt_pk_bf16(float lo, float hi) { unsigned r; asm volatile("v_cvt_pk_bf16_f32 %0, %1, %2" : "=v"(r) : "v"(lo), "v"(hi)); return r; }
__device__ __forceinline__ float bflo(unsigned u) { return __uint_as_float(u << 16); }
__device__ __forceinline__ float bfhi(unsigned u) { return __uint_as_float(u & 0xffff0000u); }
__device__ __forceinline__ float wave_sum(float v) {
#pragma unroll
    for (int o = 32; o > 0; o >>= 1) v += __shfl_xor(v, o);
    return v;
}
__device__ __forceinline__ float frcp_(float x) { return __builtin_amdgcn_rcpf(x); }
__device__ __forceinline__ float sigmoidf_(float x) { return frcp_(1.0f + __expf(-x)); }
__device__ __forceinline__ float tanhf_(float x) { return 1.0f - 2.0f * frcp_(1.0f + __expf(2.0f * x)); }
#define RL(v, j) __int_as_float(__builtin_amdgcn_readlane(__float_as_int(v), (j)))
__device__ __forceinline__ int launder0() { int z = 0; asm volatile("" : "+s"(z)); return z; }
__device__ __forceinline__ int tid_() { int z = 0; asm volatile("" : "+v"(z)); return (int)threadIdx.x + z; }
__device__ __forceinline__ int bid_() { return (int)blockIdx.x + launder0(); }
__device__ __forceinline__ int nblk_() { return (int)gridDim.x + launder0(); }
__device__ __forceinline__ int rfl(int v) { return __builtin_amdgcn_readfirstlane(v); }


#define XB_TMO      128
#define XB_XCNT(j)  (256  + 64 * (j))
#define XB_XSUB(j)  (1280 + 64 * (j))
#define XB_XGEN(j)  (2304 + 64 * (j))
#define XB_TOP      3328
#define XB_TOPGEN   3392
#define XCD_BAR_WORDS 3456
#define XB_SPIN_CAP (1u << 18)
#define LAS __attribute__((address_space(3)))
__device__ __forceinline__ unsigned xb_ld(unsigned* p)              { return __hip_atomic_load(p, __ATOMIC_RELAXED, __HIP_MEMORY_SCOPE_AGENT); }
__device__ __forceinline__ unsigned xb_add(unsigned* p, unsigned v) { return __hip_atomic_fetch_add(p, v, __ATOMIC_RELAXED, __HIP_MEMORY_SCOPE_AGENT); }
__device__ __forceinline__ unsigned xb_xcc_id() { return (unsigned)__builtin_amdgcn_s_getreg((3 << 11) | 20) & 0xFu; }
#define XB_SPIN(cond, bar) do { unsigned _sp = 0; while (cond) { __builtin_amdgcn_s_sleep(1); \
    if ((++_sp & 255u) == 0u) { if (xb_ld(&(bar)[XB_TMO])) break; if (_sp > XB_SPIN_CAP) { atomicAdd(&(bar)[XB_TMO], 1u); break; } } } } while (0)
struct XcdBarrier { unsigned* bar; unsigned x; volatile LAS unsigned* st; };
__device__ __forceinline__ XcdBarrier xcd_barrier_post(unsigned* bar, volatile LAS unsigned* st) {
    XcdBarrier b; b.bar = bar; b.x = xb_xcc_id(); b.st = st;
    if (threadIdx.x == 0) (void)xb_add(&bar[XB_XCNT(b.x)], 1u);
    return b;
}
__device__ __forceinline__ void xcd_barrier_complete(unsigned* bar, unsigned x, unsigned& nloc, unsigned& nx) {
    const unsigned G = gridDim.x * gridDim.y * gridDim.z;
    unsigned sum, cnt, mine, sp = 0u;
    for (;;) {
        sum = 0u; cnt = 0u; mine = 0u;
#pragma unroll
        for (unsigned j = 0; j < 16; ++j) { const unsigned c = xb_ld(&bar[XB_XCNT(j)]); sum += c; cnt += (c > 0u) ? 1u : 0u; mine = (j == x) ? c : mine; }
        if (sum == G) break;
        __builtin_amdgcn_s_sleep(1);
        if ((++sp & 255u) == 0u) { if (xb_ld(&bar[XB_TMO])) break; if (sp > XB_SPIN_CAP) { atomicAdd(&bar[XB_TMO], 1u); break; } }
    }
    nloc = mine > 0u ? mine : 1u; nx = cnt > 0u ? cnt : 1u;
}
__device__ __forceinline__ void xcd_barrier(const XcdBarrier& b) {
    asm volatile("s_waitcnt vmcnt(0)" ::: "memory");
    __syncthreads();
    if (threadIdx.x == 0) {
        unsigned* bar = b.bar;
        __builtin_amdgcn_s_waitcnt(0);
        unsigned nloc = b.st[0], nx = b.st[1];
        if (nloc == 0u) { xcd_barrier_complete(bar, b.x, nloc, nx); b.st[0] = nloc; b.st[1] = nx; }
        const unsigned old = xb_add(&bar[XB_XSUB(b.x)], 1u);
        const unsigned gen = old / nloc;
        if (old + 1u == (gen + 1u) * nloc) {
            __builtin_amdgcn_fence(__ATOMIC_RELEASE, "agent");
            asm volatile("s_waitcnt vmcnt(0)" ::: "memory");
            const unsigned og = xb_add(&bar[XB_TOP], 1u);
            const unsigned tg = og / nx;
            if (og + 1u == (tg + 1u) * nx) xb_add(&bar[XB_TOPGEN], 1u);
            else XB_SPIN(xb_ld(&bar[XB_TOPGEN]) == tg, bar);
            __builtin_amdgcn_fence(__ATOMIC_ACQUIRE, "agent");
            xb_add(&bar[XB_XGEN(b.x)], 1u);
            asm volatile("s_waitcnt vmcnt(0)" ::: "memory");
        } else {
            XB_SPIN(xb_ld(&bar[XB_XGEN(b.x)]) == gen, bar);
            __builtin_amdgcn_fence(__ATOMIC_ACQUIRE, "agent");
            asm volatile("s_waitcnt vmcnt(0)" ::: "memory");
        }
    }
    __syncthreads();
}

#define GT_ROWB 144
template <class ARow, class Epi>
__device__ __forceinline__ void gemm_tile(unsigned char* lds, const bf16_t* A, int lda, ARow arow, const float* bp, int ldb, int K, Epi epi) {
    const int tid = tid_(), lane = tid & 63, wid = tid >> 6, wm = wid >> 1, wn = wid & 1, fr = lane & 15, fq = lane >> 4;
    if (tid >= 256) { for (int i = 0; i < 2 * (K >> 6) + 1; ++i) __syncthreads(); return; }
    unsigned char* sA = lds;
    unsigned char* sB = lds + 128 * GT_ROWB;
    const bf16_t* ap[4];
    int aoff[4];
#pragma unroll
    for (int i = 0; i < 4; ++i) { const int ch = tid + i * 256, r = ch >> 3, kc = ch & 7; ap[i] = A + (size_t)arow(r) * lda + kc * 8; aoff[i] = r * GT_ROWB + kc * 16; }
    const int bn = tid & 127, bkh = tid >> 7;
    const float* bq = bp + (size_t)(bkh * 32) * ldb;
    const int boff = bn * GT_ROWB + bkh * 64;
    f32x4 acc[4][4];
#pragma unroll
    for (int i = 0; i < 4; ++i)
#pragma unroll
        for (int j = 0; j < 4; ++j) acc[i][j] = (f32x4){0.f, 0.f, 0.f, 0.f};
    u32x4 ra[4]; float rb[32];
    const int nk = K >> 6;
#pragma unroll
    for (int i = 0; i < 4; ++i) ra[i] = *(const u32x4*)(ap[i]);
#pragma unroll
    for (int i = 0; i < 32; ++i) rb[i] = bq[(size_t)i * ldb];
    for (int kt = 0; kt < nk; ++kt) {
        __syncthreads();
#pragma unroll
        for (int i = 0; i < 4; ++i) *(u32x4*)(sA + aoff[i]) = ra[i];
#pragma unroll
        for (int g = 0; g < 4; ++g) { u32x4 w; w.x = cvt_pk_bf16(rb[g * 8 + 0], rb[g * 8 + 1]); w.y = cvt_pk_bf16(rb[g * 8 + 2], rb[g * 8 + 3]); w.z = cvt_pk_bf16(rb[g * 8 + 4], rb[g * 8 + 5]); w.w = cvt_pk_bf16(rb[g * 8 + 6], rb[g * 8 + 7]);
            *(u32x4*)(sB + boff + g * 16) = w; }
        __syncthreads();
        if (kt + 1 < nk) {
#pragma unroll
            for (int i = 0; i < 4; ++i) ra[i] = *(const u32x4*)(ap[i] + (size_t)(kt + 1) * 64);
            const float* bqq = bq + (size_t)(kt + 1) * 64 * ldb;
#pragma unroll
            for (int i = 0; i < 32; ++i) rb[i] = bqq[(size_t)i * ldb];
        }
#pragma unroll
        for (int ks = 0; ks < 2; ++ks) {
            bf16x8 af[4], bfr[4];
#pragma unroll
            for (int i = 0; i < 4; ++i) af[i] = *(const bf16x8*)(sA + (wm * 64 + i * 16 + fr) * GT_ROWB + ks * 64 + fq * 16);
#pragma unroll
            for (int j = 0; j < 4; ++j) bfr[j] = *(const bf16x8*)(sB + (wn * 64 + j * 16 + fr) * GT_ROWB + ks * 64 + fq * 16);
#pragma unroll
            for (int i = 0; i < 4; ++i)
#pragma unroll
                for (int j = 0; j < 4; ++j) acc[i][j] = __builtin_amdgcn_mfma_f32_16x16x32_bf16(bfr[j], af[i], acc[i][j], 0, 0, 0);
        }
    }
#pragma unroll
    for (int i = 0; i < 4; ++i)
#pragma unroll
        for (int j = 0; j < 4; ++j) epi(wm * 64 + i * 16 + fr, wn * 64 + j * 16 + fq * 4, acc[i][j]);
    __syncthreads();
}

#ifndef GP_SP2
#define GP_SP2 true
#endif
#ifndef GP_ALIGN
#define GP_ALIGN true
#endif
namespace gp {
constexpr int BM = 256, BK = 64, HALF = 128, HTB = HALF * BK * 2, STAGE_BYTES = 8 * HTB;
__device__ __forceinline__ int lds_byte(int r, int c) { const int st = (r >> 4) * 2 + (c >> 5), rr = r & 15, cc = c & 31, ob = rr * 64 + cc * 2; return st * 1024 + (ob ^ (((ob >> 9) & 1) << 5)); }
__device__ __forceinline__ void stage_rc(int b, int& R, int& C) { const int st = b / 1024, sb = b % 1024, swz = sb ^ (((sb >> 9) & 1) << 5); R = (st >> 1) * 16 + swz / 64; C = (st & 1) * 32 + (swz % 64) / 2; }
__device__ __forceinline__ int perm32(int rho) { const int n = rho >> 4, i = rho & 15; return 8 * (i >> 2) + 4 * n + (i & 3); }
struct Unit { int pm, pn, e; };
typedef f32x4 Acc[2][2][4][2];

template <bool GATHER, int PERM  , bool SP2, bool ALIGN_EPI, class Sched, class Epi>
__device__ __forceinline__ void gemm_phase(LAS unsigned char* lds, const int K, const Sched& S, const Epi& E) {
    const int tid = tid_(), wid = rfl(tid >> 6), lane = tid & 63, wr = wid >> 2, wc = wid & 3, fr = lane & 15, fq = lane >> 4;
    const int nt = K / BK;
    int Rr[2], Cc[2]; unsigned voffB[2], voffB1[2];
#pragma unroll
    for (int i = 0; i < 2; ++i) { int R, C; stage_rc(tid * 16 + i * 8192, R, C); Rr[i] = R; Cc[i] = C;
        if (PERM == 2) { const int wcs = R >> 5, nn = (R >> 4) & 1, ii = R & 15, cb = 64 * wcs + 16 * (ii >> 2) + 4 * nn + (ii & 3);
            voffB[i] = (unsigned)(cb * K + C) * 2u; voffB1[i] = (unsigned)((cb + 8) * K + C) * 2u; }
        else { const int Rb = (PERM == 1) ? ((R & ~31) + perm32(R & 31)) : R; voffB[i] = (unsigned)(Rb * K + C) * 2u; voffB1[i] = voffB[i]; } }
    const size_t hstepB = (PERM == 2) ? 0 : (size_t)HALF * K * 2;
    const size_t kstep = (size_t)(BK * 2);
    const size_t hstep = (size_t)HALF * K * 2;
    const unsigned ldsw = (unsigned)wid * 1024u;
    const int aoff = lds_byte(wr * 64 + fr, fq * 8), boff = lds_byte(wc * 32 + fr, fq * 8);
#define GP_SA(b, h) (((b) * 2 + (h)) * HTB)
#define GP_SB(b, h) ((4 + (b) * 2 + (h)) * HTB)
#define GP_STAGE(bufoff, gbase, voff) do { _Pragma("unroll") for (int _i = 0; _i < 2; ++_i) \
        __builtin_amdgcn_global_load_lds((const unsigned*)((const char*)(gbase) + (voff)[_i]), (LAS unsigned*)(lds + (bufoff) + ldsw + _i * 8192), 16, 0, 0); } while (0)
#define GP_LDA(dst, b, h) do { _Pragma("unroll") for (int m = 0; m < 4; ++m) _Pragma("unroll") for (int k = 0; k < 2; ++k) dst[m][k] = *(const LAS bf16x8*)(lds + GP_SA(b, h) + aoff + m * 2048 + k * 1024); } while (0)
#define GP_LDB(dst, b, h) do { _Pragma("unroll") for (int n = 0; n < 2; ++n) _Pragma("unroll") for (int k = 0; k < 2; ++k) dst[n][k] = *(const LAS bf16x8*)(lds + GP_SB(b, h) + boff + n * 2048 + k * 1024); } while (0)
#define GP_MMA(ai, bj, At, Bt) do { __builtin_amdgcn_s_setprio(1); _Pragma("unroll") for (int m = 0; m < 4; ++m) _Pragma("unroll") for (int n = 0; n < 2; ++n) _Pragma("unroll") for (int k = 0; k < 2; ++k) \
        acc[ai][bj][m][n] = __builtin_amdgcn_mfma_f32_16x16x32_bf16(Bt[n][k], At[m][k], acc[ai][bj][m][n], 0, 0, 0); __builtin_amdgcn_s_setprio(0); } while (0)
#define GP_WAIT_V(n) asm volatile("s_waitcnt vmcnt(" #n ")" ::: "memory")
#define GP_WAIT_L(n) asm volatile("s_waitcnt lgkmcnt(" #n ")" ::: "memory")
#define GP_BAR __builtin_amdgcn_s_barrier()
#define GP_SCHED __builtin_amdgcn_sched_barrier(0)
#define GP_VOFF(u, v) do { _Pragma("unroll") for (int _h = 0; _h < 2; ++_h) _Pragma("unroll") for (int _i = 0; _i < 2; ++_i) { \
        const int _row = GATHER ? S.a_row(u, _h * 128 + Rr[_i]) : (_h * 128 + Rr[_i]); v[_h][_i] = (unsigned)(_row * K + Cc[_i]) * 2u; } } while (0)
    Unit cur, nxt; int ui = 0;
    if (!S.next(0, cur)) return;
    Acc acc;
#pragma unroll
    for (int a = 0; a < 2; ++a)
#pragma unroll
        for (int b = 0; b < 2; ++b)
#pragma unroll
            for (int m = 0; m < 4; ++m)
#pragma unroll
                for (int n = 0; n < 2; ++n) acc[a][b][m][n] = (f32x4){0.f, 0.f, 0.f, 0.f};
    bf16x8 At[4][2], B0[2][2], B1[2][2];
    unsigned vA[2][2], vAn[2][2];
    const char* cA = S.a_base(cur); const char* cB = S.b_base(cur);
    GP_VOFF(cur, vA);
    if constexpr (SP2) {
        GP_STAGE(GP_SB(0, 0), cB, voffB); GP_STAGE(GP_SB(0, 1), cB + hstepB, voffB1); GP_STAGE(GP_SA(0, 0), cA, vA[0]); GP_STAGE(GP_SA(0, 1), cA, vA[1]);
        if (wr == 1) GP_BAR;
        GP_WAIT_V(2); GP_BAR;
        GP_STAGE(GP_SB(1, 0), cB + kstep, voffB); GP_STAGE(GP_SA(1, 0), cA + kstep, vA[0]); GP_STAGE(GP_SB(1, 1), cB + hstepB + kstep, voffB1);
        GP_WAIT_V(6); GP_BAR;
    } else {
        GP_STAGE(GP_SB(0, 0), cB, voffB); GP_STAGE(GP_SA(0, 0), cA, vA[0]); GP_STAGE(GP_SB(0, 1), cB + hstepB, voffB1); GP_STAGE(GP_SA(0, 1), cA, vA[1]);
        if (wr == 1) GP_BAR;
        GP_WAIT_V(4); GP_BAR;
        GP_STAGE(GP_SB(1, 0), cB + kstep, voffB); GP_STAGE(GP_SA(1, 0), cA + kstep, vA[0]); GP_STAGE(GP_SB(1, 1), cB + hstepB + kstep, voffB1);
        GP_WAIT_V(6); GP_BAR;
    }
    for (;;) {
        const bool has_next = S.next(ui + 1, nxt);
        const char* nA = has_next ? S.a_base(nxt) : cA; const char* nB = has_next ? S.b_base(nxt) : cB;
        if (GATHER) { if (has_next) { GP_VOFF(nxt, vAn); } else { vAn[0][0] = vA[0][0]; vAn[0][1] = vA[0][1]; vAn[1][0] = vA[1][0]; vAn[1][1] = vA[1][1]; } }
        for (int t = 0; t < nt; t += 2) {
            const bool last = (t == nt - 2);
            const char* a1 = cA + (size_t)(t + 1) * kstep;
            const char* a2 = last ? nA : cA + (size_t)(t + 2) * kstep; const char* b2 = last ? nB : cB + (size_t)(t + 2) * kstep;
            const char* a3 = a2 + kstep; const char* b3 = b2 + kstep;
            unsigned v2[2][2];
#pragma unroll
            for (int h = 0; h < 2; ++h)
#pragma unroll
                for (int i = 0; i < 2; ++i) v2[h][i] = (GATHER && last) ? vAn[h][i] : vA[h][i];
            if constexpr (SP2) {
            GP_LDB(B0, 0, 0); GP_LDB(B1, 0, 1); GP_SCHED; GP_LDA(At, 0, 0); GP_STAGE(GP_SA(1, 1), a1, vA[1]);
            GP_WAIT_V(8); GP_WAIT_L(0); GP_BAR; GP_MMA(0, 0, At, B0); GP_MMA(0, 1, At, B1); GP_BAR; GP_SCHED;
            GP_LDA(At, 0, 1); GP_STAGE(GP_SB(0, 0), b2, voffB); GP_STAGE(GP_SB(0, 1), b2 + hstepB, voffB1); GP_STAGE(GP_SA(0, 0), a2, v2[0]);
            GP_WAIT_V(8); GP_WAIT_L(0); GP_BAR; GP_MMA(1, 0, At, B0); GP_MMA(1, 1, At, B1); GP_BAR; GP_SCHED;
            GP_LDB(B0, 1, 0); GP_LDB(B1, 1, 1); GP_SCHED; GP_LDA(At, 1, 0); GP_STAGE(GP_SA(0, 1), a2, v2[1]);
            GP_WAIT_V(8); GP_WAIT_L(0); GP_BAR; GP_MMA(0, 0, At, B0); GP_MMA(0, 1, At, B1); GP_BAR; GP_SCHED;
            GP_LDA(At, 1, 1); GP_STAGE(GP_SB(1, 0), b3, voffB); GP_STAGE(GP_SB(1, 1), b3 + hstepB, voffB1); GP_STAGE(GP_SA(1, 0), a3, v2[0]);
            GP_WAIT_V(8); GP_WAIT_L(0); GP_BAR; GP_MMA(1, 0, At, B0); GP_MMA(1, 1, At, B1); GP_BAR; GP_SCHED;
            } else {
            GP_LDB(B0, 0, 0); GP_SCHED; GP_LDA(At, 0, 0); GP_STAGE(GP_SA(1, 1), a1, vA[1]);
            GP_WAIT_L(8); GP_BAR; GP_WAIT_L(0); GP_MMA(0, 0, At, B0); GP_BAR; GP_SCHED;
            GP_LDB(B1, 0, 1); GP_STAGE(GP_SB(0, 0), b2, voffB);
            GP_BAR; GP_WAIT_L(0); GP_MMA(0, 1, At, B1); GP_BAR;
            GP_LDA(At, 0, 1); GP_STAGE(GP_SA(0, 0), a2, v2[0]);
            GP_BAR; GP_WAIT_L(0); GP_MMA(1, 0, At, B0); GP_BAR; GP_SCHED;
            GP_STAGE(GP_SB(0, 1), b2 + hstepB, voffB1);
            GP_WAIT_V(6); GP_BAR; GP_MMA(1, 1, At, B1); GP_BAR;
            GP_LDB(B0, 1, 0); GP_SCHED; GP_LDA(At, 1, 0); GP_STAGE(GP_SA(0, 1), a2, v2[1]);
            GP_WAIT_L(8); GP_BAR; GP_WAIT_L(0); GP_MMA(0, 0, At, B0); GP_BAR; GP_SCHED;
            GP_LDB(B1, 1, 1); GP_STAGE(GP_SB(1, 0), b3, voffB);
            GP_BAR; GP_WAIT_L(0); GP_MMA(0, 1, At, B1); GP_BAR;
            GP_LDA(At, 1, 1); GP_STAGE(GP_SA(1, 0), a3, v2[0]);
            GP_BAR; GP_WAIT_L(0); GP_MMA(1, 0, At, B0); GP_BAR; GP_SCHED;
            GP_STAGE(GP_SB(1, 1), b3 + hstepB, voffB1);
            GP_WAIT_V(6); GP_BAR; GP_MMA(1, 1, At, B1); GP_BAR;
            }
        }
        if constexpr (ALIGN_EPI) { if (wr == 0) GP_BAR; }
        E(acc, cur, wr, wc, fr, fq);
        if (!has_next) break;
#pragma unroll
        for (int a = 0; a < 2; ++a)
#pragma unroll
            for (int b = 0; b < 2; ++b)
#pragma unroll
                for (int m = 0; m < 4; ++m)
#pragma unroll
                    for (int n = 0; n < 2; ++n) acc[a][b][m][n] = (f32x4){0.f, 0.f, 0.f, 0.f};
        cur = nxt; cA = nA; cB = nB; ++ui;
        if (GATHER) { vA[0][0] = vAn[0][0]; vA[0][1] = vAn[0][1]; vA[1][0] = vAn[1][0]; vA[1][1] = vAn[1][1]; }
        if constexpr (ALIGN_EPI) { if (wr == 1) GP_BAR; }
    }
    GP_WAIT_V(0);
    if constexpr (!ALIGN_EPI) { if (wr == 0) GP_BAR; }
    GP_BAR;
#undef GP_SA
#undef GP_SB
#undef GP_STAGE
#undef GP_LDA
#undef GP_LDB
#undef GP_MMA
#undef GP_WAIT_V
#undef GP_WAIT_L
#undef GP_BAR
#undef GP_SCHED
#undef GP_VOFF
}

struct DenseSched {
    const bf16_t* A; const bf16_t* Bt; int K, nM, nN, nwg, G, c;
    __device__ __forceinline__ void init(const bf16_t* A_, const bf16_t* Bt_, int M, int N, int K_, int G_, int c_) { A = A_; Bt = Bt_; K = K_; nM = M / BM; nN = N / BM; nwg = nM * nN; G = G_; c = c_; }
    __device__ __forceinline__ bool next(int i, Unit& u) const {
        const long L = (long)i * G + c; if (L >= nwg) return false;
        int wgid = (int)L; { const int q = nwg / 8, r = nwg % 8, xcd = wgid % 8, off = wgid / 8; wgid = (xcd < r ? xcd * (q + 1) : r * (q + 1) + (xcd - r) * q) + off; }
        const int nig = 8 * nN, gid = wgid / nig, fm = gid * 8, gsz = (nM - fm) < 8 ? (nM - fm) : 8;
        u.pm = fm + ((wgid % nig) % gsz); u.pn = (wgid % nig) / gsz; u.e = 0; return true;
    }
    __device__ __forceinline__ const char* a_base(const Unit& u) const { return (const char*)A + (size_t)u.pm * BM * K * 2; }
    __device__ __forceinline__ const char* b_base(const Unit& u) const { return (const char*)Bt + (size_t)u.pn * BM * K * 2; }
    __device__ __forceinline__ int a_row(const Unit&, int r) const { return r; }
};
}

struct CvDesc { const float* src; bf16_t* dst; int N, K; };
#define CV_I_IN  (32 * 100)
#define CV_I_OUT (32 * 32)
#define CV_I_GU  (32 * 8)
#define CV_I_D   (8 * 32)
#define CV_PER_L (CV_I_IN + CV_I_OUT + 65 * 2 * CV_I_GU + 65 * CV_I_D)
#define CV_TOTAL (2 * CV_PER_L)
#define CV_PRO   (CV_I_IN + CV_I_OUT)
__device__ __forceinline__ void cv_decode(const Params& p, int it0, int lane, CvDesc& d, int& rowmul) {
    const int l = it0 / CV_PER_L; int r = it0 - l * CV_PER_L;
    const float* W; bf16_t* Wt; int N, K, gu = 0; rowmul = 1;
    if (r < CV_I_IN) { W = p.w_in + (size_t)l * D_ * NIN; N = NIN; K = D_; Wt = p.WinT + (size_t)l * NINX * D_; }
    else if ((r -= CV_I_IN) < CV_I_OUT) { W = p.w_out + (size_t)l * D_ * D_; N = D_; K = D_; Wt = p.WoutT + (size_t)l * D_ * D_; }
    else if ((r -= CV_I_OUT) < 65 * 2 * CV_I_GU) { const int e = r / (2 * CV_I_GU), rr = r - e * 2 * CV_I_GU, which = rr / CV_I_GU; r = rr - which * CV_I_GU;
        W = (e < NE) ? ((which ? p.w_eu : p.w_eg) + (size_t)(l * NE + e) * D_ * 512) : ((which ? p.w_su : p.w_sg) + (size_t)l * D_ * 512);
        N = 512; K = D_; Wt = p.WguT + (size_t)(l * 65 + e) * 1024 * D_; gu = 1 + which; }
    else { r -= 65 * 2 * CV_I_GU; const int e = r / CV_I_D; r -= e * CV_I_D;
        W = (e < NE) ? (p.w_ed + (size_t)(l * NE + e) * 512 * D_) : (p.w_sd + (size_t)l * 512 * D_); N = D_; K = 512; Wt = p.WdT + (size_t)(l * 65 + e) * D_ * 512; }
    const int nkt = K >> 6, ntile = r / nkt, kt = r - ntile * nkt, k0 = kt * 64, n0 = ntile * 64;
    const int drow = gu ? ((n0 >> 7) * 256 + (gu - 1) * 128 + (n0 & 127)) : n0;
    d.src = W + (size_t)k0 * N + n0; d.dst = Wt + (size_t)drow * K + k0; d.N = N; d.K = K;
}
__device__ __forceinline__ void cv_load(const CvDesc& d, float (&v)[64], int lane) {
#pragma unroll
    for (int k = 0; k < 64; ++k) v[k] = d.src[(size_t)(k * d.N) + lane];
}
__device__ __forceinline__ void cv_store(const CvDesc& d, int rowmul, const float (&v)[64], unsigned char* scr, int lane) {
#pragma unroll
    for (int g = 0; g < 8; ++g) { u32x4 w; w.x = cvt_pk_bf16(v[g * 8 + 0], v[g * 8 + 1]); w.y = cvt_pk_bf16(v[g * 8 + 2], v[g * 8 + 3]); w.z = cvt_pk_bf16(v[g * 8 + 4], v[g * 8 + 5]); w.w = cvt_pk_bf16(v[g * 8 + 6], v[g * 8 + 7]);
        *(u32x4*)(scr + lane * 144 + g * 16) = w; }
    asm volatile("s_waitcnt lgkmcnt(0)" ::: "memory"); __builtin_amdgcn_wave_barrier();
#pragma unroll
    for (int j = 0; j < 8; ++j) { const int n = (lane >> 3) + 8 * j, kc = lane & 7; const u32x4 w = *(const u32x4*)(scr + n * 144 + kc * 16);
        *(u32x4*)(d.dst + (size_t)(n * rowmul) * d.K + kc * 8) = w; }
    __builtin_amdgcn_wave_barrier();
}
__device__ __forceinline__ void convert_one(const Params& p, int it0, unsigned char* scr, int lane) {
    CvDesc d; int rm; cv_decode(p, it0, lane, d, rm);
    float v[64]; cv_load(d, v, lane); cv_store(d, rm, v, scr, lane);
}
__device__ __forceinline__ unsigned cv_ld_stop(volatile unsigned* q) { return *q; }
__device__ __forceinline__ int convert_stream(const Params& p, int first, int stride, int hi, volatile unsigned* stop, unsigned char* scr, int lane) {
    int n = 0, it = first;
    if (it >= hi || (stop && cv_ld_stop(stop) != 0u)) return 0;
    CvDesc da, db; int rma, rmb; float va[64], vb[64];
    cv_decode(p, it, lane, da, rma); cv_load(da, va, lane);
    for (;;) {
        int itn = it + stride; bool more = itn < hi && !(stop && cv_ld_stop(stop) != 0u);
        { const int iq = more ? itn : it; cv_decode(p, iq, lane, db, rmb); cv_load(db, vb, lane); }
        cv_store(da, rma, va, scr, lane); ++n;
        if (!more) break;
        it = itn; itn = it + stride; more = itn < hi && !(stop && cv_ld_stop(stop) != 0u);
        { const int iq = more ? itn : it; cv_decode(p, iq, lane, da, rma); cv_load(da, va, lane); }
        cv_store(db, rmb, vb, scr, lane); ++n;
        if (!more) break;
        it = itn;
    }
    return n;
}
__device__ __forceinline__ int cv_lo(int l) { return l ? CV_PER_L + CV_PRO : CV_PRO; }
#define CV_NPRE(l) ((l) ? 9216 : 10240)
__device__ __forceinline__ int cv_hi(int l) { return (l ? CV_TOTAL : CV_PER_L + CV_PRO) - CV_NPRE(l); }
__device__ __forceinline__ void convert_leftovers(const Params& p, int l, unsigned char* lds) {
    const int tid = tid_(), lane = tid & 63, w = tid >> 6, gw = bid_() * NW_ + w, ncv = nblk_() * 2;
    unsigned char* scr = lds + w * 9216;
    const int g = gw % ncv, sub = gw / ncv;
    const int k0 = (int)p.cvprog[l * 1024 + g];
    (void)convert_stream(p, cv_lo(l) + g + ncv * (k0 + sub), ncv * (NW_ / 2), cv_hi(l), nullptr, scr, lane);
}
__device__ __forceinline__ void phase_convert(const Params& p, unsigned char* lds) {
    const int tid = tid_();
    { const int lane = tid & 63, w = tid >> 6; unsigned char* scr = lds + w * 9216;
      (void)convert_stream(p, bid_() * NW_ + w, nblk_() * NW_, CV_PRO, nullptr, scr, lane); }
}
__device__ __forceinline__ void phase_cv_lrt(const Params& p) {
    const int tid = tid_();
    for (int idx = bid_() * NTHR + tid; idx < 2 * 1024 * 288; idx += nblk_() * NTHR) {
        const int l = idx / (1024 * 288), r = idx - l * (1024 * 288), col = r / 288, k = r - col * 288;
        float v;
        if (k < 64) v = p.w2[((size_t)l * 64 + k) * RW + col]; else if (k < 128) v = p.a2[((size_t)l * 64 + (k - 64)) * RW + col]; else if (k < 256) v = p.g2[((size_t)l * 128 + (k - 128)) * RW + col];
        else v = (l > 0) ? p.v2[(size_t)(k - 256) * RW + col] : 0.f;
        p.LRT[idx] = (bf16_t)(cvt_pk_bf16(v, v) & 0xffffu);
    }
}
__device__ __forceinline__ void phase_cv_u(const Params& p, unsigned char* lds) {
    const int tid = tid_(), lane = tid & 63;
    {
        float* xs = (float*)lds;
        const float* muv = p.mu + 3328 + 2048;
        for (int kb = bid_(); kb < D_ / 8; kb += nblk_()) {
            const int kk = rfl(tid >> 6), k = kb * 8 + kk;
            const float* wv = p.w_in + (size_t)D_ * NIN + (size_t)k * NIN + 5120;
            float wreg[16];
#pragma unroll
            for (int i = 0; i < 16; ++i) wreg[i] = wv[i * 64 + lane];
            float a = 0.f;
#pragma unroll
            for (int half = 0; half < 2; ++half) {
                __syncthreads();
                f32x4 vq[8]; float mq[8];
#pragma unroll
                for (int j = 0; j < 8; ++j) { const int task = tid + NTHR * j, c = half * 512 + (task >> 3), q4 = (task & 7) * 4; mq[j] = muv[c]; vq[j] = *(const f32x4*)(p.v1 + c * 32 + q4); }
#pragma unroll
                for (int j = 0; j < 8; ++j) { const int task = tid + NTHR * j, cl = task >> 3, q4 = (task & 7) * 4; const float m = mq[j];
                    *(f32x4*)(xs + cl * 64 + q4) = vq[j] * (1.0f - m); *(f32x4*)(xs + cl * 64 + 32 + q4) = vq[j] * m; }
                __syncthreads();
#pragma unroll 1
                for (int i = 0; i < 8; ++i) { const float wr = wreg[0];
#pragma unroll
                    for (int q = 0; q < 15; ++q) wreg[q] = wreg[q + 1];
                    const float* xr = xs + (size_t)i * 4096 + lane;
#pragma unroll
                    for (int j = 0; j < 64; ++j) a += RL(wr, j) * xr[j * 64]; }
            }
            p.WinT[(size_t)NINX * D_ + (size_t)(NIN + lane) * D_ + k] = (bf16_t)(cvt_pk_bf16(a, a) & 0xffffu);
        }
        __syncthreads();
    }
}
__device__ __forceinline__ void phase_cv_wrt(const Params& p) {
    const int tid = tid_();
    for (int idx = bid_() * NTHR + tid; idx < 2 * NE * D_; idx += nblk_() * NTHR) {
        const int l = idx / (NE * D_), r = idx - l * (NE * D_), e = r / D_, k = r - e * D_;
        const float v = p.w_router[((size_t)l * D_ + k) * NE + e];
        const unsigned hi = cvt_pk_bf16(v, v) & 0xffffu; const float rem = v - bflo(hi);
        p.WrT[(size_t)(l * 2) * NE * D_ + r] = (bf16_t)hi; p.WrT[(size_t)(l * 2 + 1) * NE * D_ + r] = (bf16_t)(cvt_pk_bf16(rem, rem) & 0xffffu);
    }
}

struct EpiIn {
    bf16_t* P; bf16_t* Vt; float* VV;
    __device__ __forceinline__ void operator()(const gp::Acc& acc, const gp::Unit& u, int wr, int wc, int fr, int fq) const {
        const int row0 = u.pm * 256 + wr * 64 + fr, col0 = u.pn * 256 + wc * 32 + 8 * fq;
        if (u.pn == 25) {
            if (wc < 2) {
#pragma unroll
                for (int ai = 0; ai < 2; ++ai)
#pragma unroll
                    for (int m = 0; m < 4; ++m) { float* vp = VV + (size_t)(row0 + ai * 128 + m * 16) * 64 + wc * 32 + 8 * fq;
                        *(f32x4*)vp = acc[ai][0][m][0]; *(f32x4*)(vp + 4) = acc[ai][0][m][1]; } }
            return;
        }
#pragma unroll
        for (int ai = 0; ai < 2; ++ai)
#pragma unroll
            for (int m = 0; m < 4; ++m) { bf16_t* rowp = P + (size_t)(row0 + ai * 128 + m * 16) * NIN + col0;
#pragma unroll
                for (int bj = 0; bj < 2; ++bj) { const f32x4 v0 = acc[ai][bj][m][0], v1 = acc[ai][bj][m][1];
                    u32x4 w; w.x = cvt_pk_bf16(v0[0], v0[1]); w.y = cvt_pk_bf16(v0[2], v0[3]); w.z = cvt_pk_bf16(v1[0], v1[1]); w.w = cvt_pk_bf16(v1[2], v1[3]);
                    *(u32x4*)(rowp + bj * 128) = w; } }
    }
};
struct EpiBf16Rows {
    bf16_t* C; int ldc;
    __device__ __forceinline__ void operator()(const gp::Acc& acc, const gp::Unit& u, int wr, int wc, int fr, int fq) const {
        const int row0 = u.pm * 256 + wr * 64 + fr, col0 = u.pn * 256 + wc * 32 + 8 * fq;
#pragma unroll
        for (int ai = 0; ai < 2; ++ai)
#pragma unroll
            for (int m = 0; m < 4; ++m) { bf16_t* rowp = C + (size_t)(row0 + ai * 128 + m * 16) * ldc + col0;
#pragma unroll
                for (int bj = 0; bj < 2; ++bj) { const f32x4 v0 = acc[ai][bj][m][0], v1 = acc[ai][bj][m][1];
                    u32x4 w; w.x = cvt_pk_bf16(v0[0], v0[1]); w.y = cvt_pk_bf16(v0[2], v0[3]); w.z = cvt_pk_bf16(v1[0], v1[1]); w.w = cvt_pk_bf16(v1[2], v1[3]);
                    *(u32x4*)(rowp + bj * 128) = w; } }
    }
};
struct EpiF32 {
    float* C; int ldc;
    __device__ __forceinline__ void operator()(const gp::Acc& acc, const gp::Unit& u, int wr, int wc, int fr, int fq) const {
        const int row0 = u.pm * 256 + wr * 64 + fr, col0 = u.pn * 256 + wc * 32 + 4 * fq;
#pragma unroll
        for (int ai = 0; ai < 2; ++ai)
#pragma unroll
            for (int m = 0; m < 4; ++m) { float* rowp = C + (size_t)(row0 + ai * 128 + m * 16) * ldc + col0;
#pragma unroll
                for (int bj = 0; bj < 2; ++bj)
#pragma unroll
                    for (int n = 0; n < 2; ++n) *(f32x4*)(rowp + bj * 128 + n * 16) = acc[ai][bj][m][n]; }
    }
};
__device__ __forceinline__ void phase_gemm_in8(const Params& p, int l, unsigned char* lds) {
    gp::DenseSched S; S.init(p.Hn, p.WinT + (size_t)l * NINX * D_, T_, l ? NINX : NIN, D_, nblk_(), bid_());
    EpiIn E{p.P, p.Vt, p.VV};
    gp::gemm_phase<false, 1, GP_SP2, GP_ALIGN>((LAS unsigned char*)lds, D_, S, E);
    {
        const int G = nblk_(), c = bid_(), nwg = (T_ / 256) * ((l ? NINX : NIN) / 256), nlong = nwg % G;
        if (nlong != 0 && c >= nlong) {
            const int tid = tid_(), lane = tid & 63, w = tid >> 6, sw = (c - nlong) * NW_ + w, nsw = (G - nlong) * NW_;
            unsigned char* scr = lds + w * 9216;
            (void)convert_stream(p, cv_hi(l) + sw, nsw, cv_hi(l) + CV_NPRE(l), nullptr, scr, lane);
        }
    }
}
__device__ __forceinline__ void phase_gemm_out8(const Params& p, int l, unsigned char* lds) {
    gp::DenseSched S; S.init(p.ocat, p.WoutT + (size_t)l * D_ * D_, T_, D_, D_, nblk_(), bid_());
    EpiBf16Rows E{(bf16_t*)p.mixed, D_};
    gp::gemm_phase<false, 1, GP_SP2, GP_ALIGN>((LAS unsigned char*)lds, D_, S, E);
}

__device__ __forceinline__ void build_tables(const Params& p, int l, int* tab, int tshift) {
    if (threadIdx.x == 0) {
        int pb = 0, tb = 0;
        for (int e = 0; e <= NE; ++e) { const int c = (e < NE) ? (int)__hip_atomic_load(p.counts + (l * NE + e) * 32, __ATOMIC_RELAXED, __HIP_MEMORY_SCOPE_AGENT) : T_;
            tab[e] = c; tab[80 + e] = pb; tab[160 + e] = tb; pb += (c + 255) & ~255; tb += (c + (1 << tshift) - 1) >> tshift; }
        tab[80 + NE + 1] = pb; tab[160 + NE + 1] = tb;
    }
    __syncthreads();
    {
        unsigned char* emap = (unsigned char*)(tab + 256);
        const int nt = tab[160 + NE + 1];
        for (int rt = tid_(); rt < nt && rt < 1024; rt += NTHR) { int e = 0; while (e < NE && rt >= tab[160 + e + 1]) ++e; emap[rt] = (unsigned char)e; }
    }
    __syncthreads();
}
__device__ __forceinline__ int find_expert(const int* tab, int rt) { return (int)((const unsigned char*)(tab + 256))[rt]; }

struct MoeSched {
    const int* tab; const char* A; const char* Bt; size_t bt_stride; const int* rowtok; int K, nN, nunits, G, c; bool gather;
    __device__ __forceinline__ bool next(int i, gp::Unit& u) const {
        const int L = i * G + c; if (L >= nunits) return false;
        const int rtg = L / nN; u.pn = L - rtg * nN; const int e = find_expert(tab, rtg); u.e = e; u.pm = rtg - tab[160 + e]; return true;
    }
    __device__ __forceinline__ const char* a_base(const gp::Unit& u) const { return gather ? A : A + (size_t)(tab[80 + u.e] + u.pm * 256) * K * 2; }
    __device__ __forceinline__ const char* b_base(const gp::Unit& u) const { return Bt + (size_t)u.e * bt_stride + (size_t)u.pn * 256 * K * 2; }
    __device__ __forceinline__ int a_row(const gp::Unit& u, int r) const { const int slot = u.pm * 256 + r; return (slot < tab[u.e]) ? ((u.e < NE) ? rowtok[u.e * CAP + slot] : slot) : 0; }
};
struct EpiSwiglu {
    bf16_t* H1; const int* tab;
    __device__ __forceinline__ void operator()(const gp::Acc& acc, const gp::Unit& u, int wr, int wc, int fr, int fq) const {
        const int row0 = tab[80 + u.e] + u.pm * 256 + wr * 64 + fr, hid0 = u.pn * 128 + wc * 32 + 8 * fq;
#pragma unroll
        for (int ai = 0; ai < 2; ++ai)
#pragma unroll
            for (int m = 0; m < 4; ++m) { bf16_t* rowp = H1 + (size_t)(row0 + ai * 128 + m * 16) * 512 + hid0;
                float h[8];
#pragma unroll
                for (int n = 0; n < 2; ++n)
#pragma unroll
                    for (int jj = 0; jj < 4; ++jj) { const float g = acc[ai][0][m][n][jj], uu = acc[ai][1][m][n][jj]; h[n * 4 + jj] = g * frcp_(1.0f + __expf(-g)) * uu; }
                u32x4 o; o.x = cvt_pk_bf16(h[0], h[1]); o.y = cvt_pk_bf16(h[2], h[3]); o.z = cvt_pk_bf16(h[4], h[5]); o.w = cvt_pk_bf16(h[6], h[7]);
                *(u32x4*)rowp = o; }
    }
};
#define Y2_SCALE 8.0f
struct EpiDown {
    unsigned char* Y2; const int* tab;
    __device__ __forceinline__ void operator()(const gp::Acc& acc, const gp::Unit& u, int wr, int wc, int fr, int fq) const {
        const int slot0 = u.pm * 256 + wr * 64 + fr, cnt = tab[u.e], row0 = tab[80 + u.e] + slot0, col0 = u.pn * 256 + wc * 64 + 16 * fq;
#pragma unroll
        for (int ai = 0; ai < 2; ++ai)
#pragma unroll
            for (int m = 0; m < 4; ++m) {
                if (slot0 + ai * 128 + m * 16 < cnt) {
                    u32x4 o;
#pragma unroll
                    for (int bj = 0; bj < 2; ++bj) { f32x4 v0 = acc[ai][bj][m][0] * Y2_SCALE, v1 = acc[ai][bj][m][1] * Y2_SCALE;
#pragma unroll
                        for (int jj = 0; jj < 4; ++jj) { v0[jj] = __builtin_amdgcn_fmed3f(v0[jj], -440.0f, 440.0f); v1[jj] = __builtin_amdgcn_fmed3f(v1[jj], -440.0f, 440.0f); }
                        int w0 = __builtin_amdgcn_cvt_pk_fp8_f32(v0[0], v0[1], 0, false); w0 = __builtin_amdgcn_cvt_pk_fp8_f32(v0[2], v0[3], w0, true);
                        int w1 = __builtin_amdgcn_cvt_pk_fp8_f32(v1[0], v1[1], 0, false); w1 = __builtin_amdgcn_cvt_pk_fp8_f32(v1[2], v1[3], w1, true);
                        if (bj == 0) { o.x = (unsigned)w0; o.y = (unsigned)w1; } else { o.z = (unsigned)w0; o.w = (unsigned)w1; } }
                    *(u32x4*)(Y2 + (size_t)(row0 + ai * 128 + m * 16) * D_ + col0) = o; } }
    }
};
__device__ __forceinline__ int xcd_order(int c, int G) { return (G % 8 == 0) ? (c % 8) * (G / 8) + c / 8 : c; }
__device__ __forceinline__ void phase_moe_gu8(const Params& p, int l, unsigned char* lds) {
    int* tab = (int*)(lds + TAB_OFF);
    build_tables(p, l, tab, 8);
    MoeSched S{tab, (const char*)p.Hn, (const char*)(p.WguT + (size_t)l * 65 * 1024 * D_), (size_t)1024 * D_ * 2, p.rowtok, D_, 4, tab[160 + NE + 1] * 4, nblk_(), xcd_order(bid_(), nblk_()), true};
    EpiSwiglu E{p.H1, tab};
    gp::gemm_phase<true, 1, GP_SP2, GP_ALIGN>((LAS unsigned char*)lds, D_, S, E);
}
__device__ __forceinline__ void phase_moe_down8(const Params& p, int l, unsigned char* lds) {
    int* tab = (int*)(lds + TAB_OFF);
    build_tables(p, l, tab, 8);
    MoeSched S{tab, (const char*)p.H1, (const char*)(p.WdT + (size_t)l * 65 * D_ * 512), (size_t)D_ * 512 * 2, p.rowtok, 512, 8, tab[160 + NE + 1] * 8, nblk_(), xcd_order(bid_(), nblk_()), false};
    EpiDown E{(unsigned char*)p.Y2, tab};
    gp::gemm_phase<false, 2, GP_SP2, GP_ALIGN>((LAS unsigned char*)lds, 512, S, E);
}

__device__ __forceinline__ void phase_adaln(const Params& p, unsigned char* lds) {
    typedef float f32x2a __attribute__((ext_vector_type(2)));
    float* cond = (float*)lds;
    float* red = cond + 4 * D_;
    const int tid = tid_(), lane = tid & 63, w = tid >> 6;
    for (int i = tid; i < 4 * D_; i += NTHR) { const float v = p.c[i]; cond[(i & (D_ - 1)) * 4 + (i >> 11)] = v / (1.0f + __expf(-v)); }
    __syncthreads();
    for (int unit = bid_(); unit < 192; unit += nblk_()) {
        const int l = unit / 96, n0 = (unit % 96) * 128, k0 = rfl(w) * 256;
        const float* W = p.w_ada + (size_t)l * D_ * 12288 + (size_t)k0 * 12288 + n0;
        f32x2a acc[4];
#pragma unroll
        for (int b = 0; b < 4; ++b) acc[b] = (f32x2a){0.f, 0.f};
#pragma unroll 1
        for (int kb = 0; kb < 256; kb += 16) {
            f32x2a wv[16];
#pragma unroll
            for (int k = 0; k < 16; ++k) wv[k] = *(const f32x2a*)(W + (size_t)((kb + k) * 12288) + lane * 2);
#pragma unroll
            for (int k = 0; k < 16; ++k) { const f32x4 cv = *(const f32x4*)(cond + (k0 + kb + k) * 4);
#pragma unroll
                for (int b = 0; b < 4; ++b) acc[b] += wv[k] * cv[b]; }
        }
#pragma unroll
        for (int b = 0; b < 4; ++b) *(f32x2a*)(red + (w * 4 + b) * 128 + lane * 2) = acc[b];
        __syncthreads();
        { const int b = tid >> 7, col = tid & 127; float sm = 0.f;
#pragma unroll
            for (int ww = 0; ww < NW_; ++ww) sm += red[(ww * 4 + b) * 128 + col];
            p.mod[((size_t)l * 4 + b) * 12288 + n0 + col] = sm + p.b_ada[(size_t)l * 12288 + n0 + col]; }
        __syncthreads();
    }
}

__device__ __forceinline__ void emit_hn(const f32x4 (&xv)[8], float rstd, const float* g, const float* sc, const float* sh, bf16_t* dst, int lane, float* hf) {
#pragma unroll
    for (int i = 0; i < 8; ++i) {
        const int e = i * 256 + lane * 4;
        const f32x4 gv = *(const f32x4*)(g + e), scv = *(const f32x4*)(sc + e), shv = *(const f32x4*)(sh + e);
        f32x4 h;
#pragma unroll
        for (int j = 0; j < 4; ++j) h[j] = xv[i][j] * rstd * gv[j] * (1.0f + scv[j]) + shv[j];
        u32x2 o; o.x = cvt_pk_bf16(h[0], h[1]); o.y = cvt_pk_bf16(h[2], h[3]);
        *(u32x2*)(dst + e) = o;
        if (hf) *(f32x4*)(hf + e) = h;
    }
}

__device__ __forceinline__ void phase_prenorm0(const Params& p) {
    const int lane = tid_() & 63, gw = bid_() * (NTHR / 64) + (tid_() >> 6), nw = nblk_() * (NTHR / 64);
    f32x4 xn[8];
    if (gw < T_) {
#pragma unroll
        for (int i = 0; i < 8; ++i) xn[i] = *(const f32x4*)(p.x + (size_t)gw * D_ + i * 256 + lane * 4);
    }
    for (int t = gw; t < T_; t += nw) {
        const int b = t / S_;
        f32x4 xv[8]; float ss = 0.f;
#pragma unroll
        for (int i = 0; i < 8; ++i) { xv[i] = xn[i]; ss += xv[i][0] * xv[i][0] + xv[i][1] * xv[i][1] + xv[i][2] * xv[i][2] + xv[i][3] * xv[i][3]; }
        if (t + nw < T_) {
#pragma unroll
            for (int i = 0; i < 8; ++i) xn[i] = *(const f32x4*)(p.x + (size_t)(t + nw) * D_ + i * 256 + lane * 4);
        }
        ss = wave_sum(ss);
        const float rstd = rsqrtf(ss * (1.0f / D_) + 1e-6f);
        const float* md = p.mod + (size_t)b * 12288;
        emit_hn(xv, rstd, p.g_pre_mix, md + 2048, md, p.Hn + (size_t)t * D_, lane, nullptr);
    }
}

__device__ __forceinline__ void phase_gemm_in(const Params& p, int l, unsigned char* lds) {
    const float* B = p.w_in + (size_t)l * D_ * NIN;
    for (int unit = bid_(); unit < 64 * 50; unit += nblk_()) {
        const int mt = unit / 50, nt = unit % 50;
        bf16_t* Pp = p.P;
        gemm_tile(lds, p.Hn, D_, [=](int r) { return mt * 128 + r; }, B + nt * 128 + (tid_() & 127), NIN, D_,
                  [=](int m, int n, f32x4 v) { u32x2 o; o.x = cvt_pk_bf16(v[0], v[1]); o.y = cvt_pk_bf16(v[2], v[3]); *(u32x2*)(Pp + (size_t)(mt * 128 + m) * NIN + nt * 128 + n) = o; });
    }
}

__device__ __forceinline__ void phase_attn_naive(const Params& p) {
    const int lane = tid_() & 63, gw = bid_() * (NTHR / 64) + (tid_() >> 6), nw = nblk_() * (NTHR / 64);
    float* tmp = p.mixed;
    for (int it = gw; it < 2048; it += nw) {
        const int item = rfl(it);
        const int qb = 31 - (item >> 6), rest = item & 63, c = rest & 1, h = (rest >> 1) & 7, b = rest >> 4;
        const int q = qb * 64 + lane;
        const bf16_t* Pb = p.P + (size_t)b * S_ * NIN;
        float qv[64];
        {
            const bf16_t* qp = Pb + (size_t)q * NIN + h * 128 + c * 64;
#pragma unroll
            for (int i = 0; i < 8; ++i) { const u32x4 u = *(const u32x4*)(qp + i * 8);
#pragma unroll
                for (int j = 0; j < 4; ++j) { qv[i * 8 + j * 2] = __uint_as_float(u[j] << 16); qv[i * 8 + j * 2 + 1] = __uint_as_float(u[j] & 0xffff0000u); } }
        }
        const float scale2 = 0.125f * 1.44269504f, slope2 = exp2f(-(float)(h + 1)) * 1.44269504f;
        const int jmax = qb * 64 + 63;
        const bf16_t* kbase = Pb + 1024 + h * 128 + c * 64;
        const bf16_t* vbase = Pb + 2048 + h * 128;
        float m = -1e30f;
        for (int j = 0; j <= jmax; ++j) {
            const u32x4* kp = (const u32x4*)(kbase + (size_t)j * NIN);
            float s = 0.f;
#pragma unroll
            for (int i = 0; i < 8; ++i) { const u32x4 u = kp[i];
#pragma unroll
                for (int jj = 0; jj < 4; ++jj) { s += qv[i * 8 + jj * 2] * __uint_as_float(u[jj] << 16); s += qv[i * 8 + jj * 2 + 1] * __uint_as_float(u[jj] & 0xffff0000u); } }
            s = s * scale2 - slope2 * (float)(q - j);
            if (j <= q) m = fmaxf(m, s);
        }
        const float minv = 1.0f;
#pragma unroll 1
        for (int dh = 0; dh < 2; ++dh) {
            float lsum = 0.f; float acc[64];
#pragma unroll
            for (int d = 0; d < 64; ++d) acc[d] = 0.f;
            for (int j = 0; j <= jmax; ++j) {
                const u32x4* kp = (const u32x4*)(kbase + (size_t)j * NIN);
                float s = 0.f;
#pragma unroll
                for (int i = 0; i < 8; ++i) { const u32x4 u = kp[i];
#pragma unroll
                    for (int jj = 0; jj < 4; ++jj) { s += qv[i * 8 + jj * 2] * __uint_as_float(u[jj] << 16); s += qv[i * 8 + jj * 2 + 1] * __uint_as_float(u[jj] & 0xffff0000u); } }
                s = s * scale2 - slope2 * (float)(q - j);
                const float pj = (j <= q) ? exp2f(s - m) : 0.f;
                lsum += pj;
                const u32x4* vp = (const u32x4*)(vbase + (size_t)j * NIN + dh * 64);
#pragma unroll
                for (int i = 0; i < 8; ++i) { const u32x4 u = vp[i];
#pragma unroll
                    for (int jj = 0; jj < 4; ++jj) { acc[i * 8 + jj * 2] += pj * __uint_as_float(u[jj] << 16); acc[i * 8 + jj * 2 + 1] += pj * __uint_as_float(u[jj] & 0xffff0000u); } }
            }
            const float inv = minv / lsum;
            float* op = tmp + (size_t)(b * S_ + q + launder0()) * D_ + h * 256 + c * 128;
#pragma unroll
            for (int d = 0; d < 64; d += 4) *(f32x4*)(op + dh * 64 + d) = (f32x4){acc[d] * inv, acc[d + 1] * inv, acc[d + 2] * inv, acc[d + 3] * inv};
        }
    }
}

typedef float f32x16 __attribute__((ext_vector_type(16)));
#define AT_ROWB 144
#define AT_VOFF (128 * AT_ROWB)
#define AT_BUFB (128 * AT_ROWB + 64 * 256)
__device__ __forceinline__ int at_voff(int row, int ch) { return 256 * row + 16 * (ch ^ (((row & 3) << 2) | ((row >> 2) & 3))); }
typedef short s16x4 __attribute__((ext_vector_type(4)));
__device__ __forceinline__ void phase_attn8(const Params& p, int l, unsigned char* lds) {
    const int tid = tid_(), lane = tid & 63, w = tid >> 6, r32 = lane & 31, hh = lane >> 5, c = w >> 2, wq = w & 3;
    const int srow = tid >> 3, sch = tid & 7;
    const float lam_init = (l == 0) ? 0.2f : 0.35550907f;
    for (int u0 = bid_(); u0 < 256; u0 += nblk_()) {
        const int unit = (nblk_() == 256) ? xcd_order(u0, 256) : u0;
        const int jp = unit & 7, h = (unit >> 3) & 7, b = unit >> 6;
        const bf16_t* Pb = p.P + (size_t)b * S_ * NIN;
        const bf16_t* Kg = Pb + 1024 + h * 128;
        const bf16_t* Vg = Pb + 2048 + h * 128;
        const unsigned koff = (unsigned)(srow * NIN + sch * 8), voff = (unsigned)((tid >> 4) * NIN + (tid & 15) * 8);
        const float scale2 = 0.125f * 1.44269504f, slopeS = exp2f((float)(2 - h));
        bf16x8 qx, kx0, kx1;
        { u32x4 z = (u32x4){0u, 0u, 0u, 0u}, a0 = z, a1 = z, qq = z;
          if (hh == 0) { a0.x = cvt_pk_bf16((float)r32, 0.f); a1.x = cvt_pk_bf16((float)(32 + r32), 0.f); qq.x = cvt_pk_bf16(slopeS, 0.f); }
          kx0 = __builtin_bit_cast(bf16x8, a0); kx1 = __builtin_bit_cast(bf16x8, a1); qx = __builtin_bit_cast(bf16x8, qq); }
#pragma unroll 1
        for (int half = 0; half < 2; ++half) {
            const int qb = half ? jp : 15 - jp;
            const int q0 = qb * 128 + wq * 32, q = q0 + r32;
            bf16x8 qf[4];
            { const bf16_t* qp = Pb + (size_t)q * NIN + h * 128 + c * 64 + 8 * hh;
#pragma unroll
              for (int ks = 0; ks < 4; ++ks) qf[ks] = *(const bf16x8*)(qp + 16 * ks); }
            f32x16 O[4];
#pragma unroll
            for (int d = 0; d < 4; ++d)
#pragma unroll
                for (int r = 0; r < 16; ++r) O[d][r] = 0.f;
            float m = -1e30f, lsum = 0.f;
            const int ntiles = 2 * qb + 2;
            u32x4 rk0, rk1, rv0, rv1, nk0, nk1, nv0, nv1;
            rk0 = *(const u32x4*)(Kg + koff); rk1 = *(const u32x4*)(Kg + 64 + koff); rv0 = *(const u32x4*)(Vg + voff); rv1 = *(const u32x4*)(Vg + (size_t)32 * NIN + voff);
            *(u32x4*)(lds + srow * AT_ROWB + sch * 16) = rk0; *(u32x4*)(lds + (64 + srow) * AT_ROWB + sch * 16) = rk1;
            *(u32x4*)(lds + AT_VOFF + at_voff(tid >> 4, tid & 15)) = rv0; *(u32x4*)(lds + AT_VOFF + at_voff(32 + (tid >> 4), tid & 15)) = rv1;
            { const bf16_t* kq = Kg + (size_t)64 * NIN; const bf16_t* vq = Vg + (size_t)64 * NIN;
              rk0 = *(const u32x4*)(kq + koff); rk1 = *(const u32x4*)(kq + 64 + koff); rv0 = *(const u32x4*)(vq + voff); rv1 = *(const u32x4*)(vq + (size_t)32 * NIN + voff); }
            __syncthreads();
            auto tile = [&](const int kt, u32x4& hk0, u32x4& hk1, u32x4& hv0, u32x4& hv1, u32x4& gk0, u32x4& gk1, u32x4& gv0, u32x4& gv1) __attribute__((always_inline)) {
                unsigned char* bufp = lds + (kt & 1) * AT_BUFB;
                { const int kn = (kt + 2 < ntiles) ? kt + 2 : ntiles - 1;
                    const bf16_t* kq = Kg + (size_t)kn * 64 * NIN; const bf16_t* vq = Vg + (size_t)kn * 64 * NIN;
                    gk0 = *(const u32x4*)(kq + koff); gk1 = *(const u32x4*)(kq + 64 + koff); gv0 = *(const u32x4*)(vq + voff); gv1 = *(const u32x4*)(vq + (size_t)32 * NIN + voff); }
                if (kt * 64 <= q0 + 31) {
                    f32x16 st[2];
                    {
                        bf16x8 kfr[2][4];
#pragma unroll
                        for (int kb = 0; kb < 2; ++kb)
#pragma unroll
                            for (int ks = 0; ks < 4; ++ks) kfr[kb][ks] = *(const bf16x8*)(bufp + (c * 64 + 32 * kb + r32) * AT_ROWB + (16 * ks + 8 * hh) * 2);
                        __builtin_amdgcn_sched_barrier(0);
#pragma unroll
                        for (int kb = 0; kb < 2; ++kb) {
                            f32x16 a;
#pragma unroll
                            for (int r = 0; r < 16; ++r) a[r] = 0.f;
                            a = __builtin_amdgcn_mfma_f32_32x32x16_bf16(kb ? kx1 : kx0, qx, a, 0, 0, 0);
#pragma unroll
                            for (int ks = 0; ks < 4; ++ks) a = __builtin_amdgcn_mfma_f32_32x32x16_bf16(kfr[kb][ks], qf[ks], a, 0, 0, 0);
                            st[kb] = a;
                        }
                    }
                    const int g_ = lane >> 4, q_ = (lane >> 2) & 3, p_ = lane & 3, clx = (2 * (g_ & 1) + (p_ >> 1)) ^ (g_ >> 1);
                    const LAS unsigned char* vb0 = (const LAS unsigned char*)(bufp + AT_VOFF) + 8 * (p_ & 1) + 256 * (4 * (g_ >> 1) + q_) + 16 * clx;
                    const LAS unsigned char* vb1 = (const LAS unsigned char*)(bufp + AT_VOFF) + 8 * (p_ & 1) + 256 * (4 * (g_ >> 1) + q_) + 16 * (clx ^ 2);
                    s16x4 vt[2][8];
#define AT_VLOAD(buf, d) do { const int dq_ = 64 * ((d) ^ q_); _Pragma("unroll") for (int kb_ = 0; kb_ < 2; ++kb_) _Pragma("unroll") for (int s2_ = 0; s2_ < 2; ++s2_) { \
                            vt[buf][(kb_ * 2 + s2_) * 2] = __builtin_amdgcn_ds_read_tr16_b64_v4i16((LAS s16x4*)(vb0 + dq_ + 256 * (32 * kb_ + 16 * s2_))); \
                            vt[buf][(kb_ * 2 + s2_) * 2 + 1] = __builtin_amdgcn_ds_read_tr16_b64_v4i16((LAS s16x4*)(vb1 + dq_ + 256 * (32 * kb_ + 16 * s2_ + 8))); } } while (0)
                    AT_VLOAD(0, 0);
                    __builtin_amdgcn_sched_barrier(0);
                    const float tb = slopeS * (float)(kt * 64);
                    float mx = -1e30f;
                    if (kt * 64 + 63 > q0) {
                        const int kmq = kt * 64 + 4 * hh - q;
#pragma unroll
                        for (int kb = 0; kb < 2; ++kb)
#pragma unroll
                            for (int r = 0; r < 16; ++r) { const int off = 32 * kb + (r & 3) + 8 * (r >> 2);
                                const float sv = (kmq + off > 0) ? -1e30f : st[kb][r]; st[kb][r] = sv; mx = fmaxf(mx, sv); }
                    } else {
#pragma unroll
                        for (int kb = 0; kb < 2; ++kb)
#pragma unroll
                            for (int r = 0; r < 16; ++r) mx = fmaxf(mx, st[kb][r]);
                    }
                    mx = fmaxf(mx, __shfl_xor(mx, 32));
                    const float mn = fmaxf(m, mx + tb), alpha = __builtin_amdgcn_exp2f((m - mn) * scale2);
                    const bool resc = __any(mn > m);
                    m = mn;
                    const float cexp = (tb - mn) * scale2;
                    float rs = 0.f;
#pragma unroll
                    for (int kb = 0; kb < 2; ++kb)
#pragma unroll
                        for (int r = 0; r < 16; ++r) { const float pe = __builtin_amdgcn_exp2f(st[kb][r] * scale2 + cexp); st[kb][r] = pe; rs += pe; }
                    rs += __shfl_xor(rs, 32);
                    lsum = lsum * alpha + rs;
                    if (resc) {
#pragma unroll
                        for (int d = 0; d < 4; ++d)
#pragma unroll
                            for (int r = 0; r < 16; ++r) O[d][r] *= alpha;
                    }
                    bf16x8 pf[2][2];
#pragma unroll
                    for (int kb = 0; kb < 2; ++kb)
#pragma unroll
                        for (int s2 = 0; s2 < 2; ++s2) { u32x4 u; u.x = cvt_pk_bf16(st[kb][8 * s2 + 0], st[kb][8 * s2 + 1]); u.y = cvt_pk_bf16(st[kb][8 * s2 + 2], st[kb][8 * s2 + 3]);
                            u.z = cvt_pk_bf16(st[kb][8 * s2 + 4], st[kb][8 * s2 + 5]); u.w = cvt_pk_bf16(st[kb][8 * s2 + 6], st[kb][8 * s2 + 7]); pf[kb][s2] = __builtin_bit_cast(bf16x8, u); }
                    {
#pragma unroll
                        for (int d = 0; d < 4; ++d) {
                            if (d + 1 < 4) AT_VLOAD((d + 1) & 1, d + 1);
                            __builtin_amdgcn_sched_barrier(0);
#pragma unroll
                            for (int kb = 0; kb < 2; ++kb)
#pragma unroll
                                for (int s2 = 0; s2 < 2; ++s2) {
                                    const bf16x8 vf = __builtin_shufflevector(vt[d & 1][(kb * 2 + s2) * 2], vt[d & 1][(kb * 2 + s2) * 2 + 1], 0, 1, 2, 3, 4, 5, 6, 7);
                                    O[d] = __builtin_amdgcn_mfma_f32_32x32x16_bf16(vf, pf[kb][s2], O[d], 0, 0, 0); }
                            __builtin_amdgcn_sched_barrier(0);
                        }
#undef AT_VLOAD
                    }
                }
                if (kt + 1 < ntiles) { unsigned char* nb = lds + ((kt + 1) & 1) * AT_BUFB;
                    *(u32x4*)(nb + srow * AT_ROWB + sch * 16) = hk0; *(u32x4*)(nb + (64 + srow) * AT_ROWB + sch * 16) = hk1;
                    *(u32x4*)(nb + AT_VOFF + at_voff(tid >> 4, tid & 15)) = hv0; *(u32x4*)(nb + AT_VOFF + at_voff(32 + (tid >> 4), tid & 15)) = hv1; }
                __syncthreads();
            };
#pragma unroll 1
            for (int kt = 0; kt < ntiles; kt += 2) { tile(kt, rk0, rk1, rv0, rv1, nk0, nk1, nv0, nv1); tile(kt + 1, nk0, nk1, nv0, nv1, rk0, rk1, rv0, rv1); }
            const float inv = 1.0f / lsum;
            float* xo = (float*)lds + (size_t)wq * 64 * 64 + lane;
            if (c == 1) {
#pragma unroll
                for (int d = 0; d < 4; ++d)
#pragma unroll
                    for (int r = 0; r < 16; ++r) xo[(d * 16 + r) * 64] = O[d][r] * inv;
            }
            __syncthreads();
            if (c == 0) {
                float lam;
                { const float s1 = wave_sum(p.lam_q1[l * 64 + lane] * p.lam_k1[l * 64 + lane]), s2 = wave_sum(p.lam_q2[l * 64 + lane] * p.lam_k2[l * 64 + lane]); lam = __expf(s1) - __expf(s2) + lam_init; }
                float ss = 0.f;
#pragma unroll
                for (int d = 0; d < 4; ++d)
#pragma unroll
                    for (int r = 0; r < 16; ++r) { const float o = O[d][r] * inv - lam * xo[(d * 16 + r) * 64]; O[d][r] = o; ss += o * o; }
                ss += __shfl_xor(ss, 32);
                const float rstd = rsqrtf(ss * (1.0f / 128.0f) + 1e-5f) * (1.0f - lam_init);
                bf16_t* op = p.ocat + (size_t)(b * S_ + q) * D_ + h * 128 + 4 * hh;
                const float* sg = p.subln_g + l * 128 + 4 * hh;
#pragma unroll
                for (int d = 0; d < 4; ++d)
#pragma unroll
                    for (int g = 0; g < 4; ++g) { const f32x4 gv = *(const f32x4*)(sg + 32 * d + 8 * g);
                        u32x2 o; o.x = cvt_pk_bf16(O[d][4 * g] * rstd * gv[0], O[d][4 * g + 1] * rstd * gv[1]); o.y = cvt_pk_bf16(O[d][4 * g + 2] * rstd * gv[2], O[d][4 * g + 3] * rstd * gv[3]);
                        *(u32x2*)(op + 32 * d + 8 * g) = o; }
            }
            __syncthreads();
        }
    }
}

__device__ __forceinline__ float shifted(const bf16_t* P, int t, int col, float mu) {
    const float cur = bf2f(P[(size_t)t * NIN + 3072 + col]);
    const float prev = (t % S_) ? bf2f(P[(size_t)(t - 1) * NIN + 3072 + col]) : 0.f;
    return cur + (prev - cur) * mu;
}
#define PREP_RB 2
__device__ __forceinline__ void phase_rwkv_prep(const Params& p, int l, unsigned char* lds) {
    float* lowr = (float*)lds;
    float* vrow = lowr + PREP_RB * 256;
    float* red = vrow + PREP_RB * 1024;
    float* vv = red + PREP_RB * 512;
    const int tid = tid_(), lane = tid & 63;
    const float* mu = p.mu + (size_t)l * 3328;
    const float *w0 = p.w0 + l * RW, *w2 = p.w2 + (size_t)l * 64 * RW, *a0 = p.a0 + l * RW, *a2 = p.a2 + (size_t)l * 64 * RW, *g2 = p.g2 + (size_t)l * 128 * RW;
    const float *k_k = p.k_k + l * RW, *k_a = p.k_a + l * RW, *r_k = p.r_k + l * RW;
    for (int unit = bid_(); unit < T_ / PREP_RB; unit += nblk_()) {
        const int t0 = unit * PREP_RB;
        for (int idx = tid; idx < PREP_RB * 256; idx += NTHR) {
            const int r = idx >> 8, m = idx & 255;
            const float f = shifted(p.P, t0 + r, 3072 + m, mu[3072 + m]);
            lowr[idx] = (m < 64) ? tanhf(f) : (m < 128) ? f : sigmoidf_(f);
        }
        if (l > 0) {
            for (int idx = tid; idx < PREP_RB * 1024; idx += NTHR) { const int r = idx >> 10, cc = idx & 1023; vrow[idx] = shifted(p.P, t0 + r, 2048 + cc, mu[2048 + cc]); }
        }
        __syncthreads();
        if (l > 0) {
            const int j = tid & 31, part = tid >> 5;
            const float* v1 = p.v1;
#pragma unroll
            for (int r = 0; r < PREP_RB; ++r) {
                float s = 0.f;
#pragma unroll 4
                for (int cc = part * 64; cc < part * 64 + 64; ++cc) s += vrow[r * 1024 + cc] * v1[cc * 32 + j];
                red[(r * 16 + part) * 32 + j] = s;
            }
            __syncthreads();
            if (tid < PREP_RB * 32) { const int r = tid >> 5, jj = tid & 31; float s = 0.f;
#pragma unroll
                for (int pp = 0; pp < 16; ++pp) s += red[(r * 16 + pp) * 32 + jj];
                vv[r * 32 + jj] = s; }
            __syncthreads();
        }
#pragma unroll 1
        for (int i = 0; i < 1024 / NTHR; ++i) {
            const int cc = tid + i * NTHR, h = cc >> 6;
            float wa[PREP_RB], aa[PREP_RB], ga[PREP_RB];
#pragma unroll
            for (int r = 0; r < PREP_RB; ++r) { wa[r] = 0.f; aa[r] = 0.f; ga[r] = 0.f; }
#pragma unroll 2
            for (int m = 0; m < 64; ++m) {
                const float w2v = w2[m * RW + cc], a2v = a2[m * RW + cc], g2a = g2[m * RW + cc], g2b = g2[(64 + m) * RW + cc];
#pragma unroll
                for (int r = 0; r < PREP_RB; ++r) { wa[r] += lowr[r * 256 + m] * w2v; aa[r] += lowr[r * 256 + 64 + m] * a2v; ga[r] += lowr[r * 256 + 128 + m] * g2a + lowr[r * 256 + 192 + m] * g2b; }
            }
#pragma unroll
            for (int r = 0; r < PREP_RB; ++r) {
                const int t = t0 + r;
                const float rr = shifted(p.P, t, cc, mu[cc]), kx = shifted(p.P, t, 1024 + cc, mu[1024 + cc]);
                float vx = shifted(p.P, t, 2048 + cc, mu[2048 + cc]);
                const float wv = w0[cc] + wa[r];
                const float decay = __expf(-sigmoidf_(wv) * 0.60653066f);
                const float a = sigmoidf_(a0[cc] + aa[r]);
                const size_t o = (size_t)t * RW + cc;
                if (l == 0) p.vfirst[o] = vx;
                else {
                    float s = p.v0[cc];
#pragma unroll
                    for (int jj = 0; jj < 32; ++jj) s += vv[r * 32 + jj] * p.v2[jj * RW + cc];
                    vx = vx + (p.vfirst[o] - vx) * sigmoidf_(s);
                }
                const float kk = kx * k_k[cc];
                const float ss = wave_sum(kk * kk);
                const float kkn = kk / fmaxf(sqrtf(ss), 1e-12f);
                const float kh = kx * (1.0f + (a - 1.0f) * k_a[cc]);
                const float bc = wave_sum(rr * kh * r_k[cc]);
                if (lane == 0) p.bcoef[(size_t)t * 16 + h] = bc;
                p.sr[o] = rr; p.sw[o] = decay; p.sk[o] = kh; p.sv[o] = vx; p.sa[o] = -kkn; p.sb[o] = kkn * a; p.sg[o] = ga[r];
            }
        }
        __syncthreads();
    }
}

__device__ __forceinline__ void phase_scan_naive(const Params& p) {
    const int lane = tid_() & 63, gw = (tid_() >> 6) * nblk_() + bid_(), nw = nblk_() * (NTHR / 64);
    for (int it = gw; it < 64; it += nw) {
        const int item = rfl(it), b = item >> 4, h = item & 15;
        float st[64];
#pragma unroll
        for (int j = 0; j < 64; ++j) st[j] = 0.f;
        size_t base = (size_t)b * S_ * RW + h * 64 + lane;
        for (int t = 0; t < S_; ++t, base += RW) {
            const float wv = p.sw[base], av = p.sa[base], bv = p.sb[base], kv = p.sk[base], rv = p.sr[base], vi = p.sv[base];
            float sa = 0.f;
#pragma unroll
            for (int j = 0; j < 64; ++j) sa += st[j] * RL(av, j);
            float y = 0.f;
#pragma unroll
            for (int j = 0; j < 64; ++j) { st[j] = st[j] * RL(wv, j) + sa * RL(bv, j) + vi * RL(kv, j); y += st[j] * RL(rv, j); }
            p.sy[base] = y;
        }
    }
}

#define SC_CH 32
#define SC_BUFB (5 * SC_CH * 256 + SC_CH * 64)
__device__ __forceinline__ float dpp_add16(float x) {
    x += __int_as_float(__builtin_amdgcn_update_dpp(0, __float_as_int(x), 0xB1, 0xF, 0xF, true));
    x += __int_as_float(__builtin_amdgcn_update_dpp(0, __float_as_int(x), 0x4E, 0xF, 0xF, true));
    x += __int_as_float(__builtin_amdgcn_update_dpp(0, __float_as_int(x), 0x141, 0xF, 0xF, true));
    x += __int_as_float(__builtin_amdgcn_update_dpp(0, __float_as_int(x), 0x140, 0xF, 0xF, true));
    return x;
}
#define SC_FLAGS (2 * SC_BUFB)
#define SC_CVSCR (2 * SC_BUFB + 512)
__device__ __forceinline__ unsigned lds_ld(volatile unsigned* q) { return *q; }
__device__ __forceinline__ void phase_scan8(const Params& p, int l, unsigned char* lds) {
    const int tid = tid_(), lane = tid & 63, w = tid >> 6, l16 = lane & 15, rs = lane >> 4;
    volatile unsigned* flg = (volatile unsigned*)(lds + SC_FLAGS);
    for (int u0 = bid_(); u0 < 256; u0 += nblk_()) {
        const int unit = (nblk_() == 256) ? xcd_order(u0, 256) : u0;
        const int bh = unit >> 2, rg = unit & 3, b = bh >> 4, h = bh & 15;
        const size_t gbase = (size_t)b * S_ * RW + h * 64;
        if (tid < 8) flg[tid] = 0u;
        __syncthreads();
        if (w < 4) {
            typedef float f32x2v __attribute__((ext_vector_type(2)));
            f32x2v sA = (f32x2v){0.f, 0.f}, sB = (f32x2v){0.f, 0.f};
            const int irow = rg * 16 + w * 4 + rs;
#pragma unroll 1
            for (int c = 0; c < S_ / SC_CH; ++c) {
                { unsigned sp = 0; while (lds_ld(flg) < (unsigned)(c + 1) || lds_ld(flg + 1) < (unsigned)(c + 1)) { __builtin_amdgcn_s_sleep(1); if (++sp > (1u << 22)) break; } }
                const unsigned char* buf = lds + (c & 1) * SC_BUFB;
                float* yp = p.sy + gbase + (size_t)(c * SC_CH + l16) * RW + irow;
                const unsigned char* bl = buf + l16 * 16; const unsigned char* bv = buf + 5 * SC_CH * 256 + (w * 4 + rs) * 4;
#define SC_LOAD(W_, A_, B_, K_, R_, V_, s) do { W_ = *(const f32x4*)(bl + (s) * 256); A_ = *(const f32x4*)(bl + SC_CH * 256 + (s) * 256); B_ = *(const f32x4*)(bl + 2 * SC_CH * 256 + (s) * 256); \
        K_ = *(const f32x4*)(bl + 3 * SC_CH * 256 + (s) * 256); R_ = *(const f32x4*)(bl + 4 * SC_CH * 256 + (s) * 256); V_ = *(const float*)(bv + (s) * 64); } while (0)
#define SC_LO(x) ((f32x2v){x[0], x[1]})
#define SC_HI(x) ((f32x2v){x[2], x[3]})
#define SC_STEP(W_, A_, B_, K_, R_, V_, yout) do { f32x2v t_ = sA * SC_LO(A_); t_ = sB * SC_HI(A_) + t_; float sa = t_.x + t_.y; sa = dpp_add16(sa); \
        const f32x2v sa2 = (f32x2v){sa, sa}, v2 = (f32x2v){V_, V_}; \
        sA = sA * SC_LO(W_) + (sa2 * SC_LO(B_) + v2 * SC_LO(K_)); sB = sB * SC_HI(W_) + (sa2 * SC_HI(B_) + v2 * SC_HI(K_)); \
        f32x2v y_ = sA * SC_LO(R_); y_ = sB * SC_HI(R_) + y_; yout = y_.x + y_.y; } while (0)
#define SC_DPPADD(x, ctrl) ((x) + __int_as_float(__builtin_amdgcn_update_dpp(0, __float_as_int(x), ctrl, 0xF, 0xF, true)))
                f32x4 wA, aA, bA, kA, rA, wB, aB, bB, kB, rB; float vA, vB, ykeep = 0.f;
                const bool od1 = (l16 & 1) != 0, od2 = (l16 & 2) != 0; const int g4 = l16 >> 2;
                SC_LOAD(wA, aA, bA, kA, rA, vA, 0);
#pragma unroll 2
                for (int s = 0; s < SC_CH; s += 4) {
                    float y0, y1, y2, y3;
                    SC_LOAD(wB, aB, bB, kB, rB, vB, s + 1);
                    SC_STEP(wA, aA, bA, kA, rA, vA, y0);
                    SC_LOAD(wA, aA, bA, kA, rA, vA, s + 2);
                    SC_STEP(wB, aB, bB, kB, rB, vB, y1);
                    SC_LOAD(wB, aB, bB, kB, rB, vB, s + 3);
                    SC_STEP(wA, aA, bA, kA, rA, vA, y2);
                    if (s + 4 < SC_CH) SC_LOAD(wA, aA, bA, kA, rA, vA, s + 4);
                    SC_STEP(wB, aB, bB, kB, rB, vB, y3);
                    const float t01 = od1 ? y1 : y0, u01 = od1 ? y0 : y1, t23 = od1 ? y3 : y2, u23 = od1 ? y2 : y3;
                    const float r01 = t01 + __int_as_float(__builtin_amdgcn_update_dpp(0, __float_as_int(u01), 0xB1, 0xF, 0xF, true));
                    const float r23 = t23 + __int_as_float(__builtin_amdgcn_update_dpp(0, __float_as_int(u23), 0xB1, 0xF, 0xF, true));
                    const float tq = od2 ? r23 : r01, uq = od2 ? r01 : r23;
                    float rq = tq + __int_as_float(__builtin_amdgcn_update_dpp(0, __float_as_int(uq), 0x4E, 0xF, 0xF, true));
                    rq = SC_DPPADD(rq, 0x124);
                    rq = SC_DPPADD(rq, 0x128);
                    ykeep = (g4 == ((s >> 2) & 3)) ? rq : ykeep;
                    if ((s & 15) == 12) yp[(size_t)(s & 16) * RW] = ykeep;
                }
#undef SC_LOAD
#undef SC_STEP
#undef SC_LO
#undef SC_HI
#undef SC_DPPADD
                asm volatile("s_waitcnt lgkmcnt(0)" ::: "memory");
                if (lane == 0) flg[4 + w] = (unsigned)(c + 1);
            }
            if (threadIdx.x == 0) flg[2] = 1u;
        } else if (w < 6) {
            const bf16_t *q_a = p.ha, *q_b = p.hb, *q_k = p.hk, *q_r = p.hr;
            const int lt = tid - 256;
#pragma unroll 1
            for (int c = 0; c < S_ / SC_CH; ++c) {
                f32x4 rw[4]; u32x4 rh[8]; u32x2 rv;
#pragma unroll
                for (int i = 0; i < 4; ++i) { const int idx = lt + 128 * i, st = idx >> 4, q4 = idx & 15; rw[i] = *(const f32x4*)(p.sw + gbase + (size_t)(c * SC_CH + st) * RW + q4 * 4); }
#pragma unroll
                for (int i = 0; i < 8; ++i) { const int a = i >> 1, idx = lt + 128 * (i & 1), st = idx >> 3, q8 = idx & 7;
                    const bf16_t* src = (a == 0) ? q_a : (a == 1) ? q_b : (a == 2) ? q_k : q_r;
                    rh[i] = *(const u32x4*)(src + gbase + (size_t)(c * SC_CH + st) * RW + q8 * 8); }
                rv = *(const u32x2*)(p.hv + gbase + (size_t)(c * SC_CH + (lt >> 2)) * RW + rg * 16 + (lt & 3) * 4);
                if (c >= 2) { unsigned sp = 0; const unsigned need = (unsigned)(c - 1);
                    while (lds_ld(flg + 4) < need || lds_ld(flg + 5) < need || lds_ld(flg + 6) < need || lds_ld(flg + 7) < need) { __builtin_amdgcn_s_sleep(1); if (++sp > (1u << 22)) break; } }
                unsigned char* buf = lds + (c & 1) * SC_BUFB;
#pragma unroll
                for (int i = 0; i < 4; ++i) { const int idx = lt + 128 * i, st = idx >> 4, q4 = idx & 15; *(f32x4*)(buf + st * 256 + q4 * 16) = rw[i]; }
#pragma unroll
                for (int i = 0; i < 8; ++i) { const int a = i >> 1, idx = lt + 128 * (i & 1), st = idx >> 3, q8 = idx & 7;
                    unsigned char* dp = buf + (a + 1) * (SC_CH * 256) + st * 256 + q8 * 32;
                    *(f32x4*)dp = (f32x4){bflo(rh[i].x), bfhi(rh[i].x), bflo(rh[i].y), bfhi(rh[i].y)}; *(f32x4*)(dp + 16) = (f32x4){bflo(rh[i].z), bfhi(rh[i].z), bflo(rh[i].w), bfhi(rh[i].w)}; }
                *(f32x4*)(buf + 5 * SC_CH * 256 + (lt >> 2) * 64 + (lt & 3) * 16) = (f32x4){bflo(rv.x), bfhi(rv.x), bflo(rv.y), bfhi(rv.y)};
                asm volatile("s_waitcnt lgkmcnt(0)" ::: "memory");
                if (lane == 0) flg[w - 4] = (unsigned)(c + 1);
            }
        } else {
            unsigned char* scr = lds + SC_CVSCR + (w - 6) * 9216;
            const int g = bid_() * 2 + (w - 6), ncv = nblk_() * 2;
            const int k = convert_stream(p, cv_lo(l) + g, ncv, cv_hi(l), flg + 2, scr, lane);
            if (lane == 0) p.cvprog[l * 1024 + g] = (unsigned)k;
        }
        __syncthreads();
    }
}

#define LR_K 288
#define LR_ROWB 592
__device__ __forceinline__ void phase_prep8(const Params& p, int l, unsigned char* lds) {
    const int tid = tid_(), lane = tid & 63, w = tid >> 6, fr = lane & 15, fq = lane >> 4;
    const float* mu = p.mu + (size_t)l * 3328;
    const bf16_t* LRT = p.LRT + (size_t)l * 1024 * LR_K;
    for (int unit = bid_(); unit < T_ / 32; unit += nblk_()) {
        const int t0 = unit * 32;
        {
            const int tok = tid >> 4, cg = tid & 15, t = t0 + tok; const bool first = (t % S_) == 0;
            const bf16_t* pc = p.P + (size_t)t * NIN + 6144 + cg * 16;
            const u32x4 c0 = *(const u32x4*)pc, c1 = *(const u32x4*)(pc + 8);
            u32x4 p0 = (u32x4){0u, 0u, 0u, 0u}, p1 = p0;
            if (!first) { p0 = *(const u32x4*)(pc - NIN); p1 = *(const u32x4*)(pc - NIN + 8); }
            const float* mm = mu + 3072 + cg * 16;
            float f[16];
#pragma unroll
            for (int e = 0; e < 4; ++e) { f[2 * e] = bflo(c0[e]) + (bflo(p0[e]) - bflo(c0[e])) * mm[2 * e]; f[2 * e + 1] = bfhi(c0[e]) + (bfhi(p0[e]) - bfhi(c0[e])) * mm[2 * e + 1];
                f[8 + 2 * e] = bflo(c1[e]) + (bflo(p1[e]) - bflo(c1[e])) * mm[8 + 2 * e]; f[8 + 2 * e + 1] = bfhi(c1[e]) + (bfhi(p1[e]) - bfhi(c1[e])) * mm[8 + 2 * e + 1]; }
            if (cg < 4) {
#pragma unroll
                for (int e = 0; e < 16; ++e) f[e] = tanhf_(f[e]);
            } else if (cg >= 8) {
#pragma unroll
                for (int e = 0; e < 16; ++e) f[e] = sigmoidf_(f[e]);
            }
            u32x4 o0, o1; o0.x = cvt_pk_bf16(f[0], f[1]); o0.y = cvt_pk_bf16(f[2], f[3]); o0.z = cvt_pk_bf16(f[4], f[5]); o0.w = cvt_pk_bf16(f[6], f[7]);
            o1.x = cvt_pk_bf16(f[8], f[9]); o1.y = cvt_pk_bf16(f[10], f[11]); o1.z = cvt_pk_bf16(f[12], f[13]); o1.w = cvt_pk_bf16(f[14], f[15]);
            *(u32x4*)(lds + tok * LR_ROWB + cg * 32) = o0; *(u32x4*)(lds + tok * LR_ROWB + cg * 32 + 16) = o1;
            if (l > 0) {
                const float* vr = p.VV + (size_t)t * 64;
                const float a0_ = vr[cg] + (first ? 0.f : vr[-64 + 32 + cg]), a1_ = vr[16 + cg] + (first ? 0.f : vr[-64 + 48 + cg]);
                bf16_t* vvp = (bf16_t*)(lds + tok * LR_ROWB + 512);
                vvp[cg] = (bf16_t)(cvt_pk_bf16(a0_, a0_) & 0xffffu); vvp[16 + cg] = (bf16_t)(cvt_pk_bf16(a1_, a1_) & 0xffffu);
            }
        }
        __syncthreads();
#pragma unroll 1
        for (int it = 0; it < 4; ++it) {
            const int hd = it >> 1, mt = it & 1, head = 2 * w + hd;
            const int t = t0 + 16 * mt + fr; const bool first = (t % S_) == 0;
            const bf16_t* prow = p.P + (size_t)t * NIN + 3072;
            const bf16_t* qrow = first ? prow : prow - NIN;
            f32x4 aw[4], aa[4], ag[4], av[4];
#pragma unroll
            for (int nt = 0; nt < 4; ++nt) { aw[nt] = (f32x4){0.f, 0.f, 0.f, 0.f}; aa[nt] = aw[nt]; ag[nt] = aw[nt]; av[nt] = aw[nt]; }
            bf16x8 af[9];
#pragma unroll
            for (int ks = 0; ks < 9; ++ks) af[ks] = *(const bf16x8*)(lds + (mt * 16 + fr) * LR_ROWB + ks * 64 + fq * 16);
            bf16x8 bq[3][9];
#define PR_LOADB(buf, nt_) do { const bf16_t* bp_ = LRT + (size_t)(head * 64 + ((nt_) >> 1) * 32 + 8 * (fr >> 2) + 4 * ((nt_) & 1) + (fr & 3)) * LR_K + fq * 8; \
                _Pragma("unroll") for (int ks_ = 0; ks_ < 9; ++ks_) bq[buf][ks_] = *(const bf16x8*)(bp_ + ks_ * 32); } while (0)
#define PR_MMA(buf, nt_) do { aw[nt_] = __builtin_amdgcn_mfma_f32_16x16x32_bf16(bq[buf][0], af[0], aw[nt_], 0, 0, 0); aw[nt_] = __builtin_amdgcn_mfma_f32_16x16x32_bf16(bq[buf][1], af[1], aw[nt_], 0, 0, 0); \
                aa[nt_] = __builtin_amdgcn_mfma_f32_16x16x32_bf16(bq[buf][2], af[2], aa[nt_], 0, 0, 0); aa[nt_] = __builtin_amdgcn_mfma_f32_16x16x32_bf16(bq[buf][3], af[3], aa[nt_], 0, 0, 0); \
                _Pragma("unroll") for (int ks_ = 4; ks_ < 8; ++ks_) ag[nt_] = __builtin_amdgcn_mfma_f32_16x16x32_bf16(bq[buf][ks_], af[ks_], ag[nt_], 0, 0, 0); \
                if (l > 0) av[nt_] = __builtin_amdgcn_mfma_f32_16x16x32_bf16(bq[buf][8], af[8], av[nt_], 0, 0, 0); } while (0)
            PR_LOADB(0, 0); PR_LOADB(1, 1); PR_LOADB(2, 2);
            __builtin_amdgcn_sched_barrier(0);
            PR_MMA(0, 0);
            __builtin_amdgcn_sched_barrier(0);
            PR_LOADB(0, 3);
            u32x4 raw[2][6];
#pragma unroll
            for (int pr = 0; pr < 2; ++pr) { const int c8 = head * 64 + pr * 32 + 8 * fq;
                raw[pr][0] = *(const u32x4*)(prow + c8); raw[pr][1] = *(const u32x4*)(prow + 1024 + c8); raw[pr][2] = *(const u32x4*)(prow + 2048 + c8);
                raw[pr][3] = *(const u32x4*)(qrow + c8); raw[pr][4] = *(const u32x4*)(qrow + 1024 + c8); raw[pr][5] = *(const u32x4*)(qrow + 2048 + c8); }
            __builtin_amdgcn_sched_barrier(0);
            PR_MMA(1, 1); PR_MMA(2, 2);
            __builtin_amdgcn_sched_barrier(0);
            PR_MMA(0, 3);
#undef PR_LOADB
#undef PR_MMA
            if (first) {
#pragma unroll
                for (int pr = 0; pr < 2; ++pr) { raw[pr][3] = (u32x4){0u, 0u, 0u, 0u}; raw[pr][4] = raw[pr][3]; raw[pr][5] = raw[pr][3]; } }
            f32x4 kkv[4], aav[4]; float ss = 0.f, bc = 0.f;
#pragma unroll
            for (int pr = 0; pr < 2; ++pr) {
                const int c8 = head * 64 + pr * 32 + 8 * fq; const size_t o8 = (size_t)t * RW + c8;
                const u32x4 cr = raw[pr][0], ck = raw[pr][1], cv = raw[pr][2], qr = raw[pr][3], qk = raw[pr][4], qv = raw[pr][5];
                u32x4 or_, ok_, ov_, og_;
#pragma unroll
                for (int n = 0; n < 2; ++n) {
                    const int nt = 2 * pr + n, c = c8 + 4 * n; const size_t o = (size_t)t * RW + c;
                    const unsigned crx = n ? cr.z : cr.x, cry = n ? cr.w : cr.y, ckx = n ? ck.z : ck.x, cky = n ? ck.w : ck.y, cvx = n ? cv.z : cv.x, cvy = n ? cv.w : cv.y;
                    const unsigned qrx = n ? qr.z : qr.x, qry = n ? qr.w : qr.y, qkx = n ? qk.z : qk.x, qky = n ? qk.w : qk.y, qvx = n ? qv.z : qv.x, qvy = n ? qv.w : qv.y;
                    const f32x4 mr = *(const f32x4*)(mu + c), mk = *(const f32x4*)(mu + 1024 + c), mv = *(const f32x4*)(mu + 2048 + c);
                    f32x4 rr, kx, vx;
                    rr[0] = bflo(crx) + (bflo(qrx) - bflo(crx)) * mr[0]; rr[1] = bfhi(crx) + (bfhi(qrx) - bfhi(crx)) * mr[1]; rr[2] = bflo(cry) + (bflo(qry) - bflo(cry)) * mr[2]; rr[3] = bfhi(cry) + (bfhi(qry) - bfhi(cry)) * mr[3];
                    kx[0] = bflo(ckx) + (bflo(qkx) - bflo(ckx)) * mk[0]; kx[1] = bfhi(ckx) + (bfhi(qkx) - bfhi(ckx)) * mk[1]; kx[2] = bflo(cky) + (bflo(qky) - bflo(cky)) * mk[2]; kx[3] = bfhi(cky) + (bfhi(qky) - bfhi(cky)) * mk[3];
                    vx[0] = bflo(cvx) + (bflo(qvx) - bflo(cvx)) * mv[0]; vx[1] = bfhi(cvx) + (bfhi(qvx) - bfhi(cvx)) * mv[1]; vx[2] = bflo(cvy) + (bflo(qvy) - bflo(cvy)) * mv[2]; vx[3] = bfhi(cvy) + (bfhi(qvy) - bfhi(cvy)) * mv[3];
                    const f32x4 w0v = *(const f32x4*)(p.w0 + l * RW + c), a0v = *(const f32x4*)(p.a0 + l * RW + c), kkw = *(const f32x4*)(p.k_k + l * RW + c), kaw = *(const f32x4*)(p.k_a + l * RW + c), rkw = *(const f32x4*)(p.r_k + l * RW + c);
                    f32x4 dec, av_, kh;
#pragma unroll
                    for (int j = 0; j < 4; ++j) { dec[j] = __expf(-sigmoidf_(w0v[j] + aw[nt][j]) * 0.60653066f); av_[j] = sigmoidf_(a0v[j] + aa[nt][j]); }
                    if (l == 0) *(f32x4*)(p.vfirst + o) = vx;
                    else { const f32x4 vf = *(const f32x4*)(p.vfirst + o), v0v = *(const f32x4*)(p.v0 + c);
#pragma unroll
                        for (int j = 0; j < 4; ++j) vx[j] = vx[j] + (vf[j] - vx[j]) * sigmoidf_(v0v[j] + av[nt][j]); }
#pragma unroll
                    for (int j = 0; j < 4; ++j) { const float kk = kx[j] * kkw[j]; kkv[nt][j] = kk; ss += kk * kk; kh[j] = kx[j] * (1.0f + (av_[j] - 1.0f) * kaw[j]); bc += rr[j] * kh[j] * rkw[j]; }
                    aav[nt] = av_;
                    *(f32x4*)(p.sw + o) = dec;
                    const unsigned r0 = cvt_pk_bf16(rr[0], rr[1]), r1 = cvt_pk_bf16(rr[2], rr[3]), k0_ = cvt_pk_bf16(kh[0], kh[1]), k1_ = cvt_pk_bf16(kh[2], kh[3]);
                    const unsigned v0_ = cvt_pk_bf16(vx[0], vx[1]), v1_ = cvt_pk_bf16(vx[2], vx[3]), g0_ = cvt_pk_bf16(ag[nt][0], ag[nt][1]), g1_ = cvt_pk_bf16(ag[nt][2], ag[nt][3]);
                    if (n == 0) { or_.x = r0; or_.y = r1; ok_.x = k0_; ok_.y = k1_; ov_.x = v0_; ov_.y = v1_; og_.x = g0_; og_.y = g1_; }
                    else { or_.z = r0; or_.w = r1; ok_.z = k0_; ok_.w = k1_; ov_.z = v0_; ov_.w = v1_; og_.z = g0_; og_.w = g1_; }
                }
                *(u32x4*)(p.hr + o8) = or_; *(u32x4*)(p.hk + o8) = ok_; *(u32x4*)(p.hv + o8) = ov_; *(u32x4*)(p.hg + o8) = og_;
            }
            ss += __shfl_xor(ss, 16); ss += __shfl_xor(ss, 32); bc += __shfl_xor(bc, 16); bc += __shfl_xor(bc, 32);
            const float rn = fminf(__builtin_amdgcn_rsqf(ss), 1e12f);
            if (fq == 0) p.bcoef[(size_t)t * 16 + head] = bc;
#pragma unroll
            for (int pr = 0; pr < 2; ++pr) { const size_t o8 = (size_t)t * RW + head * 64 + pr * 32 + 8 * fq;
                u32x4 oa, ob;
#pragma unroll
                for (int n = 0; n < 2; ++n) { const int nt = 2 * pr + n; f32x4 sa_, sb_;
#pragma unroll
                    for (int j = 0; j < 4; ++j) { const float kn = kkv[nt][j] * rn; sa_[j] = -kn; sb_[j] = kn * aav[nt][j]; }
                    const unsigned a0_ = cvt_pk_bf16(sa_[0], sa_[1]), a1_ = cvt_pk_bf16(sa_[2], sa_[3]), b0_ = cvt_pk_bf16(sb_[0], sb_[1]), b1_ = cvt_pk_bf16(sb_[2], sb_[3]);
                    if (n == 0) { oa.x = a0_; oa.y = a1_; ob.x = b0_; ob.y = b1_; } else { oa.z = a0_; oa.w = a1_; ob.z = b0_; ob.w = b1_; } }
                *(u32x4*)(p.ha + o8) = oa; *(u32x4*)(p.hb + o8) = ob; }
        }
        __syncthreads();
    }
}

__device__ __forceinline__ void phase_post(const Params& p, int l) {
    const int tid = tid_(), lane = tid & 63, w = tid >> 6;
    const float lam_init = (l == 0) ? 0.2f : 0.35550907f;
    float lam;
    { const float s1 = wave_sum(p.lam_q1[l * 64 + lane] * p.lam_k1[l * 64 + lane]), s2 = wave_sum(p.lam_q2[l * 64 + lane] * p.lam_k2[l * 64 + lane]); lam = __expf(s1) - __expf(s2) + lam_init; }
    const float* tmp = p.mixed;
    for (int t = bid_(); t < T_; t += nblk_()) {
        if (!USE_ATTN8) for (int h = w; h < 8; h += NTHR / 64) {
            const float* o0 = tmp + (size_t)t * D_ + h * 256 + lane * 2;
            const float x0 = o0[0] - lam * o0[128], x1 = o0[1] - lam * o0[129];
            const float ss = wave_sum(x0 * x0 + x1 * x1);
            const float rstd = rsqrtf(ss * (1.0f / 128.0f) + 1e-5f) * (1.0f - lam_init);
            const float* sg = p.subln_g + l * 128 + lane * 2;
            *(unsigned*)(p.ocat + (size_t)t * D_ + h * 128 + lane * 2) = cvt_pk_bf16(x0 * rstd * sg[0], x1 * rstd * sg[1]);
        }
        for (int h = w; h < 16; h += NTHR / 64) {
            const int cc = h * 64 + lane; const size_t o = (size_t)t * RW + cc;
            const float y = p.sy[o];
            const float mean = wave_sum(y) * (1.0f / 64.0f);
            const float d = y - mean;
            const float var = wave_sum(d * d) * (1.0f / 64.0f);
            const float yn = d * rsqrtf(var + 64e-5f) * p.lnx_w[l * RW + cc] + p.lnx_b[l * RW + cc];
            const float val = (yn + p.bcoef[(size_t)t * 16 + h] * bf2f(p.hv[o])) * bf2f(p.hg[o]);
            const float nb = __shfl_down(val, 1);
            if ((lane & 1) == 0) *(unsigned*)(p.ocat + (size_t)t * D_ + 1024 + cc) = cvt_pk_bf16(val, nb);
        }
    }
}

__device__ __forceinline__ void phase_post8(const Params& p, int l) {
    const int tid = tid_(), lane = tid & 63, l16 = lane & 15, rs = lane >> 4, gw = bid_() * NW_ + (tid >> 6), nw = nblk_() * NW_;
#pragma unroll 4
    for (int item = gw; item < T_ * 4; item += nw) {
        const int t = item >> 2, h = (item & 3) * 4 + rs, cc = h * 64 + l16 * 4; const size_t o = (size_t)t * RW + cc;
        const f32x4 y = *(const f32x4*)(p.sy + o);
        const u32x2 hv = *(const u32x2*)(p.hv + o), hg = *(const u32x2*)(p.hg + o);
        const float bc = p.bcoef[(size_t)t * 16 + h];
        const f32x4 lw = *(const f32x4*)(p.lnx_w + l * RW + cc), lb = *(const f32x4*)(p.lnx_b + l * RW + cc);
        const float mean = dpp_add16((y[0] + y[1]) + (y[2] + y[3])) * (1.0f / 64.0f);
        const f32x4 d = y - mean;
        const float var = dpp_add16((d[0] * d[0] + d[1] * d[1]) + (d[2] * d[2] + d[3] * d[3])) * (1.0f / 64.0f);
        const float rstd = rsqrtf(var + 64e-5f);
        const float v0 = ((d[0] * rstd * lw[0] + lb[0]) + bc * bflo(hv.x)) * bflo(hg.x), v1 = ((d[1] * rstd * lw[1] + lb[1]) + bc * bfhi(hv.x)) * bfhi(hg.x);
        const float v2 = ((d[2] * rstd * lw[2] + lb[2]) + bc * bflo(hv.y)) * bflo(hg.y), v3 = ((d[3] * rstd * lw[3] + lb[3]) + bc * bfhi(hv.y)) * bfhi(hg.y);
        u32x2 ov; ov.x = cvt_pk_bf16(v0, v1); ov.y = cvt_pk_bf16(v2, v3);
        *(u32x2*)(p.ocat + (size_t)t * D_ + 1024 + cc) = ov;
    }
}

__device__ __forceinline__ void phase_gemm_out(const Params& p, int l, unsigned char* lds) {
    const float* B = p.w_out + (size_t)l * D_ * D_;
    for (int unit = bid_(); unit < 64 * 16; unit += nblk_()) {
        const int mt = unit >> 4, nt = unit & 15;
        float* C = p.mixed;
        gemm_tile(lds, p.ocat, D_, [=](int r) { return mt * 128 + r; }, B + nt * 128 + (tid_() & 127), D_, D_,
                  [=](int m, int n, f32x4 v) { *(f32x4*)(C + (size_t)(mt * 128 + m) * D_ + nt * 128 + n) = v; });
    }
}

__device__ __forceinline__ void phase_res1_router(const Params& p, int l, unsigned char* lds) {
    const int tid = tid_(), lane = tid & 63, w = tid >> 6, gw = bid_() * (NTHR / 64) + w, nw = nblk_() * (NTHR / 64);
    float* hrow = (float*)lds + w * D_;
    const float* xin = (l == 0) ? p.x : p.out;
    const float* Wr = p.w_router + (size_t)l * D_ * NE;
    for (int t = gw; t < T_; t += nw) {
        const int b = t / S_;
        const float* md = p.mod + ((size_t)l * 4 + b) * 12288;
        f32x4 xv[8]; float ss = 0.f;
#pragma unroll
        for (int i = 0; i < 8; ++i) { const int e = i * 256 + lane * 4; const f32x4 mv = *(const f32x4*)(p.mixed + (size_t)t * D_ + e);
            ss += mv[0] * mv[0] + mv[1] * mv[1] + mv[2] * mv[2] + mv[3] * mv[3]; }
        ss = wave_sum(ss);
        const float rm = rsqrtf(ss * (1.0f / D_) + 1e-6f);
        float s2 = 0.f;
#pragma unroll
        for (int i = 0; i < 8; ++i) { const int e = i * 256 + lane * 4; const f32x4 gp = *(const f32x4*)(p.g_post_mix + l * D_ + e), ga = *(const f32x4*)(md + 4096 + e);
            const f32x4 mv = *(const f32x4*)(p.mixed + (size_t)t * D_ + e); xv[i] = *(const f32x4*)(xin + (size_t)t * D_ + e);
#pragma unroll
            for (int j = 0; j < 4; ++j) { xv[i][j] += ga[j] * (mv[j] * rm * gp[j]); s2 += xv[i][j] * xv[i][j]; }
            *(f32x4*)(p.out + (size_t)t * D_ + e) = xv[i]; }
        s2 = wave_sum(s2);
        const float rx = rsqrtf(s2 * (1.0f / D_) + 1e-6f);
        emit_hn(xv, rx, p.g_pre_ffn + l * D_, md + 8192, md + 6144, p.Hn + (size_t)t * D_, lane, hrow);
        __builtin_amdgcn_s_waitcnt(0);
        __builtin_amdgcn_wave_barrier();
        float lg = 0.f;
#pragma unroll 8
        for (int k = 0; k < D_; ++k) lg += hrow[k] * Wr[(size_t)k * NE + lane];
        const float score = sigmoidf_(lg), biased = score + p.router_bias[l * NE + lane];
        int rk = 0;
#pragma unroll
        for (int i = 0; i < 8; ++i) { const int src = (lane & ~7) + i; const float o = __shfl(biased, src); rk += (o > biased || (o == biased && src < lane)) ? 1 : 0; }
        float gs = (rk < 2) ? biased : 0.f;
        gs += __shfl_xor(gs, 1); gs += __shfl_xor(gs, 2); gs += __shfl_xor(gs, 4);
        int grk = 0; const int g = lane >> 3;
#pragma unroll
        for (int i = 0; i < 8; ++i) { const float o = RL(gs, i * 8); grk += (o > gs || (o == gs && i < g)) ? 1 : 0; }
        const bool gsel = grk < 4;
        const float mvv = gsel ? biased : -INFINITY;
        int erk = 0;
#pragma unroll
        for (int i = 0; i < 64; ++i) { const float o = RL(mvv, i); erk += (o > mvv || (o == mvv && i < lane)) ? 1 : 0; }
        const bool sel = gsel && erk < 8;
        const float gsum = wave_sum(sel ? score : 0.f);
        if (sel) {
            const float gate = score / gsum * 2.5f;
            const unsigned slot = atomicAdd(p.counts + (l * NE + lane) * 32, 1u);
            p.rowtok[lane * CAP + slot] = t; p.rowg[lane * CAP + slot] = gate; p.tokpos[(size_t)t * 8 + erk] = lane * CAP + (int)slot;
        }
        __builtin_amdgcn_wave_barrier();
    }
}

#define RT_ROWB 4112
__device__ __forceinline__ void phase_res1_router8(const Params& p, int l, unsigned char* lds) {
    const int tid = tid_(), lane = tid & 63, w = tid >> 6, fr = lane & 15, fq = lane >> 4;
    const float* xin = (l == 0) ? p.x : p.out;
    unsigned char* hiL = lds; unsigned char* loL = lds + 16 * RT_ROWB; float* part = (float*)lds;
    const bf16_t* Whi = p.WrT + (size_t)l * 2 * NE * D_; const bf16_t* Wlo = Whi + (size_t)NE * D_;
    int* selinfo = (int*)(lds + RSEL_OFF); int* lcount = selinfo + 4 * 128 * 3; int* lbase = lcount + NE;
    if (tid < NE) lcount[tid] = 0;
    int nsel = 0;
    __syncthreads();
    for (int unit = bid_(); unit < T_ / 16; unit += nblk_()) {
        const int b = (unit * 16) / S_;
        const float* md = p.mod + ((size_t)l * 4 + b) * 12288;
#pragma unroll 1
        for (int rr = 0; rr < 2; ++rr) {
            const int tl = w + 8 * rr, t = unit * 16 + tl;
            int e0 = lane * 4; asm volatile("" : "+v"(e0));
            f32x4 xv[8]; float ss = 0.f;
            u32x2 mq[8];
#pragma unroll
            for (int i = 0; i < 8; ++i) { const int e = i * 256 + e0; mq[i] = *(const u32x2*)((const bf16_t*)p.mixed + (size_t)t * D_ + e);
                const float m0 = bflo(mq[i].x), m1 = bfhi(mq[i].x), m2 = bflo(mq[i].y), m3 = bfhi(mq[i].y);
                ss += m0 * m0 + m1 * m1 + m2 * m2 + m3 * m3; }
            ss = wave_sum(ss);
            const float rm = rsqrtf(ss * (1.0f / D_) + 1e-6f);
            float s2 = 0.f;
#pragma unroll
            for (int i = 0; i < 8; ++i) { const int e = i * 256 + e0; const f32x4 gp = *(const f32x4*)(p.g_post_mix + l * D_ + e), ga = *(const f32x4*)(md + 4096 + e);
                const f32x4 mv = (f32x4){bflo(mq[i].x), bfhi(mq[i].x), bflo(mq[i].y), bfhi(mq[i].y)}; xv[i] = *(const f32x4*)(xin + (size_t)t * D_ + e);
#pragma unroll
                for (int j = 0; j < 4; ++j) { xv[i][j] += ga[j] * (mv[j] * rm * gp[j]); s2 += xv[i][j] * xv[i][j]; }
                *(f32x4*)(p.out + (size_t)t * D_ + e) = xv[i]; }
            s2 = wave_sum(s2);
            const float rx = rsqrtf(s2 * (1.0f / D_) + 1e-6f);
#pragma unroll
            for (int i = 0; i < 8; ++i) { const int e = i * 256 + e0;
                const f32x4 gv = *(const f32x4*)(p.g_pre_ffn + l * D_ + e), scv = *(const f32x4*)(md + 8192 + e), shv = *(const f32x4*)(md + 6144 + e);
                f32x4 h;
#pragma unroll
                for (int j = 0; j < 4; ++j) h[j] = xv[i][j] * rx * gv[j] * (1.0f + scv[j]) + shv[j];
                u32x2 hi; hi.x = cvt_pk_bf16(h[0], h[1]); hi.y = cvt_pk_bf16(h[2], h[3]);
                u32x2 lo; lo.x = cvt_pk_bf16(h[0] - bflo(hi.x), h[1] - bfhi(hi.x)); lo.y = cvt_pk_bf16(h[2] - bflo(hi.y), h[3] - bfhi(hi.y));
                *(u32x2*)(p.Hn + (size_t)t * D_ + e) = hi;
                *(u32x2*)(hiL + tl * RT_ROWB + e * 2) = hi; *(u32x2*)(loL + tl * RT_ROWB + e * 2) = lo; }
        }
        __syncthreads();
        f32x4 acc[4];
        {
#pragma unroll
            for (int nt = 0; nt < 4; ++nt) acc[nt] = (f32x4){0.f, 0.f, 0.f, 0.f};
            bf16x8 bh[2][4], bl[2][4];
            const bf16_t* wb = Whi + (size_t)fr * D_ + w * 256 + fq * 8; const bf16_t* wl = Wlo + (size_t)fr * D_ + w * 256 + fq * 8;
#pragma unroll
            for (int nt = 0; nt < 4; ++nt) { bh[0][nt] = *(const bf16x8*)(wb + (size_t)nt * 16 * D_); bl[0][nt] = *(const bf16x8*)(wl + (size_t)nt * 16 * D_); }
#pragma unroll
            for (int kk = 0; kk < 8; ++kk) {
                if (kk + 1 < 8) {
#pragma unroll
                    for (int nt = 0; nt < 4; ++nt) { bh[(kk + 1) & 1][nt] = *(const bf16x8*)(wb + (size_t)nt * 16 * D_ + (kk + 1) * 32); bl[(kk + 1) & 1][nt] = *(const bf16x8*)(wl + (size_t)nt * 16 * D_ + (kk + 1) * 32); } }
                const int ks = w * 8 + kk;
                const bf16x8 ahi = *(const bf16x8*)(hiL + fr * RT_ROWB + ks * 64 + fq * 16), alo = *(const bf16x8*)(loL + fr * RT_ROWB + ks * 64 + fq * 16);
#pragma unroll
                for (int nt = 0; nt < 4; ++nt) {
                    acc[nt] = __builtin_amdgcn_mfma_f32_16x16x32_bf16(bh[kk & 1][nt], ahi, acc[nt], 0, 0, 0);
                    acc[nt] = __builtin_amdgcn_mfma_f32_16x16x32_bf16(bh[kk & 1][nt], alo, acc[nt], 0, 0, 0);
                    acc[nt] = __builtin_amdgcn_mfma_f32_16x16x32_bf16(bl[kk & 1][nt], ahi, acc[nt], 0, 0, 0); } }
        }
        __syncthreads();
#pragma unroll
        for (int nt = 0; nt < 4; ++nt) *(f32x4*)(part + (w * 16 + fr) * 64 + nt * 16 + fq * 4) = acc[nt];
        __syncthreads();
#pragma unroll 1
        for (int rr = 0; rr < 2; ++rr) {
            const int tl = w + 8 * rr, t = unit * 16 + tl;
            float lg = 0.f;
#pragma unroll
            for (int ww = 0; ww < 8; ++ww) lg += part[(ww * 16 + tl) * 64 + lane];
            const float score = sigmoidf_(lg), biased = score + p.router_bias[l * NE + lane];
            int rk = 0;
#pragma unroll
            for (int i = 0; i < 8; ++i) { const int src = (lane & ~7) + i; const float o = __shfl(biased, src); rk += (o > biased || (o == biased && src < lane)) ? 1 : 0; }
            float gs = (rk < 2) ? biased : 0.f;
            gs += __shfl_xor(gs, 1); gs += __shfl_xor(gs, 2); gs += __shfl_xor(gs, 4);
            int grk = 0; const int g = lane >> 3;
#pragma unroll
            for (int i = 0; i < 8; ++i) { const float o = RL(gs, i * 8); grk += (o > gs || (o == gs && i < g)) ? 1 : 0; }
            const bool gsel = grk < 4;
            const float mvv = gsel ? biased : -INFINITY;
            int erk = 0;
#pragma unroll
            for (int i = 0; i < 64; ++i) { const float o = RL(mvv, i); erk += (o > mvv || (o == mvv && i < lane)) ? 1 : 0; }
            const bool sel = gsel && erk < 8;
            const float gsum = wave_sum(sel ? score : 0.f);
            if (sel) {
                const float gate = score / gsum * 2.5f;
                const int lrank = atomicAdd(lcount + lane, 1);
                int* si = selinfo + ((nsel * 16 + tl) * 8 + erk) * 3;
                si[0] = t; si[1] = (lane << 16) | lrank; si[2] = __float_as_int(gate);
            }
        }
        ++nsel;
        __syncthreads();
    }
    if (tid < NE) { const int c = lcount[tid]; lbase[tid] = c ? (int)atomicAdd(p.counts + (l * NE + tid) * 32, (unsigned)c) : 0; }
    __syncthreads();
    for (int i = tid; i < nsel * 128; i += NTHR) { const int* si = selinfo + i * 3; const int t = si[0], e = si[1] >> 16, slot = lbase[e] + (si[1] & 0xffff);
        p.rowtok[e * CAP + slot] = t; p.tokpos[(size_t)t * 8 + (i & 7)] = e * CAP + slot; p.tokgate[(size_t)t * 8 + (i & 7)] = __int_as_float(si[2]); }
    __syncthreads();
}

__device__ __forceinline__ void phase_moe_gu(const Params& p, int l, unsigned char* lds) {
    int* tab = (int*)(lds + TAB_OFF);
    build_tables(p, l, tab, 7);
    const int ntile = tab[160 + NE + 1];
    for (int unit = bid_(); unit < ntile * 8; unit += nblk_()) {
        const int rtg = unit >> 3, ct = unit & 7, e = find_expert(tab, rtg), rt = rtg - tab[160 + e], cnt = tab[e], pb = tab[80 + e];
        const float* Bg = (e < NE) ? p.w_eg + ((size_t)(l * NE + e) * D_) * 512 : p.w_sg + (size_t)l * D_ * 512;
        const float* Bu = (e < NE) ? p.w_eu + ((size_t)(l * NE + e) * D_) * 512 : p.w_su + (size_t)l * D_ * 512;
        const int n = tid_() & 127;
        const float* bp = ((n & 1) ? Bu : Bg) + ct * 64 + (n >> 1);
        const int* rtok = p.rowtok + e * CAP;
        bf16_t* H1 = p.H1;
        gemm_tile(lds, p.Hn, D_, [=](int r) { const int slot = rt * 128 + r; return (slot < cnt) ? ((e < NE) ? rtok[slot] : slot) : 0; }, bp, 512, D_,
                  [=](int m, int nn, f32x4 v) { const float h0 = v[0] / (1.0f + __expf(-v[0])) * v[1], h1 = v[2] / (1.0f + __expf(-v[2])) * v[3];
                      *(unsigned*)(H1 + (size_t)(pb + rt * 128 + m) * 512 + ct * 64 + (nn >> 1)) = cvt_pk_bf16(h0, h1); });
    }
}

__device__ __forceinline__ void phase_moe_down(const Params& p, int l, unsigned char* lds) {
    int* tab = (int*)(lds + TAB_OFF);
    build_tables(p, l, tab, 7);
    const int ntile = tab[160 + NE + 1];
    for (int unit = bid_(); unit < ntile * 16; unit += nblk_()) {
        const int rtg = unit >> 4, ct = unit & 15, e = find_expert(tab, rtg), rt = rtg - tab[160 + e], cnt = tab[e], pb = tab[80 + e];
        const float* Bd = (e < NE) ? p.w_ed + ((size_t)(l * NE + e) * 512) * D_ : p.w_sd + (size_t)l * 512 * D_;
        const float* rg = p.rowg + e * CAP;
        bf16_t* Y2 = p.Y2;
        gemm_tile(lds, p.H1, 512, [=](int r) { return pb + rt * 128 + r; }, Bd + ct * 128 + (tid_() & 127), D_, 512,
                  [=](int m, int nn, f32x4 v) { const int slot = rt * 128 + m; const float g = (slot < cnt) ? ((e < NE) ? rg[slot] : 1.0f) : 0.f;
                      u32x2 o; o.x = cvt_pk_bf16(v[0] * g, v[1] * g); o.y = cvt_pk_bf16(v[2] * g, v[3] * g);
                      *(u32x2*)(Y2 + (size_t)(pb + slot) * D_ + ct * 128 + nn) = o; });
    }
}

__device__ __forceinline__ void phase_combine(const Params& p, int l, unsigned char* lds) {
    typedef float f32x2c __attribute__((ext_vector_type(2)));
    int* tab = (int*)(lds + TAB_OFF);
    build_tables(p, l, tab, 8);
    const int lane = tid_() & 63, gw = bid_() * (NTHR / 64) + (tid_() >> 6), nw = nblk_() * (NTHR / 64);
    const unsigned char* Y2q = (const unsigned char*)p.Y2;
    for (int t = gw; t < T_; t += nw) {
        const int b = t / S_;
        const float* md = p.mod + ((size_t)l * 4 + b) * 12288;
        f32x4 yv[8];
        const unsigned char* yr[9]; float gk[9];
        { const u32x4 tp0 = *(const u32x4*)(p.tokpos + (size_t)t * 8), tp1 = *(const u32x4*)(p.tokpos + (size_t)t * 8 + 4);
          const f32x4 g0 = *(const f32x4*)(p.tokgate + (size_t)t * 8), g1 = *(const f32x4*)(p.tokgate + (size_t)t * 8 + 4);
#pragma unroll
          for (int k = 0; k < 4; ++k) { const int a = (int)tp0[k], bq = (int)tp1[k];
              yr[k] = Y2q + (size_t)(tab[80 + (a >> 13)] + (a & (CAP - 1))) * D_ + lane * 8; gk[k] = g0[k] * (1.0f / Y2_SCALE);
              yr[4 + k] = Y2q + (size_t)(tab[80 + (bq >> 13)] + (bq & (CAP - 1))) * D_ + lane * 8; gk[4 + k] = g1[k] * (1.0f / Y2_SCALE); }
          yr[8] = Y2q + (size_t)(tab[80 + NE] + t) * D_ + lane * 8; gk[8] = 1.0f / Y2_SCALE; }
        u32x2 u[9][4];
#pragma unroll
        for (int k = 0; k < 9; ++k)
#pragma unroll
            for (int i = 0; i < 4; ++i) u[k][i] = *(const u32x2*)(yr[k] + i * 512);
#pragma unroll
        for (int i = 0; i < 4; ++i) { f32x4 a0 = (f32x4){0.f, 0.f, 0.f, 0.f}, a1 = a0;
#pragma unroll
            for (int k = 0; k < 9; ++k) { const f32x2c x0 = __builtin_amdgcn_cvt_pk_f32_fp8((int)u[k][i].x, false), x1 = __builtin_amdgcn_cvt_pk_f32_fp8((int)u[k][i].x, true);
                const f32x2c x2 = __builtin_amdgcn_cvt_pk_f32_fp8((int)u[k][i].y, false), x3 = __builtin_amdgcn_cvt_pk_f32_fp8((int)u[k][i].y, true);
                a0[0] += gk[k] * x0.x; a0[1] += gk[k] * x0.y; a0[2] += gk[k] * x1.x; a0[3] += gk[k] * x1.y; a1[0] += gk[k] * x2.x; a1[1] += gk[k] * x2.y; a1[2] += gk[k] * x3.x; a1[3] += gk[k] * x3.y; }
            yv[2 * i] = a0; yv[2 * i + 1] = a1; }
        float ss = 0.f;
#pragma unroll
        for (int i = 0; i < 8; ++i) ss += yv[i][0] * yv[i][0] + yv[i][1] * yv[i][1] + yv[i][2] * yv[i][2] + yv[i][3] * yv[i][3];
        ss = wave_sum(ss);
        const float ry = rsqrtf(ss * (1.0f / D_) + 1e-6f);
        float s2 = 0.f;
#pragma unroll
        for (int i = 0; i < 8; ++i) { const int e = (i >> 1) * 512 + lane * 8 + (i & 1) * 4; const f32x4 xo = *(const f32x4*)(p.out + (size_t)t * D_ + e);
            const f32x4 gp = *(const f32x4*)(p.g_post_ffn + l * D_ + e), gf = *(const f32x4*)(md + 10240 + e);
#pragma unroll
            for (int j = 0; j < 4; ++j) { yv[i][j] = xo[j] + gf[j] * (yv[i][j] * ry * gp[j]); s2 += yv[i][j] * yv[i][j]; }
            *(f32x4*)(p.out + (size_t)t * D_ + e) = yv[i]; }
        if (l + 1 < 2) {
            s2 = wave_sum(s2);
            const float rx = rsqrtf(s2 * (1.0f / D_) + 1e-6f);
            const float* md1 = p.mod + ((size_t)(l + 1) * 4 + b) * 12288;
            const float* g = p.g_pre_mix + (l + 1) * D_;
#pragma unroll
            for (int i = 0; i < 8; ++i) { const int e = (i >> 1) * 512 + lane * 8 + (i & 1) * 4;
                const f32x4 gv = *(const f32x4*)(g + e), scv = *(const f32x4*)(md1 + 2048 + e), shv = *(const f32x4*)(md1 + e);
                f32x4 h;
#pragma unroll
                for (int j = 0; j < 4; ++j) h[j] = yv[i][j] * rx * gv[j] * (1.0f + scv[j]) + shv[j];
                u32x2 o; o.x = cvt_pk_bf16(h[0], h[1]); o.y = cvt_pk_bf16(h[2], h[3]);
                *(u32x2*)(p.Hn + (size_t)t * D_ + e) = o; }
        }
    }
}

#ifndef USE_SCAN8
#define USE_SCAN8 1
#endif
#ifndef USE_PREP8
#define USE_PREP8 1
#endif
#ifndef USE_ROUTER8
#define USE_ROUTER8 1
#endif
#ifndef USE8_IN
#define USE8_IN 1
#endif
#ifndef USE8_OUT
#define USE8_OUT 1
#endif
#ifndef USE8_GU
#define USE8_GU 1
#endif
#ifndef USE8_DOWN
#define USE8_DOWN 1
#endif
__global__ __launch_bounds__(NTHR, 2) void k_fwd(Params p) {
#define PP() (*(const Params*)((const char*)&p + launder0()))
    extern __shared__ __attribute__((aligned(16))) unsigned char lds[];
    volatile LAS unsigned* xbw = (volatile LAS unsigned*)(lds + LDS_BYTES);
    if (threadIdx.x == 0) { xbw[0] = 0u; xbw[1] = 0u; xbw[2] = 0u; xbw[3] = 0u; }
    __syncthreads();
    (void)xcd_barrier_post(p.bar, xbw);
#define GRIDBAR() do { XcdBarrier _b; _b.bar = PP().bar; _b.x = xb_xcc_id(); _b.st = (volatile LAS unsigned*)(lds + LDS_BYTES); xcd_barrier(_b); } while (0)
#ifndef TIME_PH
#define TIME_PH -1
#endif
    volatile unsigned long long* tsl = (volatile unsigned long long*)(lds + RSEL_OFF + 8192);
    int nst = 0;
#define STAMP() do { if (TIME_PH >= 0) { if (blockIdx.x == 0 && threadIdx.x == 0 && nst < 60) tsl[nst] = wall_clock64(); ++nst; } } while (0)
    STAMP();
#ifdef TIME_PRO
#define PROBAR() do { GRIDBAR(); STAMP(); } while (0)
#else
#define PROBAR() do { __syncthreads(); } while (0)
#endif
#ifndef REP_PRO
#define REP_PRO 1
#endif
#ifndef REP_GEMM
#define REP_GEMM 1
#endif
#ifndef REP_SCAN
#define REP_SCAN 1
#endif
#ifndef REP_POST
#define REP_POST 1
#endif
#ifndef REP_ATT
#define REP_ATT 1
#endif
#ifndef REP_MIX
#define REP_MIX 1
#endif
    for (int rep = 0; rep < REP_PRO; ++rep) {
    phase_adaln(PP(), lds);   PROBAR();
    phase_convert(PP(), lds); PROBAR();
    phase_cv_lrt(PP());       PROBAR();
    phase_cv_u(PP(), lds);    PROBAR();
    phase_cv_wrt(PP());
    GRIDBAR(); STAMP(); }
    phase_prenorm0(PP());
    GRIDBAR(); STAMP();
#pragma unroll 1
    for (int l = 0; l < 2; ++l) {
        for (int rep = 0; rep < REP_GEMM; ++rep) {
        if (USE8_IN) phase_gemm_in8(PP(), l, lds); else phase_gemm_in(PP(), l, lds);
        GRIDBAR(); STAMP(); }
        for (int rep = 0; rep < REP_MIX; ++rep) {
        for (int r2 = 0; r2 < REP_ATT; ++r2) { if (USE_ATTN8) phase_attn8(PP(), l, lds); else phase_attn_naive(PP()); }
        __syncthreads(); STAMP();
        if (USE_PREP8) phase_prep8(PP(), l, lds); else phase_rwkv_prep(PP(), l, lds);
        GRIDBAR(); STAMP();
        for (int r2 = 0; r2 < REP_SCAN; ++r2) { if (USE_SCAN8) phase_scan8(PP(), l, lds); else phase_scan_naive(PP());
        GRIDBAR(); STAMP(); }
        for (int r2 = 0; r2 < REP_POST; ++r2) { if (USE_ATTN8) phase_post8(PP(), l); else phase_post(PP(), l);
        GRIDBAR(); STAMP(); } }
        for (int rep = 0; rep < REP_GEMM; ++rep) {
        if (USE8_OUT) phase_gemm_out8(PP(), l, lds); else phase_gemm_out(PP(), l, lds);
        GRIDBAR(); STAMP(); }
        if (USE_ROUTER8) phase_res1_router8(PP(), l, lds); else phase_res1_router(PP(), l, lds);
        convert_leftovers(PP(), l, lds);
        GRIDBAR(); STAMP();
        for (int rep = 0; rep < REP_GEMM; ++rep) {
        if (USE8_GU) phase_moe_gu8(PP(), l, lds); else phase_moe_gu(PP(), l, lds);
        GRIDBAR(); STAMP(); }
        for (int rep = 0; rep < REP_GEMM; ++rep) {
        if (USE8_DOWN) phase_moe_down8(PP(), l, lds); else phase_moe_down(PP(), l, lds);
        GRIDBAR(); STAMP(); }
        phase_combine(PP(), l, lds);
        GRIDBAR(); STAMP();
    }
    if (TIME_PH >= 0 && blockIdx.x == 0 && threadIdx.x == 0) {
        const unsigned long long d = tsl[TIME_PH + 1] - tsl[TIME_PH], t0 = wall_clock64();
        const unsigned long long lim = (9ull * d < 5000000ull) ? 9ull * d : 5000000ull;
        while (wall_clock64() - t0 < lim) __builtin_amdgcn_s_sleep(8);
    }
}

extern "C" void kernel_launch(void* const* d_in, const int* in_sizes, int n_in, void* d_out, int out_size, void* d_ws, size_t ws_size, hipStream_t stream) {
    Params p{};
    const float* const* in = (const float* const*)d_in;
    p.x = in[0]; p.c = in[1]; p.w_ada = in[2]; p.b_ada = in[3]; p.g_pre_mix = in[4]; p.g_post_mix = in[5]; p.g_pre_ffn = in[6]; p.g_post_ffn = in[7]; p.w_in = in[8]; p.w_out = in[9];
    p.lam_q1 = in[10]; p.lam_k1 = in[11]; p.lam_q2 = in[12]; p.lam_k2 = in[13]; p.subln_g = in[14]; p.mu = in[15]; p.w0 = in[16]; p.w2 = in[17]; p.a0 = in[18]; p.a2 = in[19]; p.g2 = in[20];
    p.k_k = in[21]; p.k_a = in[22]; p.r_k = in[23]; p.lnx_w = in[24]; p.lnx_b = in[25]; p.v0 = in[26]; p.v1 = in[27]; p.v2 = in[28];
    p.w_router = in[29]; p.router_bias = in[30]; p.w_eg = in[31]; p.w_eu = in[32]; p.w_ed = in[33]; p.w_sg = in[34]; p.w_su = in[35]; p.w_sd = in[36];
    p.out = (float*)d_out;
    unsigned char* ws = (unsigned char*)d_ws; size_t off = 0;
    auto take = [&](size_t bytes) { void* r = ws + off; off += (bytes + 255) & ~(size_t)255; return r; };
    p.bar = (unsigned*)take(16384);
    p.counts = (unsigned*)take(2 * NE * 128);
    p.cvprog = (unsigned*)take(2 * 1024 * 4);
    p.mod = (float*)take((size_t)2 * 4 * 12288 * 4);
    p.Hn = (bf16_t*)take((size_t)T_ * D_ * 2);
    p.P = (bf16_t*)take((size_t)T_ * NIN * 2);
    p.sr = (float*)take((size_t)T_ * RW * 4); p.sw = (float*)take((size_t)T_ * RW * 4); p.sk = (float*)take((size_t)T_ * RW * 4); p.sv = (float*)take((size_t)T_ * RW * 4);
    p.sa = (float*)take((size_t)T_ * RW * 4); p.sb = (float*)take((size_t)T_ * RW * 4); p.sy = (float*)take((size_t)T_ * RW * 4); p.sg = (float*)take((size_t)T_ * RW * 4);
    p.vfirst = (float*)take((size_t)T_ * RW * 4);
    p.hr = (bf16_t*)p.sr; p.hk = (bf16_t*)p.sk; p.hv = (bf16_t*)p.sv; p.ha = (bf16_t*)p.sa; p.hb = (bf16_t*)p.sb; p.hg = (bf16_t*)p.sg;
    p.bcoef = (float*)take((size_t)T_ * 16 * 4);
    p.ocat = (bf16_t*)take((size_t)T_ * D_ * 2);
    p.mixed = (float*)take((size_t)T_ * D_ * 4);
    p.rowtok = (int*)take((size_t)NE * CAP * 4);
    p.rowg = (float*)take((size_t)NE * CAP * 4);
    p.tokpos = (int*)take((size_t)T_ * 8 * 4);
    p.tokgate = (float*)take((size_t)T_ * 8 * 4);
    p.H1 = (bf16_t*)take((size_t)PMAX * 512 * 2);
    p.Y2 = (bf16_t*)take((size_t)PMAX * D_ * 2);
    p.Vt = (bf16_t*)take((size_t)T_ * 1024 * 2);
    p.LRT = (bf16_t*)take((size_t)2 * 1024 * 288 * 2);
    p.WrT = (bf16_t*)take((size_t)2 * 2 * NE * D_ * 2);
    p.VV = (float*)take((size_t)T_ * 64 * 4);
    p.WinT = (bf16_t*)take((size_t)2 * NINX * D_ * 2);
    p.WoutT = (bf16_t*)take((size_t)2 * D_ * D_ * 2);
    p.WguT = (bf16_t*)take((size_t)2 * 65 * 1024 * D_ * 2);
    p.WdT = (bf16_t*)take((size_t)2 * 65 * D_ * 512 * 2);
    (void)hipMemsetAsync(p.bar, 0, (size_t)((unsigned char*)p.mod - (unsigned char*)p.bar), stream);
    static int grid = 0;
    if (!grid) {
        int dev = 0, cus = 0, per_cu = 0;
        (void)hipGetDevice(&dev);
        (void)hipDeviceGetAttribute(&cus, hipDeviceAttributeMultiprocessorCount, dev);
        (void)hipFuncSetAttribute((const void*)k_fwd, hipFuncAttributeMaxDynamicSharedMemorySize, LDS_BYTES + 16);
        (void)hipOccupancyMaxActiveBlocksPerMultiprocessor(&per_cu, k_fwd, NTHR, LDS_BYTES + 16);
        if (per_cu < 1) per_cu = 1;
        grid = cus;
    }
    k_fwd<<<grid, NTHR, LDS_BYTES + 16, stream>>>(p);
}
```

```cpp
#include <hip/hip_runtime.h>
#include <stdint.h>

typedef unsigned short bf16_t;
typedef short bf16x8 __attribute__((ext_vector_type(8)));
typedef float f32x4 __attribute__((ext_vector_type(4)));
typedef unsigned u32x4 __attribute__((ext_vector_type(4)));
typedef unsigned u32x2 __attribute__((ext_vector_type(2)));

#define T_    8192
#define D_    2048
#define S_    2048
#define NB_   4
#define NIN   6400
#define NINX  6656
#define RW    1024
#define NE    64
#define CAP   8192
#define PMAX  90112
#define USE_ATTN8 1
#define NTHR  512
#define NW_   (NTHR / 64)
#define TAB_OFF 131072
#define RSEL_OFF 133120
#define LDS_BYTES (133120 + 10240)

struct Params {
    const float *x, *c, *w_ada, *b_ada, *g_pre_mix, *g_post_mix, *g_pre_ffn, *g_post_ffn, *w_in, *w_out;
    const float *lam_q1, *lam_k1, *lam_q2, *lam_k2, *subln_g, *mu, *w0, *w2, *a0, *a2, *g2, *k_k, *k_a, *r_k, *lnx_w, *lnx_b, *v0, *v1, *v2;
    const float *w_router, *router_bias, *w_eg, *w_eu, *w_ed, *w_sg, *w_su, *w_sd;
    float* out;
    unsigned* bar;
    float* mod;
    bf16_t* Hn;
    bf16_t* P;
    float *sr, *sw, *sk, *sv, *sa, *sb, *sy, *sg, *vfirst;
    bf16_t *hr, *hk, *hv, *ha, *hb, *hg;
    float* bcoef;
    bf16_t* ocat;
    float* mixed;
    unsigned* counts;
    int* rowtok;
    float* rowg;
    int* tokpos;
    float* tokgate;
    bf16_t* H1;
    bf16_t* Y2;
    bf16_t* Vt;
    unsigned* cvprog;
    float* VV;
    bf16_t* WrT;
    bf16_t* LRT;
    bf16_t *WinT, *WoutT, *WguT, *WdT;
};

__device__ __forceinline__ float bf2f(unsigned short h) { return __uint_as_float(((unsigned)h) << 16); }
__device__ __forceinline__ unsigned cvt_pk_bf16(float lo, float hi) { unsigned r; asm volatile("v_cvt_pk_bf16_f32 %0, %1, %2" : "=v"(r) : "v"(lo), "v"(hi)); return r; }
__device__ __forceinline__ float bflo(unsigned u) { return __uint_as_float(u << 16); }
__device__ __forceinline__ float bfhi(unsigned u) { return __uint_as_float(u & 0xffff0000u); }
__device__ __forceinline__ float wave_sum(float v) {
#pragma unroll
    for (int o = 32; o > 0; o >>= 1) v += __shfl_xor(v, o);
    return v;
}
__device__ __forceinline__ float frcp_(float x) { return __builtin_amdgcn_rcpf(x); }
__device__ __forceinline__ float sigmoidf_(float x) { return frcp_(1.0f + __expf(-x)); }
__device__ __forceinline__ float tanhf_(float x) { return 1.0f - 2.0f * frcp_(1.0f + __expf(2.0f * x)); }
#define RL(v, j) __int_as_float(__builtin_amdgcn_readlane(__float_as_int(v), (j)))
__device__ __forceinline__ int launder0() { int z = 0; asm volatile("" : "+s"(z)); return z; }
__device__ __forceinline__ int tid_() { int z = 0; asm volatile("" : "+v"(z)); return (int)threadIdx.x + z; }
__device__ __forceinline__ int bid_() { return (int)blockIdx.x + launder0(); }
__device__ __forceinline__ int nblk_() { return (int)gridDim.x + launder0(); }
__device__ __forceinline__ int rfl(int v) { return __builtin_amdgcn_readfirstlane(v); }


#define XB_TMO      128
#define XB_XCNT(j)  (256  + 64 * (j))
#define XB_XSUB(j)  (1280 + 64 * (j))
#define XB_XGEN(j)  (2304 + 64 * (j))
#define XB_TOP      3328
#define XB_TOPGEN   3392
#define XCD_BAR_WORDS 3456
#define XB_SPIN_CAP (1u << 18)
#define LAS __attribute__((address_space(3)))
__device__ __forceinline__ unsigned xb_ld(unsigned* p)              { return __hip_atomic_load(p, __ATOMIC_RELAXED, __HIP_MEMORY_SCOPE_AGENT); }
__device__ __forceinline__ unsigned xb_add(unsigned* p, unsigned v) { return __hip_atomic_fetch_add(p, v, __ATOMIC_RELAXED, __HIP_MEMORY_SCOPE_AGENT); }
__device__ __forceinline__ unsigned xb_xcc_id() { return (unsigned)__builtin_amdgcn_s_getreg((3 << 11) | 20) & 0xFu; }
#define XB_SPIN(cond, bar) do { unsigned _sp = 0; while (cond) { __builtin_amdgcn_s_sleep(1); \
    if ((++_sp & 255u) == 0u) { if (xb_ld(&(bar)[XB_TMO])) break; if (_sp > XB_SPIN_CAP) { atomicAdd(&(bar)[XB_TMO], 1u); break; } } } } while (0)
struct XcdBarrier { unsigned* bar; unsigned x; volatile LAS unsigned* st; };
__device__ __forceinline__ XcdBarrier xcd_barrier_post(unsigned* bar, volatile LAS unsigned* st) {
    XcdBarrier b; b.bar = bar; b.x = xb_xcc_id(); b.st = st;
    if (threadIdx.x == 0) (void)xb_add(&bar[XB_XCNT(b.x)], 1u);
    return b;
}
__device__ __forceinline__ void xcd_barrier_complete(unsigned* bar, unsigned x, unsigned& nloc, unsigned& nx) {
    const unsigned G = gridDim.x * gridDim.y * gridDim.z;
    unsigned sum, cnt, mine, sp = 0u;
    for (;;) {
        sum = 0u; cnt = 0u; mine = 0u;
#pragma unroll
        for (unsigned j = 0; j < 16; ++j) { const unsigned c = xb_ld(&bar[XB_XCNT(j)]); sum += c; cnt += (c > 0u) ? 1u : 0u; mine = (j == x) ? c : mine; }
        if (sum == G) break;
        __builtin_amdgcn_s_sleep(1);
        if ((++sp & 255u) == 0u) { if (xb_ld(&bar[XB_TMO])) break; if (sp > XB_SPIN_CAP) { atomicAdd(&bar[XB_TMO], 1u); break; } }
    }
    nloc = mine > 0u ? mine : 1u; nx = cnt > 0u ? cnt : 1u;
}
__device__ __forceinline__ void xcd_barrier(const XcdBarrier& b) {
    asm volatile("s_waitcnt vmcnt(0)" ::: "memory");
    __syncthreads();
    if (threadIdx.x == 0) {
        unsigned* bar = b.bar;
        __builtin_amdgcn_s_waitcnt(0);
        unsigned nloc = b.st[0], nx = b.st[1];
        if (nloc == 0u) { xcd_barrier_complete(bar, b.x, nloc, nx); b.st[0] = nloc; b.st[1] = nx; }
        const unsigned old = xb_add(&bar[XB_XSUB(b.x)], 1u);
        const unsigned gen = old / nloc;
        if (old + 1u == (gen + 1u) * nloc) {
            __builtin_amdgcn_fence(__ATOMIC_RELEASE, "agent");
            asm volatile("s_waitcnt vmcnt(0)" ::: "memory");
            const unsigned og = xb_add(&bar[XB_TOP], 1u);
            const unsigned tg = og / nx;
            if (og + 1u == (tg + 1u) * nx) xb_add(&bar[XB_TOPGEN], 1u);
            else XB_SPIN(xb_ld(&bar[XB_TOPGEN]) == tg, bar);
            __builtin_amdgcn_fence(__ATOMIC_ACQUIRE, "agent");
            xb_add(&bar[XB_XGEN(b.x)], 1u);
            asm volatile("s_waitcnt vmcnt(0)" ::: "memory");
        } else {
            XB_SPIN(xb_ld(&bar[XB_XGEN(b.x)]) == gen, bar);
            __builtin_amdgcn_fence(__ATOMIC_ACQUIRE, "agent");
            asm volatile("s_waitcnt vmcnt(0)" ::: "memory");
        }
    }
    __syncthreads();
}

#define GT_ROWB 144
template <class ARow, class Epi>
__device__ __forceinline__ void gemm_tile(unsigned char* lds, const bf16_t* A, int lda, ARow arow, const float* bp, int ldb, int K, Epi epi) {
    const int tid = tid_(), lane = tid & 63, wid = tid >> 6, wm = wid >> 1, wn = wid & 1, fr = lane & 15, fq = lane >> 4;
    if (tid >= 256) { for (int i = 0; i < 2 * (K >> 6) + 1; ++i) __syncthreads(); return; }
    unsigned char* sA = lds;
    unsigned char* sB = lds + 128 * GT_ROWB;
    const bf16_t* ap[4];
    int aoff[4];
#pragma unroll
    for (int i = 0; i < 4; ++i) { const int ch = tid + i * 256, r = ch >> 3, kc = ch & 7; ap[i] = A + (size_t)arow(r) * lda + kc * 8; aoff[i] = r * GT_ROWB + kc * 16; }
    const int bn = tid & 127, bkh = tid >> 7;
    const float* bq = bp + (size_t)(bkh * 32) * ldb;
    const int boff = bn * GT_ROWB + bkh * 64;
    f32x4 acc[4][4];
#pragma unroll
    for (int i = 0; i < 4; ++i)
#pragma unroll
        for (int j = 0; j < 4; ++j) acc[i][j] = (f32x4){0.f, 0.f, 0.f, 0.f};
    u32x4 ra[4]; float rb[32];
    const int nk = K >> 6;
#pragma unroll
    for (int i = 0; i < 4; ++i) ra[i] = *(const u32x4*)(ap[i]);
#pragma unroll
    for (int i = 0; i < 32; ++i) rb[i] = bq[(size_t)i * ldb];
    for (int kt = 0; kt < nk; ++kt) {
        __syncthreads();
#pragma unroll
        for (int i = 0; i < 4; ++i) *(u32x4*)(sA + aoff[i]) = ra[i];
#pragma unroll
        for (int g = 0; g < 4; ++g) { u32x4 w; w.x = cvt_pk_bf16(rb[g * 8 + 0], rb[g * 8 + 1]); w.y = cvt_pk_bf16(rb[g * 8 + 2], rb[g * 8 + 3]); w.z = cvt_pk_bf16(rb[g * 8 + 4], rb[g * 8 + 5]); w.w = cvt_pk_bf16(rb[g * 8 + 6], rb[g * 8 + 7]);
            *(u32x4*)(sB + boff + g * 16) = w; }
        __syncthreads();
        if (kt + 1 < nk) {
#pragma unroll
            for (int i = 0; i < 4; ++i) ra[i] = *(const u32x4*)(ap[i] + (size_t)(kt + 1) * 64);
            const float* bqq = bq + (size_t)(kt + 1) * 64 * ldb;
#pragma unroll
            for (int i = 0; i < 32; ++i) rb[i] = bqq[(size_t)i * ldb];
        }
#pragma unroll
        for (int ks = 0; ks < 2; ++ks) {
            bf16x8 af[4], bfr[4];
#pragma unroll
            for (int i = 0; i < 4; ++i) af[i] = *(const bf16x8*)(sA + (wm * 64 + i * 16 + fr) * GT_ROWB + ks * 64 + fq * 16);
#pragma unroll
            for (int j = 0; j < 4; ++j) bfr[j] = *(const bf16x8*)(sB + (wn * 64 + j * 16 + fr) * GT_ROWB + ks * 64 + fq * 16);
#pragma unroll
            for (int i = 0; i < 4; ++i)
#pragma unroll
                for (int j = 0; j < 4; ++j) acc[i][j] = __builtin_amdgcn_mfma_f32_16x16x32_bf16(bfr[j], af[i], acc[i][j], 0, 0, 0);
        }
    }
#pragma unroll
    for (int i = 0; i < 4; ++i)
#pragma unroll
        for (int j = 0; j < 4; ++j) epi(wm * 64 + i * 16 + fr, wn * 64 + j * 16 + fq * 4, acc[i][j]);
    __syncthreads();
}

#ifndef GP_SP2
#define GP_SP2 true
#endif
#ifndef GP_ALIGN
#define GP_ALIGN true
#endif
namespace gp {
constexpr int BM = 256, BK = 64, HALF = 128, HTB = HALF * BK * 2, STAGE_BYTES = 8 * HTB;
__device__ __forceinline__ int lds_byte(int r, int c) { const int st = (r >> 4) * 2 + (c >> 5), rr = r & 15, cc = c & 31, ob = rr * 64 + cc * 2; return st * 1024 + (ob ^ (((ob >> 9) & 1) << 5)); }
__device__ __forceinline__ void stage_rc(int b, int& R, int& C) { const int st = b / 1024, sb = b % 1024, swz = sb ^ (((sb >> 9) & 1) << 5); R = (st >> 1) * 16 + swz / 64; C = (st & 1) * 32 + (swz % 64) / 2; }
__device__ __forceinline__ int perm32(int rho) { const int n = rho >> 4, i = rho & 15; return 8 * (i >> 2) + 4 * n + (i & 3); }
struct Unit { int pm, pn, e; };
typedef f32x4 Acc[2][2][4][2];

template <bool GATHER, int PERM  , bool SP2, bool ALIGN_EPI, class Sched, class Epi>
__device__ __forceinline__ void gemm_phase(LAS unsigned char* lds, const int K, const Sched& S, const Epi& E) {
    const int tid = tid_(), wid = rfl(tid >> 6), lane = tid & 63, wr = wid >> 2, wc = wid & 3, fr = lane & 15, fq = lane >> 4;
    const int nt = K / BK;
    int Rr[2], Cc[2]; unsigned voffB[2], voffB1[2];
#pragma unroll
    for (int i = 0; i < 2; ++i) { int R, C; stage_rc(tid * 16 + i * 8192, R, C); Rr[i] = R; Cc[i] = C;
        if (PERM == 2) { const int wcs = R >> 5, nn = (R >> 4) & 1, ii = R & 15, cb = 64 * wcs + 16 * (ii >> 2) + 4 * nn + (ii & 3);
            voffB[i] = (unsigned)(cb * K + C) * 2u; voffB1[i] = (unsigned)((cb + 8) * K + C) * 2u; }
        else { const int Rb = (PERM == 1) ? ((R & ~31) + perm32(R & 31)) : R; voffB[i] = (unsigned)(Rb * K + C) * 2u; voffB1[i] = voffB[i]; } }
    const size_t hstepB = (PERM == 2) ? 0 : (size_t)HALF * K * 2;
    const size_t kstep = (size_t)(BK * 2);
    const size_t hstep = (size_t)HALF * K * 2;
    const unsigned ldsw = (unsigned)wid * 1024u;
    const int aoff = lds_byte(wr * 64 + fr, fq * 8), boff = lds_byte(wc * 32 + fr, fq * 8);
#define GP_SA(b, h) (((b) * 2 + (h)) * HTB)
#define GP_SB(b, h) ((4 + (b) * 2 + (h)) * HTB)
#define GP_STAGE(bufoff, gbase, voff) do { _Pragma("unroll") for (int _i = 0; _i < 2; ++_i) \
        __builtin_amdgcn_global_load_lds((const unsigned*)((const char*)(gbase) + (voff)[_i]), (LAS unsigned*)(lds + (bufoff) + ldsw + _i * 8192), 16, 0, 0); } while (0)
#define GP_LDA(dst, b, h) do { _Pragma("unroll") for (int m = 0; m < 4; ++m) _Pragma("unroll") for (int k = 0; k < 2; ++k) dst[m][k] = *(const LAS bf16x8*)(lds + GP_SA(b, h) + aoff + m * 2048 + k * 1024); } while (0)
#define GP_LDB(dst, b, h) do { _Pragma("unroll") for (int n = 0; n < 2; ++n) _Pragma("unroll") for (int k = 0; k < 2; ++k) dst[n][k] = *(const LAS bf16x8*)(lds + GP_SB(b, h) + boff + n * 2048 + k * 1024); } while (0)
#define GP_MMA(ai, bj, At, Bt) do { __builtin_amdgcn_s_setprio(1); _Pragma("unroll") for (int m = 0; m < 4; ++m) _Pragma("unroll") for (int n = 0; n < 2; ++n) _Pragma("unroll") for (int k = 0; k < 2; ++k) \
        acc[ai][bj][m][n] = __builtin_amdgcn_mfma_f32_16x16x32_bf16(Bt[n][k], At[m][k], acc[ai][bj][m][n], 0, 0, 0); __builtin_amdgcn_s_setprio(0); } while (0)
#define GP_WAIT_V(n) asm volatile("s_waitcnt vmcnt(" #n ")" ::: "memory")
#define GP_WAIT_L(n) asm volatile("s_waitcnt lgkmcnt(" #n ")" ::: "memory")
#define GP_BAR __builtin_amdgcn_s_barrier()
#define GP_SCHED __builtin_amdgcn_sched_barrier(0)
#define GP_VOFF(u, v) do { _Pragma("unroll") for (int _h = 0; _h < 2; ++_h) _Pragma("unroll") for (int _i = 0; _i < 2; ++_i) { \
        const int _row = GATHER ? S.a_row(u, _h * 128 + Rr[_i]) : (_h * 128 + Rr[_i]); v[_h][_i] = (unsigned)(_row * K + Cc[_i]) * 2u; } } while (0)
    Unit cur, nxt; int ui = 0;
    if (!S.next(0, cur)) return;
    Acc acc;
#pragma unroll
    for (int a = 0; a < 2; ++a)
#pragma unroll
        for (int b = 0; b < 2; ++b)
#pragma unroll
            for (int m = 0; m < 4; ++m)
#pragma unroll
                for (int n = 0; n < 2; ++n) acc[a][b][m][n] = (f32x4){0.f, 0.f, 0.f, 0.f};
    bf16x8 At[4][2], B0[2][2], B1[2][2];
    unsigned vA[2][2], vAn[2][2];
    const char* cA = S.a_base(cur); const char* cB = S.b_base(cur);
    GP_VOFF(cur, vA);
    if constexpr (SP2) {
        GP_STAGE(GP_SB(0, 0), cB, voffB); GP_STAGE(GP_SB(0, 1), cB + hstepB, voffB1); GP_STAGE(GP_SA(0, 0), cA, vA[0]); GP_STAGE(GP_SA(0, 1), cA, vA[1]);
        if (wr == 1) GP_BAR;
        GP_WAIT_V(2); GP_BAR;
        GP_STAGE(GP_SB(1, 0), cB + kstep, voffB); GP_STAGE(GP_SA(1, 0), cA + kstep, vA[0]); GP_STAGE(GP_SB(1, 1), cB + hstepB + kstep, voffB1);
        GP_WAIT_V(6); GP_BAR;
    } else {
        GP_STAGE(GP_SB(0, 0), cB, voffB); GP_STAGE(GP_SA(0, 0), cA, vA[0]); GP_STAGE(GP_SB(0, 1), cB + hstepB, voffB1); GP_STAGE(GP_SA(0, 1), cA, vA[1]);
        if (wr == 1) GP_BAR;
        GP_WAIT_V(4); GP_BAR;
        GP_STAGE(GP_SB(1, 0), cB + kstep, voffB); GP_STAGE(GP_SA(1, 0), cA + kstep, vA[0]); GP_STAGE(GP_SB(1, 1), cB + hstepB + kstep, voffB1);
        GP_WAIT_V(6); GP_BAR;
    }
    for (;;) {
        const bool has_next = S.next(ui + 1, nxt);
        const char* nA = has_next ? S.a_base(nxt) : cA; const char* nB = has_next ? S.b_base(nxt) : cB;
        if (GATHER) { if (has_next) { GP_VOFF(nxt, vAn); } else { vAn[0][0] = vA[0][0]; vAn[0][1] = vA[0][1]; vAn[1][0] = vA[1][0]; vAn[1][1] = vA[1][1]; } }
        for (int t = 0; t < nt; t += 2) {
            const bool last = (t == nt - 2);
            const char* a1 = cA + (size_t)(t + 1) * kstep;
            const char* a2 = last ? nA : cA + (size_t)(t + 2) * kstep; const char* b2 = last ? nB : cB + (size_t)(t + 2) * kstep;
            const char* a3 = a2 + kstep; const char* b3 = b2 + kstep;
            unsigned v2[2][2];
#pragma unroll
            for (int h = 0; h < 2; ++h)
#pragma unroll
                for (int i = 0; i < 2; ++i) v2[h][i] = (GATHER && last) ? vAn[h][i] : vA[h][i];
            if constexpr (SP2) {
            GP_LDB(B0, 0, 0); GP_LDB(B1, 0, 1); GP_SCHED; GP_LDA(At, 0, 0); GP_STAGE(GP_SA(1, 1), a1, vA[1]);
            GP_WAIT_V(8); GP_WAIT_L(0); GP_BAR; GP_MMA(0, 0, At, B0); GP_MMA(0, 1, At, B1); GP_BAR; GP_SCHED;
            GP_LDA(At, 0, 1); GP_STAGE(GP_SB(0, 0), b2, voffB); GP_STAGE(GP_SB(0, 1), b2 + hstepB, voffB1); GP_STAGE(GP_SA(0, 0), a2, v2[0]);
            GP_WAIT_V(8); GP_WAIT_L(0); GP_BAR; GP_MMA(1, 0, At, B0); GP_MMA(1, 1, At, B1); GP_BAR; GP_SCHED;
            GP_LDB(B0, 1, 0); GP_LDB(B1, 1, 1); GP_SCHED; GP_LDA(At, 1, 0); GP_STAGE(GP_SA(0, 1), a2, v2[1]);
            GP_WAIT_V(8); GP_WAIT_L(0); GP_BAR; GP_MMA(0, 0, At, B0); GP_MMA(0, 1, At, B1); GP_BAR; GP_SCHED;
            GP_LDA(At, 1, 1); GP_STAGE(GP_SB(1, 0), b3, voffB); GP_STAGE(GP_SB(1, 1), b3 + hstepB, voffB1); GP_STAGE(GP_SA(1, 0), a3, v2[0]);
            GP_WAIT_V(8); GP_WAIT_L(0); GP_BAR; GP_MMA(1, 0, At, B0); GP_MMA(1, 1, At, B1); GP_BAR; GP_SCHED;
            } else {
            GP_LDB(B0, 0, 0); GP_SCHED; GP_LDA(At, 0, 0); GP_STAGE(GP_SA(1, 1), a1, vA[1]);
            GP_WAIT_L(8); GP_BAR; GP_WAIT_L(0); GP_MMA(0, 0, At, B0); GP_BAR; GP_SCHED;
            GP_LDB(B1, 0, 1); GP_STAGE(GP_SB(0, 0), b2, voffB);
            GP_BAR; GP_WAIT_L(0); GP_MMA(0, 1, At, B1); GP_BAR;
            GP_LDA(At, 0, 1); GP_STAGE(GP_SA(0, 0), a2, v2[0]);
            GP_BAR; GP_WAIT_L(0); GP_MMA(1, 0, At, B0); GP_BAR; GP_SCHED;
            GP_STAGE(GP_SB(0, 1), b2 + hstepB, voffB1);
            GP_WAIT_V(6); GP_BAR; GP_MMA(1, 1, At, B1); GP_BAR;
            GP_LDB(B0, 1, 0); GP_SCHED; GP_LDA(At, 1, 0); GP_STAGE(GP_SA(0, 1), a2, v2[1]);
            GP_WAIT_L(8); GP_BAR; GP_WAIT_L(0); GP_MMA(0, 0, At, B0); GP_BAR; GP_SCHED;
            GP_LDB(B1, 1, 1); GP_STAGE(GP_SB(1, 0), b3, voffB);
            GP_BAR; GP_WAIT_L(0); GP_MMA(0, 1, At, B1); GP_BAR;
            GP_LDA(At, 1, 1); GP_STAGE(GP_SA(1, 0), a3, v2[0]);
            GP_BAR; GP_WAIT_L(0); GP_MMA(1, 0, At, B0); GP_BAR; GP_SCHED;
            GP_STAGE(GP_SB(1, 1), b3 + hstepB, voffB1);
            GP_WAIT_V(6); GP_BAR; GP_MMA(1, 1, At, B1); GP_BAR;
            }
        }
        if constexpr (ALIGN_EPI) { if (wr == 0) GP_BAR; }
        E(acc, cur, wr, wc, fr, fq);
        if (!has_next) break;
#pragma unroll
        for (int a = 0; a < 2; ++a)
#pragma unroll
            for (int b = 0; b < 2; ++b)
#pragma unroll
                for (int m = 0; m < 4; ++m)
#pragma unroll
                    for (int n = 0; n < 2; ++n) acc[a][b][m][n] = (f32x4){0.f, 0.f, 0.f, 0.f};
        cur = nxt; cA = nA; cB = nB; ++ui;
        if (GATHER) { vA[0][0] = vAn[0][0]; vA[0][1] = vAn[0][1]; vA[1][0] = vAn[1][0]; vA[1][1] = vAn[1][1]; }
        if constexpr (ALIGN_EPI) { if (wr == 1) GP_BAR; }
    }
    GP_WAIT_V(0);
    if constexpr (!ALIGN_EPI) { if (wr == 0) GP_BAR; }
    GP_BAR;
#undef GP_SA
#undef GP_SB
#undef GP_STAGE
#undef GP_LDA
#undef GP_LDB
#undef GP_MMA
#undef GP_WAIT_V
#undef GP_WAIT_L
#undef GP_BAR
#undef GP_SCHED
#undef GP_VOFF
}

struct DenseSched {
    const bf16_t* A; const bf16_t* Bt; int K, nM, nN, nwg, G, c;
    __device__ __forceinline__ void init(const bf16_t* A_, const bf16_t* Bt_, int M, int N, int K_, int G_, int c_) { A = A_; Bt = Bt_; K = K_; nM = M / BM; nN = N / BM; nwg = nM * nN; G = G_; c = c_; }
    __device__ __forceinline__ bool next(int i, Unit& u) const {
        const long L = (long)i * G + c; if (L >= nwg) return false;
        int wgid = (int)L; { const int q = nwg / 8, r = nwg % 8, xcd = wgid % 8, off = wgid / 8; wgid = (xcd < r ? xcd * (q + 1) : r * (q + 1) + (xcd - r) * q) + off; }
        const int nig = 8 * nN, gid = wgid / nig, fm = gid * 8, gsz = (nM - fm) < 8 ? (nM - fm) : 8;
        u.pm = fm + ((wgid % nig) % gsz); u.pn = (wgid % nig) / gsz; u.e = 0; return true;
    }
    __device__ __forceinline__ const char* a_base(const Unit& u) const { return (const char*)A + (size_t)u.pm * BM * K * 2; }
    __device__ __forceinline__ const char* b_base(const Unit& u) const { return (const char*)Bt + (size_t)u.pn * BM * K * 2; }
    __device__ __forceinline__ int a_row(const Unit&, int r) const { return r; }
};
}

struct CvDesc { const float* src; bf16_t* dst; int N, K; };
#define CV_I_IN  (32 * 100)
#define CV_I_OUT (32 * 32)
#define CV_I_GU  (32 * 8)
#define CV_I_D   (8 * 32)
#define CV_PER_L (CV_I_IN + CV_I_OUT + 65 * 2 * CV_I_GU + 65 * CV_I_D)
#define CV_TOTAL (2 * CV_PER_L)
#define CV_PRO   (CV_I_IN + CV_I_OUT)
__device__ __forceinline__ void cv_decode(const Params& p, int it0, int lane, CvDesc& d, int& rowmul) {
    const int l = it0 / CV_PER_L; int r = it0 - l * CV_PER_L;
    const float* W; bf16_t* Wt; int N, K, gu = 0; rowmul = 1;
    if (r < CV_I_IN) { W = p.w_in + (size_t)l * D_ * NIN; N = NIN; K = D_; Wt = p.WinT + (size_t)l * NINX * D_; }
    else if ((r -= CV_I_IN) < CV_I_OUT) { W = p.w_out + (size_t)l * D_ * D_; N = D_; K = D_; Wt = p.WoutT + (size_t)l * D_ * D_; }
    else if ((r -= CV_I_OUT) < 65 * 2 * CV_I_GU) { const int e = r / (2 * CV_I_GU), rr = r - e * 2 * CV_I_GU, which = rr / CV_I_GU; r = rr - which * CV_I_GU;
        W = (e < NE) ? ((which ? p.w_eu : p.w_eg) + (size_t)(l * NE + e) * D_ * 512) : ((which ? p.w_su : p.w_sg) + (size_t)l * D_ * 512);
        N = 512; K = D_; Wt = p.WguT + (size_t)(l * 65 + e) * 1024 * D_; gu = 1 + which; }
    else { r -= 65 * 2 * CV_I_GU; const int e = r / CV_I_D; r -= e * CV_I_D;
        W = (e < NE) ? (p.w_ed + (size_t)(l * NE + e) * 512 * D_) : (p.w_sd + (size_t)l * 512 * D_); N = D_; K = 512; Wt = p.WdT + (size_t)(l * 65 + e) * D_ * 512; }
    const int nkt = K >> 6, ntile = r / nkt, kt = r - ntile * nkt, k0 = kt * 64, n0 = ntile * 64;
    const int drow = gu ? ((n0 >> 7) * 256 + (gu - 1) * 128 + (n0 & 127)) : n0;
    d.src = W + (size_t)k0 * N + n0; d.dst = Wt + (size_t)drow * K + k0; d.N = N; d.K = K;
}
__device__ __forceinline__ void cv_load(const CvDesc& d, float (&v)[64], int lane) {
#pragma unroll
    for (int k = 0; k < 64; ++k) v[k] = d.src[(size_t)(k * d.N) + lane];
}
__device__ __forceinline__ void cv_store(const CvDesc& d, int rowmul, const float (&v)[64], unsigned char* scr, int lane) {
#pragma unroll
    for (int g = 0; g < 8; ++g) { u32x4 w; w.x = cvt_pk_bf16(v[g * 8 + 0], v[g * 8 + 1]); w.y = cvt_pk_bf16(v[g * 8 + 2], v[g * 8 + 3]); w.z = cvt_pk_bf16(v[g * 8 + 4], v[g * 8 + 5]); w.w = cvt_pk_bf16(v[g * 8 + 6], v[g * 8 + 7]);
        *(u32x4*)(scr + lane * 144 + g * 16) = w; }
    asm volatile("s_waitcnt lgkmcnt(0)" ::: "memory"); __builtin_amdgcn_wave_barrier();
#pragma unroll
    for (int j = 0; j < 8; ++j) { const int n = (lane >> 3) + 8 * j, kc = lane & 7; const u32x4 w = *(const u32x4*)(scr + n * 144 + kc * 16);
        *(u32x4*)(d.dst + (size_t)(n * rowmul) * d.K + kc * 8) = w; }
    __builtin_amdgcn_wave_barrier();
}
__device__ __forceinline__ void convert_one(const Params& p, int it0, unsigned char* scr, int lane) {
    CvDesc d; int rm; cv_decode(p, it0, lane, d, rm);
    float v[64]; cv_load(d, v, lane); cv_store(d, rm, v, scr, lane);
}
__device__ __forceinline__ unsigned cv_ld_stop(volatile unsigned* q) { return *q; }
__device__ __forceinline__ int convert_stream(const Params& p, int first, int stride, int hi, volatile unsigned* stop, unsigned char* scr, int lane) {
    int n = 0, it = first;
    if (it >= hi || (stop && cv_ld_stop(stop) != 0u)) return 0;
    CvDesc da, db; int rma, rmb; float va[64], vb[64];
    cv_decode(p, it, lane, da, rma); cv_load(da, va, lane);
    for (;;) {
        int itn = it + stride; bool more = itn < hi && !(stop && cv_ld_stop(stop) != 0u);
        { const int iq = more ? itn : it; cv_decode(p, iq, lane, db, rmb); cv_load(db, vb, lane); }
        cv_store(da, rma, va, scr, lane); ++n;
        if (!more) break;
        it = itn; itn = it + stride; more = itn < hi && !(stop && cv_ld_stop(stop) != 0u);
        { const int iq = more ? itn : it; cv_decode(p, iq, lane, da, rma); cv_load(da, va, lane); }
        cv_store(db, rmb, vb, scr, lane); ++n;
        if (!more) break;
        it = itn;
    }
    return n;
}
__device__ __forceinline__ int cv_lo(int l) { return l ? CV_PER_L + CV_PRO : CV_PRO; }
#define CV_NPRE(l) ((l) ? 9216 : 10240)
__device__ __forceinline__ int cv_hi(int l) { return (l ? CV_TOTAL : CV_PER_L + CV_PRO) - CV_NPRE(l); }
__device__ __forceinline__ void convert_leftovers(const Params& p, int l, unsigned char* lds) {
    const int tid = tid_(), lane = tid & 63, w = tid >> 6, gw = bid_() * NW_ + w, ncv = nblk_() * 2;
    unsigned char* scr = lds + w * 9216;
    const int g = gw % ncv, sub = gw / ncv;
    const int k0 = (int)p.cvprog[l * 1024 + g];
    (void)convert_stream(p, cv_lo(l) + g + ncv * (k0 + sub), ncv * (NW_ / 2), cv_hi(l), nullptr, scr, lane);
}
__device__ __forceinline__ void phase_convert(const Params& p, unsigned char* lds) {
    const int tid = tid_();
    { const int lane = tid & 63, w = tid >> 6; unsigned char* scr = lds + w * 9216;
      (void)convert_stream(p, bid_() * NW_ + w, nblk_() * NW_, CV_PRO, nullptr, scr, lane); }
}
__device__ __forceinline__ void phase_cv_lrt(const Params& p) {
    const int tid = tid_();
    const int total = 2 * 1024 * 288, nthr = nblk_() * NTHR;
    for (int idx0 = bid_() * NTHR + tid; idx0 < total; idx0 += 4 * nthr) {
        float v[4];
#pragma unroll
        for (int j = 0; j < 4; ++j) { const int ix = idx0 + j * nthr, idx = (ix < total) ? ix : idx0;
            const int l = idx / (1024 * 288), r = idx - l * (1024 * 288), col = r / 288, k = r - col * 288;
            const float* src = (k < 64) ? p.w2 + ((size_t)l * 64 + k) * RW + col : (k < 128) ? p.a2 + ((size_t)l * 64 + (k - 64)) * RW + col
                             : (k < 256) ? p.g2 + ((size_t)l * 128 + (k - 128)) * RW + col : p.v2 + (size_t)(k - 256) * RW + col;
            const float x = *src; v[j] = (k >= 256 && l == 0) ? 0.f : x; }
#pragma unroll
        for (int j = 0; j < 4; ++j) { const int ix = idx0 + j * nthr; if (ix < total) p.LRT[ix] = (bf16_t)(cvt_pk_bf16(v[j], v[j]) & 0xffffu); }
    }
}
__device__ __forceinline__ void phase_cv_u(const Params& p, unsigned char* lds) {
    const int tid = tid_(), lane = tid & 63;
    {
        float* xs = (float*)lds;
        const float* muv = p.mu + 3328 + 2048;
        for (int kb = bid_(); kb < D_ / 8; kb += nblk_()) {
            const int kk = rfl(tid >> 6), k = kb * 8 + kk;
            const float* wv = p.w_in + (size_t)D_ * NIN + (size_t)k * NIN + 5120;
            float wreg[16];
#pragma unroll
            for (int i = 0; i < 16; ++i) wreg[i] = wv[i * 64 + lane];
            float a = 0.f;
#pragma unroll
            for (int half = 0; half < 2; ++half) {
                __syncthreads();
                f32x4 vq[8]; float mq[8];
#pragma unroll
                for (int j = 0; j < 8; ++j) { const int task = tid + NTHR * j, c = half * 512 + (task >> 3), q4 = (task & 7) * 4; mq[j] = muv[c]; vq[j] = *(const f32x4*)(p.v1 + c * 32 + q4); }
#pragma unroll
                for (int j = 0; j < 8; ++j) { const int task = tid + NTHR * j, cl = task >> 3, q4 = (task & 7) * 4; const float m = mq[j];
                    *(f32x4*)(xs + cl * 64 + q4) = vq[j] * (1.0f - m); *(f32x4*)(xs + cl * 64 + 32 + q4) = vq[j] * m; }
                __syncthreads();
#pragma unroll 1
                for (int i = 0; i < 8; ++i) { const float wr = wreg[0];
#pragma unroll
                    for (int q = 0; q < 15; ++q) wreg[q] = wreg[q + 1];
                    const float* xr = xs + (size_t)i * 4096 + lane;
#pragma unroll
                    for (int j = 0; j < 64; ++j) a += RL(wr, j) * xr[j * 64]; }
            }
            p.WinT[(size_t)NINX * D_ + (size_t)(NIN + lane) * D_ + k] = (bf16_t)(cvt_pk_bf16(a, a) & 0xffffu);
        }
        __syncthreads();
    }
}
__device__ __forceinline__ void phase_cv_wrt(const Params& p) {
    const int tid = tid_();
    const int total = 2 * NE * D_, nthr = nblk_() * NTHR;
    for (int idx0 = bid_() * NTHR + tid; idx0 < total; idx0 += 2 * nthr) {
        float v[2];
#pragma unroll
        for (int j = 0; j < 2; ++j) { const int ix = idx0 + j * nthr, idx = (ix < total) ? ix : idx0;
            const int l = idx / (NE * D_), r = idx - l * (NE * D_), e = r / D_, k = r - e * D_;
            v[j] = p.w_router[((size_t)l * D_ + k) * NE + e]; }
#pragma unroll
        for (int j = 0; j < 2; ++j) { const int idx = idx0 + j * nthr;
            if (idx < total) { const int l = idx / (NE * D_), r = idx - l * (NE * D_);
                const unsigned hi = cvt_pk_bf16(v[j], v[j]) & 0xffffu; const float rem = v[j] - bflo(hi);
                p.WrT[(size_t)(l * 2) * NE * D_ + r] = (bf16_t)hi; p.WrT[(size_t)(l * 2 + 1) * NE * D_ + r] = (bf16_t)(cvt_pk_bf16(rem, rem) & 0xffffu); } }
    }
}

struct EpiIn {
    bf16_t* P; bf16_t* Vt; float* VV;
    __device__ __forceinline__ void operator()(const gp::Acc& acc, const gp::Unit& u, int wr, int wc, int fr, int fq) const {
        const int row0 = u.pm * 256 + wr * 64 + fr, col0 = u.pn * 256 + wc * 32 + 8 * fq;
        if (u.pn == 25) {
            if (wc < 2) {
#pragma unroll
                for (int ai = 0; ai < 2; ++ai)
#pragma unroll
                    for (int m = 0; m < 4; ++m) { float* vp = VV + (size_t)(row0 + ai * 128 + m * 16) * 64 + wc * 32 + 8 * fq;
                        *(f32x4*)vp = acc[ai][0][m][0]; *(f32x4*)(vp + 4) = acc[ai][0][m][1]; } }
            return;
        }
#pragma unroll
        for (int ai = 0; ai < 2; ++ai)
#pragma unroll
            for (int m = 0; m < 4; ++m) { bf16_t* rowp = P + (size_t)(row0 + ai * 128 + m * 16) * NIN + col0;
#pragma unroll
                for (int bj = 0; bj < 2; ++bj) { const f32x4 v0 = acc[ai][bj][m][0], v1 = acc[ai][bj][m][1];
                    u32x4 w; w.x = cvt_pk_bf16(v0[0], v0[1]); w.y = cvt_pk_bf16(v0[2], v0[3]); w.z = cvt_pk_bf16(v1[0], v1[1]); w.w = cvt_pk_bf16(v1[2], v1[3]);
                    *(u32x4*)(rowp + bj * 128) = w; } }
    }
};
struct EpiBf16Rows {
    bf16_t* C; int ldc;
    __device__ __forceinline__ void operator()(const gp::Acc& acc, const gp::Unit& u, int wr, int wc, int fr, int fq) const {
        const int row0 = u.pm * 256 + wr * 64 + fr, col0 = u.pn * 256 + wc * 32 + 8 * fq;
#pragma unroll
        for (int ai = 0; ai < 2; ++ai)
#pragma unroll
            for (int m = 0; m < 4; ++m) { bf16_t* rowp = C + (size_t)(row0 + ai * 128 + m * 16) * ldc + col0;
#pragma unroll
                for (int bj = 0; bj < 2; ++bj) { const f32x4 v0 = acc[ai][bj][m][0], v1 = acc[ai][bj][m][1];
                    u32x4 w; w.x = cvt_pk_bf16(v0[0], v0[1]); w.y = cvt_pk_bf16(v0[2], v0[3]); w.z = cvt_pk_bf16(v1[0], v1[1]); w.w = cvt_pk_bf16(v1[2], v1[3]);
                    *(u32x4*)(rowp + bj * 128) = w; } }
    }
};
struct EpiF32 {
    float* C; int ldc;
    __device__ __forceinline__ void operator()(const gp::Acc& acc, const gp::Unit& u, int wr, int wc, int fr, int fq) const {
        const int row0 = u.pm * 256 + wr * 64 + fr, col0 = u.pn * 256 + wc * 32 + 4 * fq;
#pragma unroll
        for (int ai = 0; ai < 2; ++ai)
#pragma unroll
            for (int m = 0; m < 4; ++m) { float* rowp = C + (size_t)(row0 + ai * 128 + m * 16) * ldc + col0;
#pragma unroll
                for (int bj = 0; bj < 2; ++bj)
#pragma unroll
                    for (int n = 0; n < 2; ++n) *(f32x4*)(rowp + bj * 128 + n * 16) = acc[ai][bj][m][n]; }
    }
};
__device__ __forceinline__ void phase_gemm_in8(const Params& p, int l, unsigned char* lds) {
    gp::DenseSched S; S.init(p.Hn, p.WinT + (size_t)l * NINX * D_, T_, l ? NINX : NIN, D_, nblk_(), bid_());
    EpiIn E{p.P, p.Vt, p.VV};
    gp::gemm_phase<false, 1, GP_SP2, GP_ALIGN>((LAS unsigned char*)lds, D_, S, E);
    {
        const int G = nblk_(), c = bid_(), nwg = (T_ / 256) * ((l ? NINX : NIN) / 256), nlong = nwg % G;
        if (nlong != 0 && c >= nlong) {
            const int tid = tid_(), lane = tid & 63, w = tid >> 6, sw = (c - nlong) * NW_ + w, nsw = (G - nlong) * NW_;
            unsigned char* scr = lds + w * 9216;
            (void)convert_stream(p, cv_hi(l) + sw, nsw, cv_hi(l) + CV_NPRE(l), nullptr, scr, lane);
        }
    }
}
__device__ __forceinline__ void phase_gemm_out8(const Params& p, int l, unsigned char* lds) {
    gp::DenseSched S; S.init(p.ocat, p.WoutT + (size_t)l * D_ * D_, T_, D_, D_, nblk_(), bid_());
    EpiBf16Rows E{(bf16_t*)p.mixed, D_};
    gp::gemm_phase<false, 1, GP_SP2, GP_ALIGN>((LAS unsigned char*)lds, D_, S, E);
}

__device__ __forceinline__ void build_tables(const Params& p, int l, int* tab, int tshift) {
    { const int e = tid_();
      if (e <= NE) tab[e] = (e < NE) ? (int)__hip_atomic_load(p.counts + (l * NE + e) * 32, __ATOMIC_RELAXED, __HIP_MEMORY_SCOPE_AGENT) : T_; }
    __syncthreads();
    if (tid_() < 64) {
        const int e = tid_(), c = tab[e], pr = (c + 255) & ~255, tt = (c + (1 << tshift) - 1) >> tshift;
        int ip = pr, it = tt;
#pragma unroll
        for (int d = 1; d < 64; d <<= 1) { const int a = __shfl_up(ip, d), b = __shfl_up(it, d); if (e >= d) { ip += a; it += b; } }
        tab[80 + e] = ip - pr; tab[160 + e] = it - tt;
        if (e == 63) { tab[80 + NE] = ip; tab[160 + NE] = it; tab[80 + NE + 1] = ip + ((T_ + 255) & ~255); tab[160 + NE + 1] = it + ((T_ + (1 << tshift) - 1) >> tshift); }
    }
    __syncthreads();
    {
        unsigned char* emap = (unsigned char*)(tab + 256);
        const int nt = tab[160 + NE + 1];
        (void)nt;
        const int e = tid_();
        if (e <= NE) { const int lo = tab[160 + e], hi = tab[160 + e + 1]; for (int rt = lo; rt < hi && rt < 1024; ++rt) emap[rt] = (unsigned char)e; }
    }
    __syncthreads();
}
__device__ __forceinline__ int find_expert(const int* tab, int rt) { return (int)((const unsigned char*)(tab + 256))[rt]; }

struct MoeSched {
    const int* tab; const char* A; const char* Bt; size_t bt_stride; const int* rowtok; int K, nN, nunits, G, c; bool gather;
    __device__ __forceinline__ bool next(int i, gp::Unit& u) const {
        const int L = i * G + c; if (L >= nunits) return false;
        const int rtg = L / nN; u.pn = L - rtg * nN; const int e = find_expert(tab, rtg); u.e = e; u.pm = rtg - tab[160 + e]; return true;
    }
    __device__ __forceinline__ const char* a_base(const gp::Unit& u) const { return gather ? A : A + (size_t)(tab[80 + u.e] + u.pm * 256) * K * 2; }
    __device__ __forceinline__ const char* b_base(const gp::Unit& u) const { return Bt + (size_t)u.e * bt_stride + (size_t)u.pn * 256 * K * 2; }
    __device__ __forceinline__ int a_row(const gp::Unit& u, int r) const { const int slot = u.pm * 256 + r; return (slot < tab[u.e]) ? ((u.e < NE) ? rowtok[u.e * CAP + slot] : slot) : 0; }
};
struct EpiSwiglu {
    bf16_t* H1; const int* tab;
    __device__ __forceinline__ void operator()(const gp::Acc& acc, const gp::Unit& u, int wr, int wc, int fr, int fq) const {
        const int row0 = tab[80 + u.e] + u.pm * 256 + wr * 64 + fr, hid0 = u.pn * 128 + wc * 32 + 8 * fq;
#pragma unroll
        for (int ai = 0; ai < 2; ++ai)
#pragma unroll
            for (int m = 0; m < 4; ++m) { bf16_t* rowp = H1 + (size_t)(row0 + ai * 128 + m * 16) * 512 + hid0;
                float h[8];
#pragma unroll
                for (int n = 0; n < 2; ++n)
#pragma unroll
                    for (int jj = 0; jj < 4; ++jj) { const float g = acc[ai][0][m][n][jj], uu = acc[ai][1][m][n][jj]; h[n * 4 + jj] = g * frcp_(1.0f + __expf(-g)) * uu; }
                u32x4 o; o.x = cvt_pk_bf16(h[0], h[1]); o.y = cvt_pk_bf16(h[2], h[3]); o.z = cvt_pk_bf16(h[4], h[5]); o.w = cvt_pk_bf16(h[6], h[7]);
                *(u32x4*)rowp = o; }
    }
};
#define Y2_SCALE 8.0f
struct EpiDown {
    unsigned char* Y2; const int* tab;
    __device__ __forceinline__ void operator()(const gp::Acc& acc, const gp::Unit& u, int wr, int wc, int fr, int fq) const {
        const int slot0 = u.pm * 256 + wr * 64 + fr, cnt = tab[u.e], row0 = tab[80 + u.e] + slot0, col0 = u.pn * 256 + wc * 64 + 16 * fq;
#pragma unroll
        for (int ai = 0; ai < 2; ++ai)
#pragma unroll
            for (int m = 0; m < 4; ++m) {
                if (slot0 + ai * 128 + m * 16 < cnt) {
                    u32x4 o;
#pragma unroll
                    for (int bj = 0; bj < 2; ++bj) { f32x4 v0 = acc[ai][bj][m][0] * Y2_SCALE, v1 = acc[ai][bj][m][1] * Y2_SCALE;
#pragma unroll
                        for (int jj = 0; jj < 4; ++jj) { v0[jj] = __builtin_amdgcn_fmed3f(v0[jj], -440.0f, 440.0f); v1[jj] = __builtin_amdgcn_fmed3f(v1[jj], -440.0f, 440.0f); }
                        int w0 = __builtin_amdgcn_cvt_pk_fp8_f32(v0[0], v0[1], 0, false); w0 = __builtin_amdgcn_cvt_pk_fp8_f32(v0[2], v0[3], w0, true);
                        int w1 = __builtin_amdgcn_cvt_pk_fp8_f32(v1[0], v1[1], 0, false); w1 = __builtin_amdgcn_cvt_pk_fp8_f32(v1[2], v1[3], w1, true);
                        if (bj == 0) { o.x = (unsigned)w0; o.y = (unsigned)w1; } else { o.z = (unsigned)w0; o.w = (unsigned)w1; } }
                    *(u32x4*)(Y2 + (size_t)(row0 + ai * 128 + m * 16) * D_ + col0) = o; } }
    }
};
__device__ __forceinline__ int xcd_order(int c, int G) { return (G % 8 == 0) ? (c % 8) * (G / 8) + c / 8 : c; }
__device__ __forceinline__ void phase_moe_gu8(const Params& p, int l, unsigned char* lds) {
    int* tab = (int*)(lds + TAB_OFF);
    build_tables(p, l, tab, 8);
    MoeSched S{tab, (const char*)p.Hn, (const char*)(p.WguT + (size_t)l * 65 * 1024 * D_), (size_t)1024 * D_ * 2, p.rowtok, D_, 4, tab[160 + NE + 1] * 4, nblk_(), xcd_order(bid_(), nblk_()), true};
    EpiSwiglu E{p.H1, tab};
    gp::gemm_phase<true, 1, GP_SP2, GP_ALIGN>((LAS unsigned char*)lds, D_, S, E);
}
__device__ __forceinline__ void phase_moe_down8(const Params& p, int l, unsigned char* lds) {
    int* tab = (int*)(lds + TAB_OFF);
    build_tables(p, l, tab, 8);
    MoeSched S{tab, (const char*)p.H1, (const char*)(p.WdT + (size_t)l * 65 * D_ * 512), (size_t)D_ * 512 * 2, p.rowtok, 512, 8, tab[160 + NE + 1] * 8, nblk_(), xcd_order(bid_(), nblk_()), false};
    EpiDown E{(unsigned char*)p.Y2, tab};
    gp::gemm_phase<false, 2, GP_SP2, GP_ALIGN>((LAS unsigned char*)lds, 512, S, E);
}

__device__ __forceinline__ void phase_adaln(const Params& p, unsigned char* lds) {
    typedef float f32x2a __attribute__((ext_vector_type(2)));
    float* cond = (float*)lds;
    float* red = cond + 4 * D_;
    const int tid = tid_(), lane = tid & 63, w = tid >> 6;
    {
        f32x4 cv4[4];
#pragma unroll
        for (int j = 0; j < 4; ++j) cv4[j] = *(const f32x4*)(p.c + tid * 16 + j * 4);
#pragma unroll
        for (int j = 0; j < 4; ++j)
#pragma unroll
            for (int q = 0; q < 4; ++q) { const int i = tid * 16 + j * 4 + q; const float v = cv4[j][q]; cond[(i & (D_ - 1)) * 4 + (i >> 11)] = v / (1.0f + __expf(-v)); }
    }
    __syncthreads();
    for (int unit = bid_(); unit < 192; unit += nblk_()) {
        const int l = unit / 96, n0 = (unit % 96) * 128, k0 = rfl(w) * 256;
        const float* W = p.w_ada + (size_t)l * D_ * 12288 + (size_t)k0 * 12288 + n0;
        f32x2a acc[4];
#pragma unroll
        for (int b = 0; b < 4; ++b) acc[b] = (f32x2a){0.f, 0.f};
#pragma unroll 1
        for (int kb = 0; kb < 256; kb += 16) {
            f32x2a wv[16];
#pragma unroll
            for (int k = 0; k < 16; ++k) wv[k] = *(const f32x2a*)(W + (size_t)((kb + k) * 12288) + lane * 2);
#pragma unroll
            for (int k = 0; k < 16; ++k) { const f32x4 cv = *(const f32x4*)(cond + (k0 + kb + k) * 4);
#pragma unroll
                for (int b = 0; b < 4; ++b) acc[b] += wv[k] * cv[b]; }
        }
#pragma unroll
        for (int b = 0; b < 4; ++b) *(f32x2a*)(red + (w * 4 + b) * 128 + lane * 2) = acc[b];
        __syncthreads();
        { const int b = tid >> 7, col = tid & 127; float sm = 0.f;
#pragma unroll
            for (int ww = 0; ww < NW_; ++ww) sm += red[(ww * 4 + b) * 128 + col];
            p.mod[((size_t)l * 4 + b) * 12288 + n0 + col] = sm + p.b_ada[(size_t)l * 12288 + n0 + col]; }
        __syncthreads();
    }
}

__device__ __forceinline__ void emit_hn(const f32x4 (&xv)[8], float rstd, const float* g, const float* sc, const float* sh, bf16_t* dst, int lane, float* hf) {
    f32x4 pg[8], ps[8], ph[8];
#pragma unroll
    for (int i = 0; i < 8; ++i) { const int e = i * 256 + lane * 4; pg[i] = *(const f32x4*)(g + e); ps[i] = *(const f32x4*)(sc + e); ph[i] = *(const f32x4*)(sh + e); }
    __builtin_amdgcn_sched_barrier(0);
#pragma unroll
    for (int i = 0; i < 8; ++i) {
        const int e = i * 256 + lane * 4;
        const f32x4 gv = pg[i], scv = ps[i], shv = ph[i];
        f32x4 h;
#pragma unroll
        for (int j = 0; j < 4; ++j) h[j] = xv[i][j] * rstd * gv[j] * (1.0f + scv[j]) + shv[j];
        u32x2 o; o.x = cvt_pk_bf16(h[0], h[1]); o.y = cvt_pk_bf16(h[2], h[3]);
        *(u32x2*)(dst + e) = o;
        if (hf) *(f32x4*)(hf + e) = h;
    }
}

__device__ __forceinline__ void phase_prenorm0(const Params& p) {
    const int lane = tid_() & 63, gw = bid_() * (NTHR / 64) + (tid_() >> 6), nw = nblk_() * (NTHR / 64);
    f32x4 xn[8];
    if (gw < T_) {
#pragma unroll
        for (int i = 0; i < 8; ++i) xn[i] = *(const f32x4*)(p.x + (size_t)gw * D_ + i * 256 + lane * 4);
    }
    for (int t = gw; t < T_; t += nw) {
        const int b = t / S_;
        f32x4 xv[8]; float ss = 0.f;
#pragma unroll
        for (int i = 0; i < 8; ++i) { xv[i] = xn[i]; ss += xv[i][0] * xv[i][0] + xv[i][1] * xv[i][1] + xv[i][2] * xv[i][2] + xv[i][3] * xv[i][3]; }
        if (t + nw < T_) {
#pragma unroll
            for (int i = 0; i < 8; ++i) xn[i] = *(const f32x4*)(p.x + (size_t)(t + nw) * D_ + i * 256 + lane * 4);
        }
        ss = wave_sum(ss);
        const float rstd = rsqrtf(ss * (1.0f / D_) + 1e-6f);
        const float* md = p.mod + (size_t)b * 12288;
        emit_hn(xv, rstd, p.g_pre_mix, md + 2048, md, p.Hn + (size_t)t * D_, lane, nullptr);
    }
}

__device__ __forceinline__ void phase_gemm_in(const Params& p, int l, unsigned char* lds) {
    const float* B = p.w_in + (size_t)l * D_ * NIN;
    for (int unit = bid_(); unit < 64 * 50; unit += nblk_()) {
        const int mt = unit / 50, nt = unit % 50;
        bf16_t* Pp = p.P;
        gemm_tile(lds, p.Hn, D_, [=](int r) { return mt * 128 + r; }, B + nt * 128 + (tid_() & 127), NIN, D_,
                  [=](int m, int n, f32x4 v) { u32x2 o; o.x = cvt_pk_bf16(v[0], v[1]); o.y = cvt_pk_bf16(v[2], v[3]); *(u32x2*)(Pp + (size_t)(mt * 128 + m) * NIN + nt * 128 + n) = o; });
    }
}

__device__ __forceinline__ void phase_attn_naive(const Params& p) {
    const int lane = tid_() & 63, gw = bid_() * (NTHR / 64) + (tid_() >> 6), nw = nblk_() * (NTHR / 64);
    float* tmp = p.mixed;
    for (int it = gw; it < 2048; it += nw) {
        const int item = rfl(it);
        const int qb = 31 - (item >> 6), rest = item & 63, c = rest & 1, h = (rest >> 1) & 7, b = rest >> 4;
        const int q = qb * 64 + lane;
        const bf16_t* Pb = p.P + (size_t)b * S_ * NIN;
        float qv[64];
        {
            const bf16_t* qp = Pb + (size_t)q * NIN + h * 128 + c * 64;
#pragma unroll
            for (int i = 0; i < 8; ++i) { const u32x4 u = *(const u32x4*)(qp + i * 8);
#pragma unroll
                for (int j = 0; j < 4; ++j) { qv[i * 8 + j * 2] = __uint_as_float(u[j] << 16); qv[i * 8 + j * 2 + 1] = __uint_as_float(u[j] & 0xffff0000u); } }
        }
        const float scale2 = 0.125f * 1.44269504f, slope2 = exp2f(-(float)(h + 1)) * 1.44269504f;
        const int jmax = qb * 64 + 63;
        const bf16_t* kbase = Pb + 1024 + h * 128 + c * 64;
        const bf16_t* vbase = Pb + 2048 + h * 128;
        float m = -1e30f;
        for (int j = 0; j <= jmax; ++j) {
            const u32x4* kp = (const u32x4*)(kbase + (size_t)j * NIN);
            float s = 0.f;
#pragma unroll
            for (int i = 0; i < 8; ++i) { const u32x4 u = kp[i];
#pragma unroll
                for (int jj = 0; jj < 4; ++jj) { s += qv[i * 8 + jj * 2] * __uint_as_float(u[jj] << 16); s += qv[i * 8 + jj * 2 + 1] * __uint_as_float(u[jj] & 0xffff0000u); } }
            s = s * scale2 - slope2 * (float)(q - j);
            if (j <= q) m = fmaxf(m, s);
        }
        const float minv = 1.0f;
#pragma unroll 1
        for (int dh = 0; dh < 2; ++dh) {
            float lsum = 0.f; float acc[64];
#pragma unroll
            for (int d = 0; d < 64; ++d) acc[d] = 0.f;
            for (int j = 0; j <= jmax; ++j) {
                const u32x4* kp = (const u32x4*)(kbase + (size_t)j * NIN);
                float s = 0.f;
#pragma unroll
                for (int i = 0; i < 8; ++i) { const u32x4 u = kp[i];
#pragma unroll
                    for (int jj = 0; jj < 4; ++jj) { s += qv[i * 8 + jj * 2] * __uint_as_float(u[jj] << 16); s += qv[i * 8 + jj * 2 + 1] * __uint_as_float(u[jj] & 0xffff0000u); } }
                s = s * scale2 - slope2 * (float)(q - j);
                const float pj = (j <= q) ? exp2f(s - m) : 0.f;
                lsum += pj;
                const u32x4* vp = (const u32x4*)(vbase + (size_t)j * NIN + dh * 64);
#pragma unroll
                for (int i = 0; i < 8; ++i) { const u32x4 u = vp[i];
#pragma unroll
                    for (int jj = 0; jj < 4; ++jj) { acc[i * 8 + jj * 2] += pj * __uint_as_float(u[jj] << 16); acc[i * 8 + jj * 2 + 1] += pj * __uint_as_float(u[jj] & 0xffff0000u); } }
            }
            const float inv = minv / lsum;
            float* op = tmp + (size_t)(b * S_ + q + launder0()) * D_ + h * 256 + c * 128;
#pragma unroll
            for (int d = 0; d < 64; d += 4) *(f32x4*)(op + dh * 64 + d) = (f32x4){acc[d] * inv, acc[d + 1] * inv, acc[d + 2] * inv, acc[d + 3] * inv};
        }
    }
}

typedef float f32x16 __attribute__((ext_vector_type(16)));
#define AT_ROWB 144
#define AT_VOFF (128 * AT_ROWB)
#define AT_BUFB (128 * AT_ROWB + 64 * 256)
__device__ __forceinline__ int at_voff(int row, int ch) { return 256 * row + 16 * (ch ^ (((row & 3) << 2) | ((row >> 2) & 3))); }
typedef short s16x4 __attribute__((ext_vector_type(4)));
__device__ __forceinline__ void phase_attn8(const Params& p, int l, unsigned char* lds) {
    const int tid = tid_(), lane = tid & 63, w = tid >> 6, r32 = lane & 31, hh = lane >> 5, c = w >> 2, wq = w & 3;
    const int srow = tid >> 3, sch = tid & 7;
    const float lam_init = (l == 0) ? 0.2f : 0.35550907f;
    for (int u0 = bid_(); u0 < 256; u0 += nblk_()) {
        const int unit = (nblk_() == 256) ? xcd_order(u0, 256) : u0;
        const int jp = unit & 7, h = (unit >> 3) & 7, b = unit >> 6;
        const bf16_t* Pb = p.P + (size_t)b * S_ * NIN;
        const bf16_t* Kg = Pb + 1024 + h * 128;
        const bf16_t* Vg = Pb + 2048 + h * 128;
        const unsigned koff = (unsigned)(srow * NIN + sch * 8), voff = (unsigned)((tid >> 4) * NIN + (tid & 15) * 8);
        const float scale2 = 0.125f * 1.44269504f, slopeS = exp2f((float)(2 - h));
        bf16x8 qx, kx0, kx1;
        { u32x4 z = (u32x4){0u, 0u, 0u, 0u}, a0 = z, a1 = z, qq = z;
          if (hh == 0) { a0.x = cvt_pk_bf16((float)r32, 0.f); a1.x = cvt_pk_bf16((float)(32 + r32), 0.f); qq.x = cvt_pk_bf16(slopeS, 0.f); }
          kx0 = __builtin_bit_cast(bf16x8, a0); kx1 = __builtin_bit_cast(bf16x8, a1); qx = __builtin_bit_cast(bf16x8, qq); }
#pragma unroll 1
        for (int half = 0; half < 2; ++half) {
            const int qb = half ? jp : 15 - jp;
            const int q0 = qb * 128 + wq * 32, q = q0 + r32;
            bf16x8 qf[4];
            { const bf16_t* qp = Pb + (size_t)q * NIN + h * 128 + c * 64 + 8 * hh;
#pragma unroll
              for (int ks = 0; ks < 4; ++ks) qf[ks] = *(const bf16x8*)(qp + 16 * ks); }
            f32x16 O[4];
#pragma unroll
            for (int d = 0; d < 4; ++d)
#pragma unroll
                for (int r = 0; r < 16; ++r) O[d][r] = 0.f;
            float m = -1e30f, lsum = 0.f;
            const int ntiles = 2 * qb + 2;
            u32x4 rk0, rk1, rv0, rv1, nk0, nk1, nv0, nv1;
            rk0 = *(const u32x4*)(Kg + koff); rk1 = *(const u32x4*)(Kg + 64 + koff); rv0 = *(const u32x4*)(Vg + voff); rv1 = *(const u32x4*)(Vg + (size_t)32 * NIN + voff);
            *(u32x4*)(lds + srow * AT_ROWB + sch * 16) = rk0; *(u32x4*)(lds + (64 + srow) * AT_ROWB + sch * 16) = rk1;
            *(u32x4*)(lds + AT_VOFF + at_voff(tid >> 4, tid & 15)) = rv0; *(u32x4*)(lds + AT_VOFF + at_voff(32 + (tid >> 4), tid & 15)) = rv1;
            { const bf16_t* kq = Kg + (size_t)64 * NIN; const bf16_t* vq = Vg + (size_t)64 * NIN;
              rk0 = *(const u32x4*)(kq + koff); rk1 = *(const u32x4*)(kq + 64 + koff); rv0 = *(const u32x4*)(vq + voff); rv1 = *(const u32x4*)(vq + (size_t)32 * NIN + voff); }
            __syncthreads();
            auto tile = [&](const int kt, u32x4& hk0, u32x4& hk1, u32x4& hv0, u32x4& hv1, u32x4& gk0, u32x4& gk1, u32x4& gv0, u32x4& gv1) __attribute__((always_inline)) {
                unsigned char* bufp = lds + (kt & 1) * AT_BUFB;
                { const int kn = (kt + 2 < ntiles) ? kt + 2 : ntiles - 1;
                    const bf16_t* kq = Kg + (size_t)kn * 64 * NIN; const bf16_t* vq = Vg + (size_t)kn * 64 * NIN;
                    gk0 = *(const u32x4*)(kq + koff); gk1 = *(const u32x4*)(kq + 64 + koff); gv0 = *(const u32x4*)(vq + voff); gv1 = *(const u32x4*)(vq + (size_t)32 * NIN + voff); }
                if (kt * 64 <= q0 + 31) {
                    f32x16 st[2];
                    {
                        bf16x8 kfr[2][4];
#pragma unroll
                        for (int kb = 0; kb < 2; ++kb)
#pragma unroll
                            for (int ks = 0; ks < 4; ++ks) kfr[kb][ks] = *(const bf16x8*)(bufp + (c * 64 + 32 * kb + r32) * AT_ROWB + (16 * ks + 8 * hh) * 2);
                        __builtin_amdgcn_sched_barrier(0);
#pragma unroll
                        for (int kb = 0; kb < 2; ++kb) {
                            f32x16 a;
#pragma unroll
                            for (int r = 0; r < 16; ++r) a[r] = 0.f;
                            a = __builtin_amdgcn_mfma_f32_32x32x16_bf16(kb ? kx1 : kx0, qx, a, 0, 0, 0);
#pragma unroll
                            for (int ks = 0; ks < 4; ++ks) a = __builtin_amdgcn_mfma_f32_32x32x16_bf16(kfr[kb][ks], qf[ks], a, 0, 0, 0);
                            st[kb] = a;
                        }
                    }
                    const int g_ = lane >> 4, q_ = (lane >> 2) & 3, p_ = lane & 3, clx = (2 * (g_ & 1) + (p_ >> 1)) ^ (g_ >> 1);
                    const LAS unsigned char* vb0 = (const LAS unsigned char*)(bufp + AT_VOFF) + 8 * (p_ & 1) + 256 * (4 * (g_ >> 1) + q_) + 16 * clx;
                    const LAS unsigned char* vb1 = (const LAS unsigned char*)(bufp + AT_VOFF) + 8 * (p_ & 1) + 256 * (4 * (g_ >> 1) + q_) + 16 * (clx ^ 2);
                    s16x4 vt[2][8];
#define AT_VLOAD(buf, d) do { const int dq_ = 64 * ((d) ^ q_); _Pragma("unroll") for (int kb_ = 0; kb_ < 2; ++kb_) _Pragma("unroll") for (int s2_ = 0; s2_ < 2; ++s2_) { \
                            vt[buf][(kb_ * 2 + s2_) * 2] = __builtin_amdgcn_ds_read_tr16_b64_v4i16((LAS s16x4*)(vb0 + dq_ + 256 * (32 * kb_ + 16 * s2_))); \
                            vt[buf][(kb_ * 2 + s2_) * 2 + 1] = __builtin_amdgcn_ds_read_tr16_b64_v4i16((LAS s16x4*)(vb1 + dq_ + 256 * (32 * kb_ + 16 * s2_ + 8))); } } while (0)
                    AT_VLOAD(0, 0);
                    __builtin_amdgcn_sched_barrier(0);
                    const float tb = slopeS * (float)(kt * 64);
                    float mx = -1e30f;
                    if (kt * 64 + 63 > q0) {
                        const int kmq = kt * 64 + 4 * hh - q;
#pragma unroll
                        for (int kb = 0; kb < 2; ++kb)
#pragma unroll
                            for (int r = 0; r < 16; ++r) { const int off = 32 * kb + (r & 3) + 8 * (r >> 2);
                                const float sv = (kmq + off > 0) ? -1e30f : st[kb][r]; st[kb][r] = sv; mx = fmaxf(mx, sv); }
                    } else {
#pragma unroll
                        for (int kb = 0; kb < 2; ++kb)
#pragma unroll
                            for (int r = 0; r < 16; ++r) mx = fmaxf(mx, st[kb][r]);
                    }
                    mx = fmaxf(mx, __shfl_xor(mx, 32));
                    const float mn = fmaxf(m, mx + tb), alpha = __builtin_amdgcn_exp2f((m - mn) * scale2);
                    const bool resc = __any(mn > m);
                    m = mn;
                    const float cexp = (tb - mn) * scale2;
                    float rs = 0.f;
#pragma unroll
                    for (int kb = 0; kb < 2; ++kb)
#pragma unroll
                        for (int r = 0; r < 16; ++r) { const float pe = __builtin_amdgcn_exp2f(st[kb][r] * scale2 + cexp); st[kb][r] = pe; rs += pe; }
                    rs += __shfl_xor(rs, 32);
                    lsum = lsum * alpha + rs;
                    if (resc) {
#pragma unroll
                        for (int d = 0; d < 4; ++d)
#pragma unroll
                            for (int r = 0; r < 16; ++r) O[d][r] *= alpha;
                    }
                    bf16x8 pf[2][2];
#pragma unroll
                    for (int kb = 0; kb < 2; ++kb)
#pragma unroll
                        for (int s2 = 0; s2 < 2; ++s2) { u32x4 u; u.x = cvt_pk_bf16(st[kb][8 * s2 + 0], st[kb][8 * s2 + 1]); u.y = cvt_pk_bf16(st[kb][8 * s2 + 2], st[kb][8 * s2 + 3]);
                            u.z = cvt_pk_bf16(st[kb][8 * s2 + 4], st[kb][8 * s2 + 5]); u.w = cvt_pk_bf16(st[kb][8 * s2 + 6], st[kb][8 * s2 + 7]); pf[kb][s2] = __builtin_bit_cast(bf16x8, u); }
                    {
#pragma unroll
                        for (int d = 0; d < 4; ++d) {
                            if (d + 1 < 4) AT_VLOAD((d + 1) & 1, d + 1);
                            __builtin_amdgcn_sched_barrier(0);
#pragma unroll
                            for (int kb = 0; kb < 2; ++kb)
#pragma unroll
                                for (int s2 = 0; s2 < 2; ++s2) {
                                    const bf16x8 vf = __builtin_shufflevector(vt[d & 1][(kb * 2 + s2) * 2], vt[d & 1][(kb * 2 + s2) * 2 + 1], 0, 1, 2, 3, 4, 5, 6, 7);
                                    O[d] = __builtin_amdgcn_mfma_f32_32x32x16_bf16(vf, pf[kb][s2], O[d], 0, 0, 0); }
                            __builtin_amdgcn_sched_barrier(0);
                        }
#undef AT_VLOAD
                    }
                }
                if (kt + 1 < ntiles) { unsigned char* nb = lds + ((kt + 1) & 1) * AT_BUFB;
                    *(u32x4*)(nb + srow * AT_ROWB + sch * 16) = hk0; *(u32x4*)(nb + (64 + srow) * AT_ROWB + sch * 16) = hk1;
                    *(u32x4*)(nb + AT_VOFF + at_voff(tid >> 4, tid & 15)) = hv0; *(u32x4*)(nb + AT_VOFF + at_voff(32 + (tid >> 4), tid & 15)) = hv1; }
                __syncthreads();
            };
#pragma unroll 1
            for (int kt = 0; kt < ntiles; kt += 2) { tile(kt, rk0, rk1, rv0, rv1, nk0, nk1, nv0, nv1); tile(kt + 1, nk0, nk1, nv0, nv1, rk0, rk1, rv0, rv1); }
            const float inv = 1.0f / lsum;
            float* xo = (float*)lds + (size_t)wq * 64 * 64 + lane;
            if (c == 1) {
#pragma unroll
                for (int d = 0; d < 4; ++d)
#pragma unroll
                    for (int r = 0; r < 16; ++r) xo[(d * 16 + r) * 64] = O[d][r] * inv;
            }
            __syncthreads();
            if (c == 0) {
                float lam;
                { const float s1 = wave_sum(p.lam_q1[l * 64 + lane] * p.lam_k1[l * 64 + lane]), s2 = wave_sum(p.lam_q2[l * 64 + lane] * p.lam_k2[l * 64 + lane]); lam = __expf(s1) - __expf(s2) + lam_init; }
                float ss = 0.f;
#pragma unroll
                for (int d = 0; d < 4; ++d)
#pragma unroll
                    for (int r = 0; r < 16; ++r) { const float o = O[d][r] * inv - lam * xo[(d * 16 + r) * 64]; O[d][r] = o; ss += o * o; }
                ss += __shfl_xor(ss, 32);
                const float rstd = rsqrtf(ss * (1.0f / 128.0f) + 1e-5f) * (1.0f - lam_init);
                bf16_t* op = p.ocat + (size_t)(b * S_ + q) * D_ + h * 128 + 4 * hh;
                const float* sg = p.subln_g + l * 128 + 4 * hh;
#pragma unroll
                for (int d = 0; d < 4; ++d)
#pragma unroll
                    for (int g = 0; g < 4; ++g) { const f32x4 gv = *(const f32x4*)(sg + 32 * d + 8 * g);
                        u32x2 o; o.x = cvt_pk_bf16(O[d][4 * g] * rstd * gv[0], O[d][4 * g + 1] * rstd * gv[1]); o.y = cvt_pk_bf16(O[d][4 * g + 2] * rstd * gv[2], O[d][4 * g + 3] * rstd * gv[3]);
                        *(u32x2*)(op + 32 * d + 8 * g) = o; }
            }
            __syncthreads();
        }
    }
}

__device__ __forceinline__ float shifted(const bf16_t* P, int t, int col, float mu) {
    const float cur = bf2f(P[(size_t)t * NIN + 3072 + col]);
    const float prev = (t % S_) ? bf2f(P[(size_t)(t - 1) * NIN + 3072 + col]) : 0.f;
    return cur + (prev - cur) * mu;
}
#define PREP_RB 2
__device__ __forceinline__ void phase_rwkv_prep(const Params& p, int l, unsigned char* lds) {
    float* lowr = (float*)lds;
    float* vrow = lowr + PREP_RB * 256;
    float* red = vrow + PREP_RB * 1024;
    float* vv = red + PREP_RB * 512;
    const int tid = tid_(), lane = tid & 63;
    const float* mu = p.mu + (size_t)l * 3328;
    const float *w0 = p.w0 + l * RW, *w2 = p.w2 + (size_t)l * 64 * RW, *a0 = p.a0 + l * RW, *a2 = p.a2 + (size_t)l * 64 * RW, *g2 = p.g2 + (size_t)l * 128 * RW;
    const float *k_k = p.k_k + l * RW, *k_a = p.k_a + l * RW, *r_k = p.r_k + l * RW;
    for (int unit = bid_(); unit < T_ / PREP_RB; unit += nblk_()) {
        const int t0 = unit * PREP_RB;
        for (int idx = tid; idx < PREP_RB * 256; idx += NTHR) {
            const int r = idx >> 8, m = idx & 255;
            const float f = shifted(p.P, t0 + r, 3072 + m, mu[3072 + m]);
            lowr[idx] = (m < 64) ? tanhf(f) : (m < 128) ? f : sigmoidf_(f);
        }
        if (l > 0) {
            for (int idx = tid; idx < PREP_RB * 1024; idx += NTHR) { const int r = idx >> 10, cc = idx & 1023; vrow[idx] = shifted(p.P, t0 + r, 2048 + cc, mu[2048 + cc]); }
        }
        __syncthreads();
        if (l > 0) {
            const int j = tid & 31, part = tid >> 5;
            const float* v1 = p.v1;
#pragma unroll
            for (int r = 0; r < PREP_RB; ++r) {
                float s = 0.f;
#pragma unroll 4
                for (int cc = part * 64; cc < part * 64 + 64; ++cc) s += vrow[r * 1024 + cc] * v1[cc * 32 + j];
                red[(r * 16 + part) * 32 + j] = s;
            }
            __syncthreads();
            if (tid < PREP_RB * 32) { const int r = tid >> 5, jj = tid & 31; float s = 0.f;
#pragma unroll
                for (int pp = 0; pp < 16; ++pp) s += red[(r * 16 + pp) * 32 + jj];
                vv[r * 32 + jj] = s; }
            __syncthreads();
        }
#pragma unroll 1
        for (int i = 0; i < 1024 / NTHR; ++i) {
            const int cc = tid + i * NTHR, h = cc >> 6;
            float wa[PREP_RB], aa[PREP_RB], ga[PREP_RB];
#pragma unroll
            for (int r = 0; r < PREP_RB; ++r) { wa[r] = 0.f; aa[r] = 0.f; ga[r] = 0.f; }
#pragma unroll 2
            for (int m = 0; m < 64; ++m) {
                const float w2v = w2[m * RW + cc], a2v = a2[m * RW + cc], g2a = g2[m * RW + cc], g2b = g2[(64 + m) * RW + cc];
#pragma unroll
                for (int r = 0; r < PREP_RB; ++r) { wa[r] += lowr[r * 256 + m] * w2v; aa[r] += lowr[r * 256 + 64 + m] * a2v; ga[r] += lowr[r * 256 + 128 + m] * g2a + lowr[r * 256 + 192 + m] * g2b; }
            }
#pragma unroll
            for (int r = 0; r < PREP_RB; ++r) {
                const int t = t0 + r;
                const float rr = shifted(p.P, t, cc, mu[cc]), kx = shifted(p.P, t, 1024 + cc, mu[1024 + cc]);
                float vx = shifted(p.P, t, 2048 + cc, mu[2048 + cc]);
                const float wv = w0[cc] + wa[r];
                const float decay = __expf(-sigmoidf_(wv) * 0.60653066f);
                const float a = sigmoidf_(a0[cc] + aa[r]);
                const size_t o = (size_t)t * RW + cc;
                if (l == 0) p.vfirst[o] = vx;
                else {
                    float s = p.v0[cc];
#pragma unroll
                    for (int jj = 0; jj < 32; ++jj) s += vv[r * 32 + jj] * p.v2[jj * RW + cc];
                    vx = vx + (p.vfirst[o] - vx) * sigmoidf_(s);
                }
                const float kk = kx * k_k[cc];
                const float ss = wave_sum(kk * kk);
                const float kkn = kk / fmaxf(sqrtf(ss), 1e-12f);
                const float kh = kx * (1.0f + (a - 1.0f) * k_a[cc]);
                const float bc = wave_sum(rr * kh * r_k[cc]);
                if (lane == 0) p.bcoef[(size_t)t * 16 + h] = bc;
                p.sr[o] = rr; p.sw[o] = decay; p.sk[o] = kh; p.sv[o] = vx; p.sa[o] = -kkn; p.sb[o] = kkn * a; p.sg[o] = ga[r];
            }
        }
        __syncthreads();
    }
}

__device__ __forceinline__ void phase_scan_naive(const Params& p) {
    const int lane = tid_() & 63, gw = (tid_() >> 6) * nblk_() + bid_(), nw = nblk_() * (NTHR / 64);
    for (int it = gw; it < 64; it += nw) {
        const int item = rfl(it), b = item >> 4, h = item & 15;
        float st[64];
#pragma unroll
        for (int j = 0; j < 64; ++j) st[j] = 0.f;
        size_t base = (size_t)b * S_ * RW + h * 64 + lane;
        for (int t = 0; t < S_; ++t, base += RW) {
            const float wv = p.sw[base], av = p.sa[base], bv = p.sb[base], kv = p.sk[base], rv = p.sr[base], vi = p.sv[base];
            float sa = 0.f;
#pragma unroll
            for (int j = 0; j < 64; ++j) sa += st[j] * RL(av, j);
            float y = 0.f;
#pragma unroll
            for (int j = 0; j < 64; ++j) { st[j] = st[j] * RL(wv, j) + sa * RL(bv, j) + vi * RL(kv, j); y += st[j] * RL(rv, j); }
            p.sy[base] = y;
        }
    }
}

#define SC_CH 32
#define SC_BUFB (5 * SC_CH * 256 + SC_CH * 64)
__device__ __forceinline__ float dpp_add16(float x) {
    x += __int_as_float(__builtin_amdgcn_update_dpp(0, __float_as_int(x), 0xB1, 0xF, 0xF, true));
    x += __int_as_float(__builtin_amdgcn_update_dpp(0, __float_as_int(x), 0x4E, 0xF, 0xF, true));
    x += __int_as_float(__builtin_amdgcn_update_dpp(0, __float_as_int(x), 0x141, 0xF, 0xF, true));
    x += __int_as_float(__builtin_amdgcn_update_dpp(0, __float_as_int(x), 0x140, 0xF, 0xF, true));
    return x;
}
#define SC_FLAGS (2 * SC_BUFB)
#define SC_CVSCR (2 * SC_BUFB + 512)
__device__ __forceinline__ unsigned lds_ld(volatile unsigned* q) { return *q; }
__device__ __forceinline__ void phase_scan8(const Params& p, int l, unsigned char* lds) {
    const int tid = tid_(), lane = tid & 63, w = tid >> 6, l16 = lane & 15, rs = lane >> 4;
    volatile unsigned* flg = (volatile unsigned*)(lds + SC_FLAGS);
    for (int u0 = bid_(); u0 < 256; u0 += nblk_()) {
        const int unit = (nblk_() == 256) ? xcd_order(u0, 256) : u0;
        const int bh = unit >> 2, rg = unit & 3, b = bh >> 4, h = bh & 15;
        const size_t gbase = (size_t)b * S_ * RW + h * 64;
        if (tid < 8) flg[tid] = 0u;
        __syncthreads();
        if (w < 4) {
            typedef float f32x2v __attribute__((ext_vector_type(2)));
            f32x2v sA = (f32x2v){0.f, 0.f}, sB = (f32x2v){0.f, 0.f};
            const int irow = rg * 16 + w * 4 + rs;
#pragma unroll 1
            for (int c = 0; c < S_ / SC_CH; ++c) {
                { unsigned sp = 0; while (lds_ld(flg) < (unsigned)(c + 1) || lds_ld(flg + 1) < (unsigned)(c + 1)) { __builtin_amdgcn_s_sleep(1); if (++sp > (1u << 22)) break; } }
                const unsigned char* buf = lds + (c & 1) * SC_BUFB;
                float* yp = p.sy + gbase + (size_t)(c * SC_CH + l16) * RW + irow;
                const unsigned char* bl = buf + l16 * 16; const unsigned char* bv = buf + 5 * SC_CH * 256 + (w * 4 + rs) * 4;
#define SC_LOAD(W_, A_, B_, K_, R_, V_, s) do { W_ = *(const f32x4*)(bl + (s) * 256); A_ = *(const f32x4*)(bl + SC_CH * 256 + (s) * 256); B_ = *(const f32x4*)(bl + 2 * SC_CH * 256 + (s) * 256); \
        K_ = *(const f32x4*)(bl + 3 * SC_CH * 256 + (s) * 256); R_ = *(const f32x4*)(bl + 4 * SC_CH * 256 + (s) * 256); V_ = *(const float*)(bv + (s) * 64); } while (0)
#define SC_LO(x) ((f32x2v){x[0], x[1]})
#define SC_HI(x) ((f32x2v){x[2], x[3]})
#define SC_STEP(W_, A_, B_, K_, R_, V_, yout) do { f32x2v t_ = sA * SC_LO(A_); t_ = sB * SC_HI(A_) + t_; float sa = t_.x + t_.y; sa = dpp_add16(sa); \
        const f32x2v sa2 = (f32x2v){sa, sa}, v2 = (f32x2v){V_, V_}; \
        sA = sA * SC_LO(W_) + (sa2 * SC_LO(B_) + v2 * SC_LO(K_)); sB = sB * SC_HI(W_) + (sa2 * SC_HI(B_) + v2 * SC_HI(K_)); \
        f32x2v y_ = sA * SC_LO(R_); y_ = sB * SC_HI(R_) + y_; yout = y_.x + y_.y; } while (0)
#define SC_DPPADD(x, ctrl) ((x) + __int_as_float(__builtin_amdgcn_update_dpp(0, __float_as_int(x), ctrl, 0xF, 0xF, true)))
                f32x4 wA, aA, bA, kA, rA, wB, aB, bB, kB, rB; float vA, vB, ykeep = 0.f;
                const bool od1 = (l16 & 1) != 0, od2 = (l16 & 2) != 0; const int g4 = l16 >> 2;
                SC_LOAD(wA, aA, bA, kA, rA, vA, 0);
#pragma unroll 2
                for (int s = 0; s < SC_CH; s += 4) {
                    float y0, y1, y2, y3;
                    SC_LOAD(wB, aB, bB, kB, rB, vB, s + 1);
                    SC_STEP(wA, aA, bA, kA, rA, vA, y0);
                    SC_LOAD(wA, aA, bA, kA, rA, vA, s + 2);
                    SC_STEP(wB, aB, bB, kB, rB, vB, y1);
                    SC_LOAD(wB, aB, bB, kB, rB, vB, s + 3);
                    SC_STEP(wA, aA, bA, kA, rA, vA, y2);
                    if (s + 4 < SC_CH) SC_LOAD(wA, aA, bA, kA, rA, vA, s + 4);
                    SC_STEP(wB, aB, bB, kB, rB, vB, y3);
                    const float t01 = od1 ? y1 : y0, u01 = od1 ? y0 : y1, t23 = od1 ? y3 : y2, u23 = od1 ? y2 : y3;
                    const float r01 = t01 + __int_as_float(__builtin_amdgcn_update_dpp(0, __float_as_int(u01), 0xB1, 0xF, 0xF, true));
                    const float r23 = t23 + __int_as_float(__builtin_amdgcn_update_dpp(0, __float_as_int(u23), 0xB1, 0xF, 0xF, true));
                    const float tq = od2 ? r23 : r01, uq = od2 ? r01 : r23;
                    float rq = tq + __int_as_float(__builtin_amdgcn_update_dpp(0, __float_as_int(uq), 0x4E, 0xF, 0xF, true));
                    rq = SC_DPPADD(rq, 0x124);
                    rq = SC_DPPADD(rq, 0x128);
                    ykeep = (g4 == ((s >> 2) & 3)) ? rq : ykeep;
                    if ((s & 15) == 12) yp[(size_t)(s & 16) * RW] = ykeep;
                }
#undef SC_LOAD
#undef SC_STEP
#undef SC_LO
#undef SC_HI
#undef SC_DPPADD
                asm volatile("s_waitcnt lgkmcnt(0)" ::: "memory");
                if (lane == 0) flg[4 + w] = (unsigned)(c + 1);
            }
            if (threadIdx.x == 0) flg[2] = 1u;
        } else if (w < 6) {
            const bf16_t *q_a = p.ha, *q_b = p.hb, *q_k = p.hk, *q_r = p.hr;
            const int lt = tid - 256;
#pragma unroll 1
            for (int c = 0; c < S_ / SC_CH; ++c) {
                f32x4 rw[4]; u32x4 rh[8]; u32x2 rv;
#pragma unroll
                for (int i = 0; i < 4; ++i) { const int idx = lt + 128 * i, st = idx >> 4, q4 = idx & 15; rw[i] = *(const f32x4*)(p.sw + gbase + (size_t)(c * SC_CH + st) * RW + q4 * 4); }
#pragma unroll
                for (int i = 0; i < 8; ++i) { const int a = i >> 1, idx = lt + 128 * (i & 1), st = idx >> 3, q8 = idx & 7;
                    const bf16_t* src = (a == 0) ? q_a : (a == 1) ? q_b : (a == 2) ? q_k : q_r;
                    rh[i] = *(const u32x4*)(src + gbase + (size_t)(c * SC_CH + st) * RW + q8 * 8); }
                rv = *(const u32x2*)(p.hv + gbase + (size_t)(c * SC_CH + (lt >> 2)) * RW + rg * 16 + (lt & 3) * 4);
                if (c >= 2) { unsigned sp = 0; const unsigned need = (unsigned)(c - 1);
                    while (lds_ld(flg + 4) < need || lds_ld(flg + 5) < need || lds_ld(flg + 6) < need || lds_ld(flg + 7) < need) { __builtin_amdgcn_s_sleep(1); if (++sp > (1u << 22)) break; } }
                unsigned char* buf = lds + (c & 1) * SC_BUFB;
#pragma unroll
                for (int i = 0; i < 4; ++i) { const int idx = lt + 128 * i, st = idx >> 4, q4 = idx & 15; *(f32x4*)(buf + st * 256 + q4 * 16) = rw[i]; }
#pragma unroll
                for (int i = 0; i < 8; ++i) { const int a = i >> 1, idx = lt + 128 * (i & 1), st = idx >> 3, q8 = idx & 7;
                    unsigned char* dp = buf + (a + 1) * (SC_CH * 256) + st * 256 + q8 * 32;
                    *(f32x4*)dp = (f32x4){bflo(rh[i].x), bfhi(rh[i].x), bflo(rh[i].y), bfhi(rh[i].y)}; *(f32x4*)(dp + 16) = (f32x4){bflo(rh[i].z), bfhi(rh[i].z), bflo(rh[i].w), bfhi(rh[i].w)}; }
                *(f32x4*)(buf + 5 * SC_CH * 256 + (lt >> 2) * 64 + (lt & 3) * 16) = (f32x4){bflo(rv.x), bfhi(rv.x), bflo(rv.y), bfhi(rv.y)};
                asm volatile("s_waitcnt lgkmcnt(0)" ::: "memory");
                if (lane == 0) flg[w - 4] = (unsigned)(c + 1);
            }
        } else {
            unsigned char* scr = lds + SC_CVSCR + (w - 6) * 9216;
            const int g = bid_() * 2 + (w - 6), ncv = nblk_() * 2;
            const int k = convert_stream(p, cv_lo(l) + g, ncv, cv_hi(l), flg + 2, scr, lane);
            if (lane == 0) p.cvprog[l * 1024 + g] = (unsigned)k;
        }
        __syncthreads();
    }
}

#define LR_K 288
#define LR_ROWB 592
template <int l>
__device__ __forceinline__ void phase_prep8(const Params& p, unsigned char* lds) {
    const int tid = tid_(), lane = tid & 63, w = tid >> 6, fr = lane & 15, fq = lane >> 4;
    const float* mu = p.mu + (size_t)l * 3328;
    const bf16_t* LRT = p.LRT + (size_t)l * 1024 * LR_K;
    for (int unit = bid_(); unit < T_ / 32; unit += nblk_()) {
        const int t0 = unit * 32;
        {
            const int tok = tid >> 4, cg = tid & 15, t = t0 + tok; const bool first = (t % S_) == 0;
            const bf16_t* pc = p.P + (size_t)t * NIN + 6144 + cg * 16;
            const u32x4 c0 = *(const u32x4*)pc, c1 = *(const u32x4*)(pc + 8);
            u32x4 p0 = (u32x4){0u, 0u, 0u, 0u}, p1 = p0;
            if (!first) { p0 = *(const u32x4*)(pc - NIN); p1 = *(const u32x4*)(pc - NIN + 8); }
            const float* mm = mu + 3072 + cg * 16;
            float f[16];
#pragma unroll
            for (int e = 0; e < 4; ++e) { f[2 * e] = bflo(c0[e]) + (bflo(p0[e]) - bflo(c0[e])) * mm[2 * e]; f[2 * e + 1] = bfhi(c0[e]) + (bfhi(p0[e]) - bfhi(c0[e])) * mm[2 * e + 1];
                f[8 + 2 * e] = bflo(c1[e]) + (bflo(p1[e]) - bflo(c1[e])) * mm[8 + 2 * e]; f[8 + 2 * e + 1] = bfhi(c1[e]) + (bfhi(p1[e]) - bfhi(c1[e])) * mm[8 + 2 * e + 1]; }
            if (cg < 4) {
#pragma unroll
                for (int e = 0; e < 16; ++e) f[e] = tanhf_(f[e]);
            } else if (cg >= 8) {
#pragma unroll
                for (int e = 0; e < 16; ++e) f[e] = sigmoidf_(f[e]);
            }
            u32x4 o0, o1; o0.x = cvt_pk_bf16(f[0], f[1]); o0.y = cvt_pk_bf16(f[2], f[3]); o0.z = cvt_pk_bf16(f[4], f[5]); o0.w = cvt_pk_bf16(f[6], f[7]);
            o1.x = cvt_pk_bf16(f[8], f[9]); o1.y = cvt_pk_bf16(f[10], f[11]); o1.z = cvt_pk_bf16(f[12], f[13]); o1.w = cvt_pk_bf16(f[14], f[15]);
            *(u32x4*)(lds + tok * LR_ROWB + cg * 32) = o0; *(u32x4*)(lds + tok * LR_ROWB + cg * 32 + 16) = o1;
            if (l > 0) {
                const float* vr = p.VV + (size_t)t * 64;
                const float a0_ = vr[cg] + (first ? 0.f : vr[-64 + 32 + cg]), a1_ = vr[16 + cg] + (first ? 0.f : vr[-64 + 48 + cg]);
                bf16_t* vvp = (bf16_t*)(lds + tok * LR_ROWB + 512);
                vvp[cg] = (bf16_t)(cvt_pk_bf16(a0_, a0_) & 0xffffu); vvp[16 + cg] = (bf16_t)(cvt_pk_bf16(a1_, a1_) & 0xffffu);
            }
        }
        __syncthreads();
#pragma unroll 1
        for (int it = 0; it < 4; ++it) {
            const int hd = it >> 1, mt = it & 1, head = 2 * w + hd;
            const int t = t0 + 16 * mt + fr; const bool first = (t % S_) == 0;
            const bf16_t* prow = p.P + (size_t)t * NIN + 3072;
            const bf16_t* qrow = first ? prow : prow - NIN;
            f32x4 aw[4], aa[4], ag[4], av[4];
#pragma unroll
            for (int nt = 0; nt < 4; ++nt) { aw[nt] = (f32x4){0.f, 0.f, 0.f, 0.f}; aa[nt] = aw[nt]; ag[nt] = aw[nt]; av[nt] = aw[nt]; }
            bf16x8 af[9];
#pragma unroll
            for (int ks = 0; ks < 9; ++ks) af[ks] = *(const bf16x8*)(lds + (mt * 16 + fr) * LR_ROWB + ks * 64 + fq * 16);
            bf16x8 bq[2][9];
#define PR_LOADB(buf, nt_) do { const bf16_t* bp_ = LRT + (size_t)(head * 64 + ((nt_) >> 1) * 32 + 8 * (fr >> 2) + 4 * ((nt_) & 1) + (fr & 3)) * LR_K + fq * 8; \
                _Pragma("unroll") for (int ks_ = 0; ks_ < 9; ++ks_) bq[buf][ks_] = *(const bf16x8*)(bp_ + ks_ * 32); } while (0)
#define PR_MMA(buf, nt_) do { aw[nt_] = __builtin_amdgcn_mfma_f32_16x16x32_bf16(bq[buf][0], af[0], aw[nt_], 0, 0, 0); aw[nt_] = __builtin_amdgcn_mfma_f32_16x16x32_bf16(bq[buf][1], af[1], aw[nt_], 0, 0, 0); \
                aa[nt_] = __builtin_amdgcn_mfma_f32_16x16x32_bf16(bq[buf][2], af[2], aa[nt_], 0, 0, 0); aa[nt_] = __builtin_amdgcn_mfma_f32_16x16x32_bf16(bq[buf][3], af[3], aa[nt_], 0, 0, 0); \
                _Pragma("unroll") for (int ks_ = 4; ks_ < 8; ++ks_) ag[nt_] = __builtin_amdgcn_mfma_f32_16x16x32_bf16(bq[buf][ks_], af[ks_], ag[nt_], 0, 0, 0); \
                if (l > 0) av[nt_] = __builtin_amdgcn_mfma_f32_16x16x32_bf16(bq[buf][8], af[8], av[nt_], 0, 0, 0); } while (0)
            PR_LOADB(0, 0); PR_LOADB(1, 1);
            __builtin_amdgcn_sched_barrier(0);
            PR_MMA(0, 0);
            __builtin_amdgcn_sched_barrier(0);
            PR_LOADB(0, 2);
            __builtin_amdgcn_sched_barrier(0);
            PR_MMA(1, 1);
            __builtin_amdgcn_sched_barrier(0);
            PR_LOADB(1, 3);
            u32x4 raw[2][6];
#pragma unroll
            for (int pr = 0; pr < 2; ++pr) { const int c8 = head * 64 + pr * 32 + 8 * fq;
                raw[pr][0] = *(const u32x4*)(prow + c8); raw[pr][1] = *(const u32x4*)(prow + 1024 + c8); raw[pr][2] = *(const u32x4*)(prow + 2048 + c8);
                raw[pr][3] = *(const u32x4*)(qrow + c8); raw[pr][4] = *(const u32x4*)(qrow + 1024 + c8); raw[pr][5] = *(const u32x4*)(qrow + 2048 + c8); }
            __builtin_amdgcn_sched_barrier(0);
            PR_MMA(0, 2);
            __builtin_amdgcn_sched_barrier(0);
            PR_MMA(1, 3);
#undef PR_LOADB
#undef PR_MMA
            if (first) {
#pragma unroll
                for (int pr = 0; pr < 2; ++pr) { raw[pr][3] = (u32x4){0u, 0u, 0u, 0u}; raw[pr][4] = raw[pr][3]; raw[pr][5] = raw[pr][3]; } }
            f32x4 kkv[4], aav[4]; float ss = 0.f, bc = 0.f;
#pragma unroll
            for (int pr = 0; pr < 2; ++pr) {
                __builtin_amdgcn_sched_barrier(0);
                const int c8 = head * 64 + pr * 32 + 8 * fq; const size_t o8 = (size_t)t * RW + c8;
                const u32x4 cr = raw[pr][0], ck = raw[pr][1], cv = raw[pr][2], qr = raw[pr][3], qk = raw[pr][4], qv = raw[pr][5];
                u32x4 or_, ok_, ov_, og_;
                f32x4 Pmr[2], Pmk[2], Pmv[2], Pw0[2], Pa0[2], Pkk[2], Pka[2], Prk[2], Pv0[2], Pvf[2];
#pragma unroll
                for (int n = 0; n < 2; ++n) { const int c = c8 + 4 * n;
                    Pmr[n] = *(const f32x4*)(mu + c); Pmk[n] = *(const f32x4*)(mu + 1024 + c); Pmv[n] = *(const f32x4*)(mu + 2048 + c);
                    Pw0[n] = *(const f32x4*)(p.w0 + l * RW + c); Pa0[n] = *(const f32x4*)(p.a0 + l * RW + c); Pkk[n] = *(const f32x4*)(p.k_k + l * RW + c); Pka[n] = *(const f32x4*)(p.k_a + l * RW + c); Prk[n] = *(const f32x4*)(p.r_k + l * RW + c);
                    if (l > 0) { Pvf[n] = *(const f32x4*)(p.vfirst + (size_t)t * RW + c); Pv0[n] = *(const f32x4*)(p.v0 + c); } }
                __builtin_amdgcn_sched_barrier(0);
#pragma unroll
                for (int n = 0; n < 2; ++n) {
                    const int nt = 2 * pr + n, c = c8 + 4 * n; const size_t o = (size_t)t * RW + c;
                    const unsigned crx = n ? cr.z : cr.x, cry = n ? cr.w : cr.y, ckx = n ? ck.z : ck.x, cky = n ? ck.w : ck.y, cvx = n ? cv.z : cv.x, cvy = n ? cv.w : cv.y;
                    const unsigned qrx = n ? qr.z : qr.x, qry = n ? qr.w : qr.y, qkx = n ? qk.z : qk.x, qky = n ? qk.w : qk.y, qvx = n ? qv.z : qv.x, qvy = n ? qv.w : qv.y;
                    const f32x4 mr = Pmr[n], mk = Pmk[n], mv = Pmv[n];
                    f32x4 rr, kx, vx;
                    rr[0] = bflo(crx) + (bflo(qrx) - bflo(crx)) * mr[0]; rr[1] = bfhi(crx) + (bfhi(qrx) - bfhi(crx)) * mr[1]; rr[2] = bflo(cry) + (bflo(qry) - bflo(cry)) * mr[2]; rr[3] = bfhi(cry) + (bfhi(qry) - bfhi(cry)) * mr[3];
                    kx[0] = bflo(ckx) + (bflo(qkx) - bflo(ckx)) * mk[0]; kx[1] = bfhi(ckx) + (bfhi(qkx) - bfhi(ckx)) * mk[1]; kx[2] = bflo(cky) + (bflo(qky) - bflo(cky)) * mk[2]; kx[3] = bfhi(cky) + (bfhi(qky) - bfhi(cky)) * mk[3];
                    vx[0] = bflo(cvx) + (bflo(qvx) - bflo(cvx)) * mv[0]; vx[1] = bfhi(cvx) + (bfhi(qvx) - bfhi(cvx)) * mv[1]; vx[2] = bflo(cvy) + (bflo(qvy) - bflo(cvy)) * mv[2]; vx[3] = bfhi(cvy) + (bfhi(qvy) - bfhi(cvy)) * mv[3];
                    const f32x4 w0v = Pw0[n], a0v = Pa0[n], kkw = Pkk[n], kaw = Pka[n], rkw = Prk[n];
                    f32x4 dec, av_, kh;
#pragma unroll
                    for (int j = 0; j < 4; ++j) { dec[j] = __expf(-sigmoidf_(w0v[j] + aw[nt][j]) * 0.60653066f); av_[j] = sigmoidf_(a0v[j] + aa[nt][j]); }
                    if (l == 0) *(f32x4*)(p.vfirst + o) = vx;
                    else { const f32x4 vf = Pvf[n], v0v = Pv0[n];
#pragma unroll
                        for (int j = 0; j < 4; ++j) vx[j] = vx[j] + (vf[j] - vx[j]) * sigmoidf_(v0v[j] + av[nt][j]); }
#pragma unroll
                    for (int j = 0; j < 4; ++j) { const float kk = kx[j] * kkw[j]; kkv[nt][j] = kk; ss += kk * kk; kh[j] = kx[j] * (1.0f + (av_[j] - 1.0f) * kaw[j]); bc += rr[j] * kh[j] * rkw[j]; }
                    aav[nt] = av_;
                    *(f32x4*)(p.sw + o) = dec;
                    const unsigned r0 = cvt_pk_bf16(rr[0], rr[1]), r1 = cvt_pk_bf16(rr[2], rr[3]), k0_ = cvt_pk_bf16(kh[0], kh[1]), k1_ = cvt_pk_bf16(kh[2], kh[3]);
                    const unsigned v0_ = cvt_pk_bf16(vx[0], vx[1]), v1_ = cvt_pk_bf16(vx[2], vx[3]), g0_ = cvt_pk_bf16(ag[nt][0], ag[nt][1]), g1_ = cvt_pk_bf16(ag[nt][2], ag[nt][3]);
                    if (n == 0) { or_.x = r0; or_.y = r1; ok_.x = k0_; ok_.y = k1_; ov_.x = v0_; ov_.y = v1_; og_.x = g0_; og_.y = g1_; }
                    else { or_.z = r0; or_.w = r1; ok_.z = k0_; ok_.w = k1_; ov_.z = v0_; ov_.w = v1_; og_.z = g0_; og_.w = g1_; }
                }
                *(u32x4*)(p.hr + o8) = or_; *(u32x4*)(p.hk + o8) = ok_; *(u32x4*)(p.hv + o8) = ov_; *(u32x4*)(p.hg + o8) = og_;
            }
            ss += __shfl_xor(ss, 16); ss += __shfl_xor(ss, 32); bc += __shfl_xor(bc, 16); bc += __shfl_xor(bc, 32);
            const float rn = fminf(__builtin_amdgcn_rsqf(ss), 1e12f);
            if (fq == 0) p.bcoef[(size_t)t * 16 + head] = bc;
#pragma unroll
            for (int pr = 0; pr < 2; ++pr) { const size_t o8 = (size_t)t * RW + head * 64 + pr * 32 + 8 * fq;
                u32x4 oa, ob;
#pragma unroll
                for (int n = 0; n < 2; ++n) { const int nt = 2 * pr + n; f32x4 sa_, sb_;
#pragma unroll
                    for (int j = 0; j < 4; ++j) { const float kn = kkv[nt][j] * rn; sa_[j] = -kn; sb_[j] = kn * aav[nt][j]; }
                    const unsigned a0_ = cvt_pk_bf16(sa_[0], sa_[1]), a1_ = cvt_pk_bf16(sa_[2], sa_[3]), b0_ = cvt_pk_bf16(sb_[0], sb_[1]), b1_ = cvt_pk_bf16(sb_[2], sb_[3]);
                    if (n == 0) { oa.x = a0_; oa.y = a1_; ob.x = b0_; ob.y = b1_; } else { oa.z = a0_; oa.w = a1_; ob.z = b0_; ob.w = b1_; } }
                *(u32x4*)(p.ha + o8) = oa; *(u32x4*)(p.hb + o8) = ob; }
        }
        __syncthreads();
    }
}

__device__ __forceinline__ void phase_post(const Params& p, int l) {
    const int tid = tid_(), lane = tid & 63, w = tid >> 6;
    const float lam_init = (l == 0) ? 0.2f : 0.35550907f;
    float lam;
    { const float s1 = wave_sum(p.lam_q1[l * 64 + lane] * p.lam_k1[l * 64 + lane]), s2 = wave_sum(p.lam_q2[l * 64 + lane] * p.lam_k2[l * 64 + lane]); lam = __expf(s1) - __expf(s2) + lam_init; }
    const float* tmp = p.mixed;
    for (int t = bid_(); t < T_; t += nblk_()) {
        if (!USE_ATTN8) for (int h = w; h < 8; h += NTHR / 64) {
            const float* o0 = tmp + (size_t)t * D_ + h * 256 + lane * 2;
            const float x0 = o0[0] - lam * o0[128], x1 = o0[1] - lam * o0[129];
            const float ss = wave_sum(x0 * x0 + x1 * x1);
            const float rstd = rsqrtf(ss * (1.0f / 128.0f) + 1e-5f) * (1.0f - lam_init);
            const float* sg = p.subln_g + l * 128 + lane * 2;
            *(unsigned*)(p.ocat + (size_t)t * D_ + h * 128 + lane * 2) = cvt_pk_bf16(x0 * rstd * sg[0], x1 * rstd * sg[1]);
        }
        for (int h = w; h < 16; h += NTHR / 64) {
            const int cc = h * 64 + lane; const size_t o = (size_t)t * RW + cc;
            const float y = p.sy[o];
            const float mean = wave_sum(y) * (1.0f / 64.0f);
            const float d = y - mean;
            const float var = wave_sum(d * d) * (1.0f / 64.0f);
            const float yn = d * rsqrtf(var + 64e-5f) * p.lnx_w[l * RW + cc] + p.lnx_b[l * RW + cc];
            const float val = (yn + p.bcoef[(size_t)t * 16 + h] * bf2f(p.hv[o])) * bf2f(p.hg[o]);
            const float nb = __shfl_down(val, 1);
            if ((lane & 1) == 0) *(unsigned*)(p.ocat + (size_t)t * D_ + 1024 + cc) = cvt_pk_bf16(val, nb);
        }
    }
}

__device__ __forceinline__ void phase_post8(const Params& p, int l) {
    const int tid = tid_(), lane = tid & 63, l16 = lane & 15, rs = lane >> 4, gw = bid_() * NW_ + (tid >> 6), nw = nblk_() * NW_;
#pragma unroll 4
    for (int item = gw; item < T_ * 4; item += nw) {
        const int t = item >> 2, h = (item & 3) * 4 + rs, cc = h * 64 + l16 * 4; const size_t o = (size_t)t * RW + cc;
        const f32x4 y = *(const f32x4*)(p.sy + o);
        const u32x2 hv = *(const u32x2*)(p.hv + o), hg = *(const u32x2*)(p.hg + o);
        const float bc = p.bcoef[(size_t)t * 16 + h];
        const f32x4 lw = *(const f32x4*)(p.lnx_w + l * RW + cc), lb = *(const f32x4*)(p.lnx_b + l * RW + cc);
        const float mean = dpp_add16((y[0] + y[1]) + (y[2] + y[3])) * (1.0f / 64.0f);
        const f32x4 d = y - mean;
        const float var = dpp_add16((d[0] * d[0] + d[1] * d[1]) + (d[2] * d[2] + d[3] * d[3])) * (1.0f / 64.0f);
        const float rstd = rsqrtf(var + 64e-5f);
        const float v0 = ((d[0] * rstd * lw[0] + lb[0]) + bc * bflo(hv.x)) * bflo(hg.x), v1 = ((d[1] * rstd * lw[1] + lb[1]) + bc * bfhi(hv.x)) * bfhi(hg.x);
        const float v2 = ((d[2] * rstd * lw[2] + lb[2]) + bc * bflo(hv.y)) * bflo(hg.y), v3 = ((d[3] * rstd * lw[3] + lb[3]) + bc * bfhi(hv.y)) * bfhi(hg.y);
        u32x2 ov; ov.x = cvt_pk_bf16(v0, v1); ov.y = cvt_pk_bf16(v2, v3);
        *(u32x2*)(p.ocat + (size_t)t * D_ + 1024 + cc) = ov;
    }
}

__device__ __forceinline__ void phase_gemm_out(const Params& p, int l, unsigned char* lds) {
    const float* B = p.w_out + (size_t)l * D_ * D_;
    for (int unit = bid_(); unit < 64 * 16; unit += nblk_()) {
        const int mt = unit >> 4, nt = unit & 15;
        float* C = p.mixed;
        gemm_tile(lds, p.ocat, D_, [=](int r) { return mt * 128 + r; }, B + nt * 128 + (tid_() & 127), D_, D_,
                  [=](int m, int n, f32x4 v) { *(f32x4*)(C + (size_t)(mt * 128 + m) * D_ + nt * 128 + n) = v; });
    }
}

__device__ __forceinline__ void phase_res1_router(const Params& p, int l, unsigned char* lds) {
    const int tid = tid_(), lane = tid & 63, w = tid >> 6, gw = bid_() * (NTHR / 64) + w, nw = nblk_() * (NTHR / 64);
    float* hrow = (float*)lds + w * D_;
    const float* xin = (l == 0) ? p.x : p.out;
    const float* Wr = p.w_router + (size_t)l * D_ * NE;
    for (int t = gw; t < T_; t += nw) {
        const int b = t / S_;
        const float* md = p.mod + ((size_t)l * 4 + b) * 12288;
        f32x4 xv[8]; float ss = 0.f;
#pragma unroll
        for (int i = 0; i < 8; ++i) { const int e = i * 256 + lane * 4; const f32x4 mv = *(const f32x4*)(p.mixed + (size_t)t * D_ + e);
            ss += mv[0] * mv[0] + mv[1] * mv[1] + mv[2] * mv[2] + mv[3] * mv[3]; }
        ss = wave_sum(ss);
        const float rm = rsqrtf(ss * (1.0f / D_) + 1e-6f);
        float s2 = 0.f;
#pragma unroll
        for (int i = 0; i < 8; ++i) { const int e = i * 256 + lane * 4; const f32x4 gp = *(const f32x4*)(p.g_post_mix + l * D_ + e), ga = *(const f32x4*)(md + 4096 + e);
            const f32x4 mv = *(const f32x4*)(p.mixed + (size_t)t * D_ + e); xv[i] = *(const f32x4*)(xin + (size_t)t * D_ + e);
#pragma unroll
            for (int j = 0; j < 4; ++j) { xv[i][j] += ga[j] * (mv[j] * rm * gp[j]); s2 += xv[i][j] * xv[i][j]; }
            *(f32x4*)(p.out + (size_t)t * D_ + e) = xv[i]; }
        s2 = wave_sum(s2);
        const float rx = rsqrtf(s2 * (1.0f / D_) + 1e-6f);
        emit_hn(xv, rx, p.g_pre_ffn + l * D_, md + 8192, md + 6144, p.Hn + (size_t)t * D_, lane, hrow);
        __builtin_amdgcn_s_waitcnt(0);
        __builtin_amdgcn_wave_barrier();
        float lg = 0.f;
#pragma unroll 8
        for (int k = 0; k < D_; ++k) lg += hrow[k] * Wr[(size_t)k * NE + lane];
        const float score = sigmoidf_(lg), biased = score + p.router_bias[l * NE + lane];
        int rk = 0;
#pragma unroll
        for (int i = 0; i < 8; ++i) { const int src = (lane & ~7) + i; const float o = __shfl(biased, src); rk += (o > biased || (o == biased && src < lane)) ? 1 : 0; }
        float gs = (rk < 2) ? biased : 0.f;
        gs += __shfl_xor(gs, 1); gs += __shfl_xor(gs, 2); gs += __shfl_xor(gs, 4);
        int grk = 0; const int g = lane >> 3;
#pragma unroll
        for (int i = 0; i < 8; ++i) { const float o = RL(gs, i * 8); grk += (o > gs || (o == gs && i < g)) ? 1 : 0; }
        const bool gsel = grk < 4;
        const float mvv = gsel ? biased : -INFINITY;
        int erk = 0;
#pragma unroll
        for (int i = 0; i < 64; ++i) { const float o = RL(mvv, i); erk += (o > mvv || (o == mvv && i < lane)) ? 1 : 0; }
        const bool sel = gsel && erk < 8;
        const float gsum = wave_sum(sel ? score : 0.f);
        if (sel) {
            const float gate = score / gsum * 2.5f;
            const unsigned slot = atomicAdd(p.counts + (l * NE + lane) * 32, 1u);
            p.rowtok[lane * CAP + slot] = t; p.rowg[lane * CAP + slot] = gate; p.tokpos[(size_t)t * 8 + erk] = lane * CAP + (int)slot;
        }
        __builtin_amdgcn_wave_barrier();
    }
}

#define RT_ROWB 4112
__device__ __forceinline__ void phase_res1_router8(const Params& p, int l, unsigned char* lds) {
    const int tid = tid_(), lane = tid & 63, w = tid >> 6, fr = lane & 15, fq = lane >> 4;
    const float* xin = (l == 0) ? p.x : p.out;
    unsigned char* hiL = lds; unsigned char* loL = lds + 16 * RT_ROWB; float* part = (float*)lds;
    const bf16_t* Whi = p.WrT + (size_t)l * 2 * NE * D_; const bf16_t* Wlo = Whi + (size_t)NE * D_;
    int* selinfo = (int*)(lds + RSEL_OFF); int* lcount = selinfo + 4 * 128 * 3; int* lbase = lcount + NE;
    if (tid < NE) lcount[tid] = 0;
    int nsel = 0;
    __syncthreads();
    for (int unit = bid_(); unit < T_ / 16; unit += nblk_()) {
        const int b = (unit * 16) / S_;
        const float* md = p.mod + ((size_t)l * 4 + b) * 12288;
#pragma unroll 1
        for (int rr = 0; rr < 2; ++rr) {
            const int tl = rfl(w) + 8 * rr, t = unit * 16 + tl;
            int e0 = lane * 4; asm volatile("" : "+v"(e0));
            f32x4 xv[8], pa[8], pb[8], pc[8]; float ss = 0.f;
            u32x2 mq[8];
#pragma unroll
            for (int i = 0; i < 8; ++i) { const int e = i * 256 + e0; mq[i] = *(const u32x2*)((const bf16_t*)p.mixed + (size_t)t * D_ + e); xv[i] = *(const f32x4*)(xin + (size_t)t * D_ + e);
                pa[i] = *(const f32x4*)(p.g_post_mix + l * D_ + e); pb[i] = *(const f32x4*)(md + 4096 + e); }
            __builtin_amdgcn_sched_barrier(0);
#pragma unroll
            for (int i = 0; i < 8; ++i) { const float m0 = bflo(mq[i].x), m1 = bfhi(mq[i].x), m2 = bflo(mq[i].y), m3 = bfhi(mq[i].y); ss += m0 * m0 + m1 * m1 + m2 * m2 + m3 * m3; }
            ss = wave_sum(ss);
            const float rm = rsqrtf(ss * (1.0f / D_) + 1e-6f);
            float s2 = 0.f;
#pragma unroll
            for (int i = 0; i < 8; ++i) { const int e = i * 256 + e0;
                const f32x4 mv = (f32x4){bflo(mq[i].x), bfhi(mq[i].x), bflo(mq[i].y), bfhi(mq[i].y)};
#pragma unroll
                for (int j = 0; j < 4; ++j) { xv[i][j] += pb[i][j] * (mv[j] * rm * pa[i][j]); s2 += xv[i][j] * xv[i][j]; }
                *(f32x4*)(p.out + (size_t)t * D_ + e) = xv[i]; }
            __builtin_amdgcn_sched_barrier(0);
#pragma unroll
            for (int i = 0; i < 8; ++i) { const int e = i * 256 + e0; pa[i] = *(const f32x4*)(p.g_pre_ffn + l * D_ + e); pb[i] = *(const f32x4*)(md + 8192 + e); pc[i] = *(const f32x4*)(md + 6144 + e); }
            __builtin_amdgcn_sched_barrier(0);
            s2 = wave_sum(s2);
            const float rx = rsqrtf(s2 * (1.0f / D_) + 1e-6f);
#pragma unroll
            for (int i = 0; i < 8; ++i) { const int e = i * 256 + e0;
                f32x4 h;
#pragma unroll
                for (int j = 0; j < 4; ++j) h[j] = xv[i][j] * rx * pa[i][j] * (1.0f + pb[i][j]) + pc[i][j];
                u32x2 hi; hi.x = cvt_pk_bf16(h[0], h[1]); hi.y = cvt_pk_bf16(h[2], h[3]);
                u32x2 lo; lo.x = cvt_pk_bf16(h[0] - bflo(hi.x), h[1] - bfhi(hi.x)); lo.y = cvt_pk_bf16(h[2] - bflo(hi.y), h[3] - bfhi(hi.y));
                *(u32x2*)(p.Hn + (size_t)t * D_ + e) = hi;
                *(u32x2*)(hiL + tl * RT_ROWB + e * 2) = hi; *(u32x2*)(loL + tl * RT_ROWB + e * 2) = lo; }
        }
        __syncthreads();
        f32x4 acc[4];
        {
#pragma unroll
            for (int nt = 0; nt < 4; ++nt) acc[nt] = (f32x4){0.f, 0.f, 0.f, 0.f};
            bf16x8 bh[2][8], bl[2][8];
            int wz = fq * 8; asm volatile("" : "+v"(wz));
            const bf16_t* wb = Whi + (size_t)fr * D_ + w * 256 + wz; const bf16_t* wl = Wlo + (size_t)fr * D_ + w * 256 + wz;
#define RT_LOADB(buf, nt_) do { _Pragma("unroll") for (int kk_ = 0; kk_ < 8; ++kk_) { bh[buf][kk_] = *(const bf16x8*)(wb + (size_t)(nt_) * 16 * D_ + kk_ * 32); bl[buf][kk_] = *(const bf16x8*)(wl + (size_t)(nt_) * 16 * D_ + kk_ * 32); } } while (0)
            RT_LOADB(0, 0); RT_LOADB(1, 1);
            __builtin_amdgcn_sched_barrier(0);
#pragma unroll
            for (int nt = 0; nt < 4; ++nt) {
#pragma unroll
                for (int kk = 0; kk < 8; ++kk) { const int ks = w * 8 + kk;
                    const bf16x8 ahi = *(const bf16x8*)(hiL + fr * RT_ROWB + ks * 64 + fq * 16), alo = *(const bf16x8*)(loL + fr * RT_ROWB + ks * 64 + fq * 16);
                    acc[nt] = __builtin_amdgcn_mfma_f32_16x16x32_bf16(bh[nt & 1][kk], ahi, acc[nt], 0, 0, 0);
                    acc[nt] = __builtin_amdgcn_mfma_f32_16x16x32_bf16(bh[nt & 1][kk], alo, acc[nt], 0, 0, 0);
                    acc[nt] = __builtin_amdgcn_mfma_f32_16x16x32_bf16(bl[nt & 1][kk], ahi, acc[nt], 0, 0, 0); }
                __builtin_amdgcn_sched_barrier(0);
                if (nt + 2 < 4) { if (nt == 0) RT_LOADB(0, 2); else RT_LOADB(1, 3); }
                __builtin_amdgcn_sched_barrier(0);
            }
#undef RT_LOADB
        }
        __syncthreads();
#pragma unroll
        for (int nt = 0; nt < 4; ++nt) *(f32x4*)(part + (w * 16 + fr) * 64 + nt * 16 + fq * 4) = acc[nt];
        __syncthreads();
#pragma unroll 1
        for (int rr = 0; rr < 2; ++rr) {
            const int tl = w + 8 * rr, t = unit * 16 + tl;
            float lg = 0.f;
#pragma unroll
            for (int ww = 0; ww < 8; ++ww) lg += part[(ww * 16 + tl) * 64 + lane];
            const float score = sigmoidf_(lg), biased = score + p.router_bias[l * NE + lane];
            int rk = 0;
#pragma unroll
            for (int i = 0; i < 8; ++i) { const int src = (lane & ~7) + i; const float o = __shfl(biased, src); rk += (o > biased || (o == biased && src < lane)) ? 1 : 0; }
            float gs = (rk < 2) ? biased : 0.f;
            gs += __shfl_xor(gs, 1); gs += __shfl_xor(gs, 2); gs += __shfl_xor(gs, 4);
            int grk = 0; const int g = lane >> 3;
#pragma unroll
            for (int i = 0; i < 8; ++i) { const float o = RL(gs, i * 8); grk += (o > gs || (o == gs && i < g)) ? 1 : 0; }
            const bool gsel = grk < 4;
            const float mvv = gsel ? biased : -INFINITY;
            int erk = 0;
#pragma unroll
            for (int i = 0; i < 64; ++i) { const float o = RL(mvv, i); erk += (o > mvv || (o == mvv && i < lane)) ? 1 : 0; }
            const bool sel = gsel && erk < 8;
            const float gsum = wave_sum(sel ? score : 0.f);
            if (sel) {
                const float gate = score / gsum * 2.5f;
                const int lrank = atomicAdd(lcount + lane, 1);
                int* si = selinfo + ((nsel * 16 + tl) * 8 + erk) * 3;
                si[0] = t; si[1] = (lane << 16) | lrank; si[2] = __float_as_int(gate);
            }
        }
        ++nsel;
        __syncthreads();
    }
    if (tid < NE) { const int c = lcount[tid]; lbase[tid] = c ? (int)atomicAdd(p.counts + (l * NE + tid) * 32, (unsigned)c) : 0; }
    __syncthreads();
    for (int i = tid; i < nsel * 128; i += NTHR) { const int* si = selinfo + i * 3; const int t = si[0], e = si[1] >> 16, slot = lbase[e] + (si[1] & 0xffff);
        p.rowtok[e * CAP + slot] = t; p.tokpos[(size_t)t * 8 + (i & 7)] = e * CAP + slot; p.tokgate[(size_t)t * 8 + (i & 7)] = __int_as_float(si[2]); }
    __syncthreads();
}

__device__ __forceinline__ void phase_moe_gu(const Params& p, int l, unsigned char* lds) {
    int* tab = (int*)(lds + TAB_OFF);
    build_tables(p, l, tab, 7);
    const int ntile = tab[160 + NE + 1];
    for (int unit = bid_(); unit < ntile * 8; unit += nblk_()) {
        const int rtg = unit >> 3, ct = unit & 7, e = find_expert(tab, rtg), rt = rtg - tab[160 + e], cnt = tab[e], pb = tab[80 + e];
        const float* Bg = (e < NE) ? p.w_eg + ((size_t)(l * NE + e) * D_) * 512 : p.w_sg + (size_t)l * D_ * 512;
        const float* Bu = (e < NE) ? p.w_eu + ((size_t)(l * NE + e) * D_) * 512 : p.w_su + (size_t)l * D_ * 512;
        const int n = tid_() & 127;
        const float* bp = ((n & 1) ? Bu : Bg) + ct * 64 + (n >> 1);
        const int* rtok = p.rowtok + e * CAP;
        bf16_t* H1 = p.H1;
        gemm_tile(lds, p.Hn, D_, [=](int r) { const int slot = rt * 128 + r; return (slot < cnt) ? ((e < NE) ? rtok[slot] : slot) : 0; }, bp, 512, D_,
                  [=](int m, int nn, f32x4 v) { const float h0 = v[0] / (1.0f + __expf(-v[0])) * v[1], h1 = v[2] / (1.0f + __expf(-v[2])) * v[3];
                      *(unsigned*)(H1 + (size_t)(pb + rt * 128 + m) * 512 + ct * 64 + (nn >> 1)) = cvt_pk_bf16(h0, h1); });
    }
}

__device__ __forceinline__ void phase_moe_down(const Params& p, int l, unsigned char* lds) {
    int* tab = (int*)(lds + TAB_OFF);
    build_tables(p, l, tab, 7);
    const int ntile = tab[160 + NE + 1];
    for (int unit = bid_(); unit < ntile * 16; unit += nblk_()) {
        const int rtg = unit >> 4, ct = unit & 15, e = find_expert(tab, rtg), rt = rtg - tab[160 + e], cnt = tab[e], pb = tab[80 + e];
        const float* Bd = (e < NE) ? p.w_ed + ((size_t)(l * NE + e) * 512) * D_ : p.w_sd + (size_t)l * 512 * D_;
        const float* rg = p.rowg + e * CAP;
        bf16_t* Y2 = p.Y2;
        gemm_tile(lds, p.H1, 512, [=](int r) { return pb + rt * 128 + r; }, Bd + ct * 128 + (tid_() & 127), D_, 512,
                  [=](int m, int nn, f32x4 v) { const int slot = rt * 128 + m; const float g = (slot < cnt) ? ((e < NE) ? rg[slot] : 1.0f) : 0.f;
                      u32x2 o; o.x = cvt_pk_bf16(v[0] * g, v[1] * g); o.y = cvt_pk_bf16(v[2] * g, v[3] * g);
                      *(u32x2*)(Y2 + (size_t)(pb + slot) * D_ + ct * 128 + nn) = o; });
    }
}

__device__ __forceinline__ void phase_combine(const Params& p, int l, unsigned char* lds) {
    typedef float f32x2c __attribute__((ext_vector_type(2)));
    int* tab = (int*)(lds + TAB_OFF);
    build_tables(p, l, tab, 8);
    const int lane = tid_() & 63, gw = bid_() * (NTHR / 64) + (tid_() >> 6), nw = nblk_() * (NTHR / 64);
    const unsigned char* Y2q = (const unsigned char*)p.Y2;
    float* lp = (float*)lds;
    {   const int tid = tid_(), nreg = (l + 1 < 2) ? 14 : 5;
        f32x4 pv[14];
#pragma unroll
        for (int j = 0; j < 14; ++j) if (j < nreg) {
            const float* src = (j == 0) ? p.g_post_ffn + l * D_ : (j < 5) ? p.mod + ((size_t)l * 4 + (j - 1)) * 12288 + 10240 : (j == 5) ? p.g_pre_mix + (l + 1) * D_
                             : (j < 10) ? p.mod + ((size_t)(l + 1) * 4 + (j - 6)) * 12288 + 2048 : p.mod + ((size_t)(l + 1) * 4 + (j - 10)) * 12288;
            pv[j] = *(const f32x4*)(src + tid * 4); }
#pragma unroll
        for (int j = 0; j < 14; ++j) if (j < nreg) *(f32x4*)(lp + j * 2048 + tid * 4) = pv[j];
        __syncthreads();
    }
    for (int t = gw; t < T_; t += nw) {
        const int b = t / S_;
        const float* md = p.mod + ((size_t)l * 4 + b) * 12288;
        f32x4 yv[8];
        const unsigned char* yr[9]; float gk[9];
        { const u32x4 tp0 = *(const u32x4*)(p.tokpos + (size_t)t * 8), tp1 = *(const u32x4*)(p.tokpos + (size_t)t * 8 + 4);
          const f32x4 g0 = *(const f32x4*)(p.tokgate + (size_t)t * 8), g1 = *(const f32x4*)(p.tokgate + (size_t)t * 8 + 4);
#pragma unroll
          for (int k = 0; k < 4; ++k) { const int a = (int)tp0[k], bq = (int)tp1[k];
              yr[k] = Y2q + (size_t)(tab[80 + (a >> 13)] + (a & (CAP - 1))) * D_ + lane * 8; gk[k] = g0[k] * (1.0f / Y2_SCALE);
              yr[4 + k] = Y2q + (size_t)(tab[80 + (bq >> 13)] + (bq & (CAP - 1))) * D_ + lane * 8; gk[4 + k] = g1[k] * (1.0f / Y2_SCALE); }
          yr[8] = Y2q + (size_t)(tab[80 + NE] + t) * D_ + lane * 8; gk[8] = 1.0f / Y2_SCALE; }
        u32x2 u[9][4];
#pragma unroll
        for (int k = 0; k < 9; ++k)
#pragma unroll
            for (int i = 0; i < 4; ++i) u[k][i] = *(const u32x2*)(yr[k] + i * 512);
        f32x4 xo8[8];
#pragma unroll
        for (int i = 0; i < 8; ++i) xo8[i] = *(const f32x4*)(p.out + (size_t)t * D_ + (i >> 1) * 512 + lane * 8 + (i & 1) * 4);
        __builtin_amdgcn_sched_barrier(0);
#pragma unroll
        for (int i = 0; i < 4; ++i) { f32x4 a0 = (f32x4){0.f, 0.f, 0.f, 0.f}, a1 = a0;
#pragma unroll
            for (int k = 0; k < 9; ++k) { const f32x2c x0 = __builtin_amdgcn_cvt_pk_f32_fp8((int)u[k][i].x, false), x1 = __builtin_amdgcn_cvt_pk_f32_fp8((int)u[k][i].x, true);
                const f32x2c x2 = __builtin_amdgcn_cvt_pk_f32_fp8((int)u[k][i].y, false), x3 = __builtin_amdgcn_cvt_pk_f32_fp8((int)u[k][i].y, true);
                a0[0] += gk[k] * x0.x; a0[1] += gk[k] * x0.y; a0[2] += gk[k] * x1.x; a0[3] += gk[k] * x1.y; a1[0] += gk[k] * x2.x; a1[1] += gk[k] * x2.y; a1[2] += gk[k] * x3.x; a1[3] += gk[k] * x3.y; }
            yv[2 * i] = a0; yv[2 * i + 1] = a1; }
        float ss = 0.f;
#pragma unroll
        for (int i = 0; i < 8; ++i) ss += yv[i][0] * yv[i][0] + yv[i][1] * yv[i][1] + yv[i][2] * yv[i][2] + yv[i][3] * yv[i][3];
        ss = wave_sum(ss);
        const float ry = rsqrtf(ss * (1.0f / D_) + 1e-6f);
        float s2 = 0.f;
#pragma unroll
        for (int i = 0; i < 8; ++i) { const int e = (i >> 1) * 512 + lane * 8 + (i & 1) * 4; const f32x4 xo = xo8[i];
            const f32x4 gp = *(const f32x4*)(lp + e), gf = *(const f32x4*)(lp + (1 + b) * 2048 + e);
#pragma unroll
            for (int j = 0; j < 4; ++j) { yv[i][j] = xo[j] + gf[j] * (yv[i][j] * ry * gp[j]); s2 += yv[i][j] * yv[i][j]; }
            *(f32x4*)(p.out + (size_t)t * D_ + e) = yv[i]; }
        if (l + 1 < 2) {
            s2 = wave_sum(s2);
            const float rx = rsqrtf(s2 * (1.0f / D_) + 1e-6f);
            const float* md1 = p.mod + ((size_t)(l + 1) * 4 + b) * 12288;
            const float* g = p.g_pre_mix + (l + 1) * D_;
#pragma unroll
            for (int i = 0; i < 8; ++i) { const int e = (i >> 1) * 512 + lane * 8 + (i & 1) * 4;
                const f32x4 gv = *(const f32x4*)(lp + 5 * 2048 + e), scv = *(const f32x4*)(lp + (6 + b) * 2048 + e), shv = *(const f32x4*)(lp + (10 + b) * 2048 + e);
                f32x4 h;
#pragma unroll
                for (int j = 0; j < 4; ++j) h[j] = yv[i][j] * rx * gv[j] * (1.0f + scv[j]) + shv[j];
                u32x2 o; o.x = cvt_pk_bf16(h[0], h[1]); o.y = cvt_pk_bf16(h[2], h[3]);
                *(u32x2*)(p.Hn + (size_t)t * D_ + e) = o; }
        }
    }
}

#ifndef USE_SCAN8
#define USE_SCAN8 1
#endif
#ifndef USE_PREP8
#define USE_PREP8 1
#endif
#ifndef USE_ROUTER8
#define USE_ROUTER8 1
#endif
#ifndef USE8_IN
#define USE8_IN 1
#endif
#ifndef USE8_OUT
#define USE8_OUT 1
#endif
#ifndef USE8_GU
#define USE8_GU 1
#endif
#ifndef USE8_DOWN
#define USE8_DOWN 1
#endif
__global__ __launch_bounds__(NTHR, 2) void k_fwd(Params p) {
#define PP() (*(const Params*)((const char*)&p + launder0()))
    extern __shared__ __attribute__((aligned(16))) unsigned char lds[];
    volatile LAS unsigned* xbw = (volatile LAS unsigned*)(lds + LDS_BYTES);
    if (threadIdx.x == 0) { xbw[0] = 0u; xbw[1] = 0u; xbw[2] = 0u; xbw[3] = 0u; }
    __syncthreads();
    (void)xcd_barrier_post(p.bar, xbw);
#define GRIDBAR() do { XcdBarrier _b; _b.bar = PP().bar; _b.x = xb_xcc_id(); _b.st = (volatile LAS unsigned*)(lds + LDS_BYTES); xcd_barrier(_b); } while (0)
#ifndef TIME_PH
#define TIME_PH -1
#endif
    volatile unsigned long long* tsl = (volatile unsigned long long*)(lds + RSEL_OFF + 8192);
    int nst = 0;
#define STAMP() do { if (TIME_PH >= 0) { if (blockIdx.x == 0 && threadIdx.x == 0 && nst < 60) tsl[nst] = wall_clock64(); ++nst; } } while (0)
    STAMP();
#ifdef TIME_PRO
#define PROBAR() do { GRIDBAR(); STAMP(); } while (0)
#else
#define PROBAR() do { __syncthreads(); } while (0)
#endif
#ifndef REP_PRO
#define REP_PRO 1
#endif
#ifndef REP_GEMM
#define REP_GEMM 1
#endif
#ifndef REP_SCAN
#define REP_SCAN 1
#endif
#ifndef REP_POST
#define REP_POST 1
#endif
#ifndef REP_ATT
#define REP_ATT 1
#endif
#ifndef REP_MIX
#define REP_MIX 1
#endif
    for (int rep = 0; rep < REP_PRO; ++rep) {
    phase_adaln(PP(), lds);   PROBAR();
    phase_convert(PP(), lds); PROBAR();
    phase_cv_lrt(PP());       PROBAR();
    phase_cv_u(PP(), lds);    PROBAR();
    phase_cv_wrt(PP());
    GRIDBAR(); STAMP(); }
    phase_prenorm0(PP());
    GRIDBAR(); STAMP();
#pragma unroll 1
    for (int l = 0; l < 2; ++l) {
        for (int rep = 0; rep < REP_GEMM; ++rep) {
        if (USE8_IN) phase_gemm_in8(PP(), l, lds); else phase_gemm_in(PP(), l, lds);
        GRIDBAR(); STAMP(); }
        for (int rep = 0; rep < REP_MIX; ++rep) {
        for (int r2 = 0; r2 < REP_ATT; ++r2) { if (USE_ATTN8) phase_attn8(PP(), l, lds); else phase_attn_naive(PP()); }
        __syncthreads(); STAMP();
        if (USE_PREP8) { if (l == 0) phase_prep8<0>(PP(), lds); else phase_prep8<1>(PP(), lds); } else phase_rwkv_prep(PP(), l, lds);
        GRIDBAR(); STAMP();
        for (int r2 = 0; r2 < REP_SCAN; ++r2) { if (USE_SCAN8) phase_scan8(PP(), l, lds); else phase_scan_naive(PP());
        GRIDBAR(); STAMP(); }
        for (int r2 = 0; r2 < REP_POST; ++r2) { if (USE_ATTN8) phase_post8(PP(), l); else phase_post(PP(), l);
        GRIDBAR(); STAMP(); } }
        for (int rep = 0; rep < REP_GEMM; ++rep) {
        if (USE8_OUT) phase_gemm_out8(PP(), l, lds); else phase_gemm_out(PP(), l, lds);
        GRIDBAR(); STAMP(); }
        if (USE_ROUTER8) phase_res1_router8(PP(), l, lds); else phase_res1_router(PP(), l, lds);
        convert_leftovers(PP(), l, lds);
        GRIDBAR(); STAMP();
        for (int rep = 0; rep < REP_GEMM; ++rep) {
        if (USE8_GU) phase_moe_gu8(PP(), l, lds); else phase_moe_gu(PP(), l, lds);
        GRIDBAR(); STAMP(); }
        for (int rep = 0; rep < REP_GEMM; ++rep) {
        if (USE8_DOWN) phase_moe_down8(PP(), l, lds); else phase_moe_down(PP(), l, lds);
        GRIDBAR(); STAMP(); }
        phase_combine(PP(), l, lds);
        GRIDBAR(); STAMP();
    }
    if (TIME_PH >= 0 && blockIdx.x == 0 && threadIdx.x == 0) {
        const unsigned long long d = tsl[TIME_PH + 1] - tsl[TIME_PH], t0 = wall_clock64();
        const unsigned long long lim = (9ull * d < 5000000ull) ? 9ull * d : 5000000ull;
        while (wall_clock64() - t0 < lim) __builtin_amdgcn_s_sleep(8);
    }
}

extern "C" void kernel_launch(void* const* d_in, const int* in_sizes, int n_in, void* d_out, int out_size, void* d_ws, size_t ws_size, hipStream_t stream) {
    Params p{};
    const float* const* in = (const float* const*)d_in;
    p.x = in[0]; p.c = in[1]; p.w_ada = in[2]; p.b_ada = in[3]; p.g_pre_mix = in[4]; p.g_post_mix = in[5]; p.g_pre_ffn = in[6]; p.g_post_ffn = in[7]; p.w_in = in[8]; p.w_out = in[9];
    p.lam_q1 = in[10]; p.lam_k1 = in[11]; p.lam_q2 = in[12]; p.lam_k2 = in[13]; p.subln_g = in[14]; p.mu = in[15]; p.w0 = in[16]; p.w2 = in[17]; p.a0 = in[18]; p.a2 = in[19]; p.g2 = in[20];
    p.k_k = in[21]; p.k_a = in[22]; p.r_k = in[23]; p.lnx_w = in[24]; p.lnx_b = in[25]; p.v0 = in[26]; p.v1 = in[27]; p.v2 = in[28];
    p.w_router = in[29]; p.router_bias = in[30]; p.w_eg = in[31]; p.w_eu = in[32]; p.w_ed = in[33]; p.w_sg = in[34]; p.w_su = in[35]; p.w_sd = in[36];
    p.out = (float*)d_out;
    unsigned char* ws = (unsigned char*)d_ws; size_t off = 0;
    auto take = [&](size_t bytes) { void* r = ws + off; off += (bytes + 255) & ~(size_t)255; return r; };
    p.bar = (unsigned*)take(16384);
    p.counts = (unsigned*)take(2 * NE * 128);
    p.cvprog = (unsigned*)take(2 * 1024 * 4);
    p.mod = (float*)take((size_t)2 * 4 * 12288 * 4);
    p.Hn = (bf16_t*)take((size_t)T_ * D_ * 2);
    p.P = (bf16_t*)take((size_t)T_ * NIN * 2);
    p.sr = (float*)take((size_t)T_ * RW * 4); p.sw = (float*)take((size_t)T_ * RW * 4); p.sk = (float*)take((size_t)T_ * RW * 4); p.sv = (float*)take((size_t)T_ * RW * 4);
    p.sa = (float*)take((size_t)T_ * RW * 4); p.sb = (float*)take((size_t)T_ * RW * 4); p.sy = (float*)take((size_t)T_ * RW * 4); p.sg = (float*)take((size_t)T_ * RW * 4);
    p.vfirst = (float*)take((size_t)T_ * RW * 4);
    p.hr = (bf16_t*)p.sr; p.hk = (bf16_t*)p.sk; p.hv = (bf16_t*)p.sv; p.ha = (bf16_t*)p.sa; p.hb = (bf16_t*)p.sb; p.hg = (bf16_t*)p.sg;
    p.bcoef = (float*)take((size_t)T_ * 16 * 4);
    p.ocat = (bf16_t*)take((size_t)T_ * D_ * 2);
    p.mixed = (float*)take((size_t)T_ * D_ * 4);
    p.rowtok = (int*)take((size_t)NE * CAP * 4);
    p.rowg = (float*)take((size_t)NE * CAP * 4);
    p.tokpos = (int*)take((size_t)T_ * 8 * 4);
    p.tokgate = (float*)take((size_t)T_ * 8 * 4);
    p.H1 = (bf16_t*)take((size_t)PMAX * 512 * 2);
    p.Y2 = (bf16_t*)take((size_t)PMAX * D_ * 2);
    p.Vt = (bf16_t*)take((size_t)T_ * 1024 * 2);
    p.LRT = (bf16_t*)take((size_t)2 * 1024 * 288 * 2);
    p.WrT = (bf16_t*)take((size_t)2 * 2 * NE * D_ * 2);
    p.VV = (float*)take((size_t)T_ * 64 * 4);
    p.WinT = (bf16_t*)take((size_t)2 * NINX * D_ * 2);
    p.WoutT = (bf16_t*)take((size_t)2 * D_ * D_ * 2);
    p.WguT = (bf16_t*)take((size_t)2 * 65 * 1024 * D_ * 2);
    p.WdT = (bf16_t*)take((size_t)2 * 65 * D_ * 512 * 2);
    (void)hipMemsetAsync(p.bar, 0, (size_t)((unsigned char*)p.mod - (unsigned char*)p.bar), stream);
    static int grid = 0;
    if (!grid) {
        int dev = 0, cus = 0, per_cu = 0;
        (void)hipGetDevice(&dev);
        (void)hipDeviceGetAttribute(&cus, hipDeviceAttributeMultiprocessorCount, dev);
        (void)hipFuncSetAttribute((const void*)k_fwd, hipFuncAttributeMaxDynamicSharedMemorySize, LDS_BYTES + 16);
        (void)hipOccupancyMaxActiveBlocksPerMultiprocessor(&per_cu, k_fwd, NTHR, LDS_BYTES + 16);
        if (per_cu < 1) per_cu = 1;
        grid = cus;
    }
    k_fwd<<<grid, NTHR, LDS_BYTES + 16, stream>>>(p);
}
```
